# Optimizing an MI355X kernel written in HIP

```python
import math
import jax, jax.numpy as jnp
from jax import lax
import numpy as np

D_MODEL = 2048
BATCH = 16
SEQ = 2048
DEPTH = 4

N_MIXERS = 2
N_ATTN_LAYERS = (DEPTH + 1) // 2
N_SSM_LAYERS = DEPTH // 2

N_HEADS = 16
HEAD_DIM = D_MODEL // N_HEADS
DILATED_GROUPS = ((128, 1), (512, 4), (2048, 16))
N_DGROUPS = len(DILATED_GROUPS)
ATTN_BLOCK = 128
QK_COLS = N_DGROUPS * N_HEADS * HEAD_DIM
V_COLS = N_HEADS * HEAD_DIM
ATTN_IN_COLS = 2 * QK_COLS + V_COLS

SSM_GROUP = 16
SSM_NGROUPS = D_MODEL // SSM_GROUP
SSM_STATE = 64
STEP_MIN = 0.001
STEP_MAX = 0.1

D_FF = 5632
CONV_W = 3

EPS = 1e-6

kernel_name = "hybrid_dilated_attn_s5_convffn_adaln"


def rms_norm(x, g):
    xf = x.astype(jnp.float32)
    y = xf * lax.rsqrt(jnp.mean(xf * xf, axis=-1, keepdims=True) + EPS)
    return (y * g.astype(jnp.float32)).astype(x.dtype)


def alibi_slopes():
    return 2.0 ** (-8.0 * jnp.arange(1, N_HEADS + 1, dtype=jnp.float32) / N_HEADS)


def dilated_branch(q, k, v, window, dilation):
    B, T, H, dh = q.shape
    blk = ATTN_BLOCK
    span = window // dilation
    L = -(-T // dilation)
    nb = -(-L // blk)
    Lp = nb * blk
    Tp = Lp * dilation

    def to_classes(a):
        a = jnp.pad(a, ((0, 0), (0, Tp - T), (0, 0), (0, 0)))
        a = a.reshape(B, Lp, dilation, H, dh).transpose(0, 2, 1, 3, 4)
        return a.reshape(B, dilation, nb, blk, H, dh)

    def with_prev(a):
        prev = jnp.pad(a, ((0, 0), (0, 0), (1, 0), (0, 0), (0, 0), (0, 0)))[:, :, :-1]
        return jnp.concatenate([prev, a], axis=3)

    qb = to_classes(q)
    kk = with_prev(to_classes(k))
    vv = with_prev(to_classes(v))

    s = jnp.einsum('brnqhc,brnkhc->brnhqk', qb, kk,
                   preferred_element_type=jnp.float32) * (HEAD_DIM ** -0.5)
    qi = jnp.arange(blk)[:, None]
    kj = jnp.arange(2 * blk)[None, :]
    dist = blk + qi - kj
    nidx = jnp.arange(nb)[:, None, None]
    valid = (dist >= 0) & (dist <= span) & (nidx * blk + kj - blk >= 0)
    bias = -alibi_slopes()[:, None, None] * (dist * dilation).astype(jnp.float32)
    s = jnp.where(valid[:, None], s + bias, -jnp.inf)
    m = jnp.max(s, axis=-1, keepdims=True)
    e = jnp.exp(s - m)
    den = jnp.sum(e, axis=-1, keepdims=True)
    lse = (m + jnp.log(den))[..., 0]
    p = e / den
    o = jnp.einsum('brnhqk,brnkhc->brnqhc', p, vv.astype(jnp.float32))
    o = o.reshape(B, dilation, Lp, H, dh).transpose(0, 2, 1, 3, 4).reshape(B, Tp, H, dh)[:, :T]
    lse = lse.transpose(0, 1, 2, 4, 3).reshape(B, dilation, Lp, H).transpose(0, 2, 1, 3)
    lse = lse.reshape(B, Tp, H)[:, :T]
    return o, lse


def dilated_attention(h, w_in, w_out):
    B, T, _ = h.shape
    proj = h @ w_in
    q, k, v = jnp.split(proj, [QK_COLS, 2 * QK_COLS], axis=-1)
    q = q.reshape(B, T, N_DGROUPS, N_HEADS, HEAD_DIM)
    k = k.reshape(B, T, N_DGROUPS, N_HEADS, HEAD_DIM)
    v = v.reshape(B, T, N_HEADS, HEAD_DIM)
    outs, lses = [], []
    for g, (window, dilation) in enumerate(DILATED_GROUPS):
        o, l = dilated_branch(q[:, :, g], k[:, :, g], v, window, dilation)
        outs.append(o)
        lses.append(l)
    wts = jax.nn.softmax(jnp.stack(lses, axis=0), axis=0)
    o = sum(wts[g][..., None] * outs[g] for g in range(N_DGROUPS))
    return o.reshape(B, T, V_COLS).astype(h.dtype) @ w_out


def _ssm_combine(left, right):
    a1r, a1i, b1r, b1i = left
    a2r, a2i, b2r, b2i = right
    return (a2r * a1r - a2i * a1i,
            a2r * a1i + a2i * a1r,
            a2r * b1r - a2i * b1i + b2r,
            a2r * b1i + a2i * b1r + b2i)


def _s5_core(ug, lb_re, lb_im, bb_re, bb_im, c_re, c_im):
    T = ug.shape[0]
    bu_re = jnp.einsum('tgc,gpc->tgp', ug, bb_re)
    bu_im = jnp.einsum('tgc,gpc->tgp', ug, bb_im)
    ar = jnp.broadcast_to(lb_re, (T,) + lb_re.shape)
    ai = jnp.broadcast_to(lb_im, (T,) + lb_im.shape)
    _, _, xr, xi = lax.associative_scan(_ssm_combine, (ar, ai, bu_re, bu_im), axis=0)
    return jnp.einsum('tgp,gcp->tgc', xr, c_re) - jnp.einsum('tgp,gcp->tgc', xi, c_im)


def s5_mixer(h, w_in, log_step, a_re, a_im, b_re, b_im, c_re, c_im, d_skip, w_gate, w_out):
    B, T, _ = h.shape
    f32 = jnp.float32
    u = (h @ w_in).astype(f32)
    ug = u.reshape(B, T, SSM_NGROUPS, SSM_GROUP)
    step = jnp.exp(log_step.astype(f32))[:, None]
    lr, li = a_re.astype(f32), a_im.astype(f32)
    mag = jnp.exp(lr * step)
    ang = li * step
    lb_re = mag * jnp.cos(ang)
    lb_im = mag * jnp.sin(ang)
    nr, ni = lb_re - 1.0, lb_im
    den = lr * lr + li * li
    coef_re = ((nr * lr + ni * li) / den)[..., None]
    coef_im = ((ni * lr - nr * li) / den)[..., None]
    br, bi = b_re.astype(f32), b_im.astype(f32)
    bb_re = coef_re * br - coef_im * bi
    bb_im = coef_re * bi + coef_im * br
    cr, ci = c_re.astype(f32), c_im.astype(f32)
    y = lax.map(lambda us: _s5_core(us, lb_re, lb_im, bb_re, bb_im, cr, ci), ug)
    y = y.reshape(B, T, D_MODEL) + d_skip.astype(f32) * u
    g = jax.nn.gelu(y).astype(h.dtype)
    g = g * jax.nn.sigmoid(g @ w_gate)
    return g @ w_out


def conv_ffn(h, w_up, conv_w, conv_b, w_down):
    T = h.shape[1]
    a = h @ w_up
    ap = jnp.pad(a, ((0, 0), (CONV_W - 1, 0), (0, 0)))
    a = conv_b + sum(conv_w[j] * ap[:, j:j + T] for j in range(CONV_W))
    gate, up = jnp.split(a, 2, axis=-1)
    return (jax.nn.silu(gate) * up) @ w_down


def setup_inputs(seed: int = 0) -> dict:
    key = jax.random.key(seed)
    ks = iter(jax.random.split(key, 32))
    f32 = jnp.float32

    def nrm(shape, std):
        return std * jax.random.normal(next(ks), shape, f32)

    D, F, G, P, C = D_MODEL, D_FF, SSM_NGROUPS, SSM_STATE, SSM_GROUP
    NA, NB = N_ATTN_LAYERS, N_SSM_LAYERS
    x = nrm((BATCH, SEQ, D), 1.0)
    c = nrm((BATCH, D), 1.0)
    ada_w = nrm((DEPTH, D, 6 * D), 0.3 * D ** -0.5)
    ada_b = nrm((DEPTH, 6 * D), 0.01)
    norm1_g = 1.0 + nrm((DEPTH, D), 0.05)
    norm2_g = 1.0 + nrm((DEPTH, D), 0.05)
    attn_w_in = nrm((NA, D, ATTN_IN_COLS), D ** -0.5)
    attn_w_out = nrm((NA, V_COLS, D), V_COLS ** -0.5)
    ssm_w_in = nrm((NB, D, D), D ** -0.5)
    ssm_log_step = jax.random.uniform(next(ks), (NB, G), f32,
                                      minval=math.log(STEP_MIN), maxval=math.log(STEP_MAX))
    ssm_a_re = -0.5 * jnp.exp(nrm((NB, G, P), 0.05))
    ssm_a_im = jnp.pi * jnp.arange(P, dtype=f32) + nrm((NB, G, P), 0.01)
    ssm_b_re = nrm((NB, G, P, C), (2.0 * C) ** -0.5)
    ssm_b_im = nrm((NB, G, P, C), (2.0 * C) ** -0.5)
    ssm_c_re = nrm((NB, G, C, P), P ** -0.5)
    ssm_c_im = nrm((NB, G, C, P), P ** -0.5)
    ssm_d = nrm((NB, D), 0.5)
    ssm_w_gate = nrm((NB, D, D), D ** -0.5)
    ssm_w_out = nrm((NB, D, D), D ** -0.5)
    ffn_w_up = nrm((DEPTH, D, 2 * F), D ** -0.5)
    ffn_conv_w = nrm((DEPTH, CONV_W, 2 * F), CONV_W ** -0.5)
    ffn_conv_b = nrm((DEPTH, 2 * F), 0.01)
    ffn_w_down = nrm((DEPTH, F, D), F ** -0.5)
    final_norm_g = 1.0 + nrm((D,), 0.05)
    return {"x": x, "c": c, "ada_w": ada_w, "ada_b": ada_b,
            "norm1_g": norm1_g, "norm2_g": norm2_g,
            "attn_w_in": attn_w_in, "attn_w_out": attn_w_out,
            "ssm_w_in": ssm_w_in, "ssm_log_step": ssm_log_step,
            "ssm_a_re": ssm_a_re, "ssm_a_im": ssm_a_im,
            "ssm_b_re": ssm_b_re, "ssm_b_im": ssm_b_im,
            "ssm_c_re": ssm_c_re, "ssm_c_im": ssm_c_im,
            "ssm_d": ssm_d, "ssm_w_gate": ssm_w_gate, "ssm_w_out": ssm_w_out,
            "ffn_w_up": ffn_w_up, "ffn_conv_w": ffn_conv_w, "ffn_conv_b": ffn_conv_b,
            "ffn_w_down": ffn_w_down, "final_norm_g": final_norm_g}


def reference(x, c, ada_w, ada_b, norm1_g, norm2_g, attn_w_in, attn_w_out,
              ssm_w_in, ssm_log_step, ssm_a_re, ssm_a_im, ssm_b_re, ssm_b_im,
              ssm_c_re, ssm_c_im, ssm_d, ssm_w_gate, ssm_w_out,
              ffn_w_up, ffn_conv_w, ffn_conv_b, ffn_w_down, final_norm_g):
    cs = jax.nn.silu(c)
    for i in range(DEPTH):
        j = i // N_MIXERS
        mod = (cs @ ada_w[i] + ada_b[i])[:, None, :]
        sh1, sc1, g1, sh2, sc2, g2 = jnp.split(mod, 6, axis=-1)
        h = rms_norm(x, norm1_g[i]) * (1.0 + sc1) + sh1
        if i % N_MIXERS == 0:
            mix = dilated_attention(h, attn_w_in[j], attn_w_out[j])
        else:
            mix = s5_mixer(h, ssm_w_in[j], ssm_log_step[j], ssm_a_re[j], ssm_a_im[j],
                           ssm_b_re[j], ssm_b_im[j], ssm_c_re[j], ssm_c_im[j],
                           ssm_d[j], ssm_w_gate[j], ssm_w_out[j])
        x = x + g1 * mix
        h = rms_norm(x, norm2_g[i]) * (1.0 + sc2) + sh2
        x = x + g2 * conv_ffn(h, ffn_w_up[i], ffn_conv_w[i], ffn_conv_b[i], ffn_w_down[i])
    return rms_norm(x, final_norm_g)
```

```cpp
#include <hip/hip_runtime.h>
#include <cstdio>
#include <cstdint>

#ifndef MK_ONE_LAUNCH
#define MK_ONE_LAUNCH 1
#endif
#ifndef MK_DEBUG_CHECKS
#define MK_DEBUG_CHECKS 0
#endif
#ifndef MK_DEBUG_NOTAPS
#define MK_DEBUG_NOTAPS 0
#endif

constexpr int BATCH = 16, T = 2048, D = 2048, M = BATCH * T, DEPTH = 4;
constexpr int NH = 16, HD = 128, QK_COLS = 3 * NH * HD, V_COLS = NH * HD, AIN = 2 * QK_COLS + V_COLS;
constexpr int SG = 16, NG = D / SG, SP = 64;
constexpr int FF = 5632, FF2 = 2 * FF;
constexpr int MODW = 6 * D;
constexpr float EPS = 1e-6f;

namespace pg8 {
#define PG8_LAS __attribute__((address_space(3)))
typedef unsigned short bf16_t;
typedef short bf16x8 __attribute__((ext_vector_type(8)));
typedef float f32x4 __attribute__((ext_vector_type(4)));
typedef unsigned u32x4 __attribute__((ext_vector_type(4)));
typedef unsigned u32x2 __attribute__((ext_vector_type(2)));
constexpr int BM = 256, BK = 64, HALF = 128, HTB = HALF * BK * 2  , STAGE_BYTES = 8 * HTB, NXCD = 8, WGM = 8;

__host__ __device__ __forceinline__ int lds_byte(int r, int c) { const int st = (r >> 4) * 2 + (c >> 5), rr = r & 15, cc = c & 31, ob = rr * 64 + cc * 2; return st * 1024 + (ob ^ (((ob >> 9) & 1) << 5)); }
__host__ __device__ __forceinline__ void stage_rc(int b, int& R, int& C) { const int st = b / 1024, sb = b % 1024, swz = sb ^ (((sb >> 9) & 1) << 5); R = (st >> 1) * 16 + swz / 64; C = (st & 1) * 32 + (swz % 64) / 2; }
__host__ __device__ __forceinline__ int perm32(int rho) { const int n = rho >> 4, i = rho & 15; return 8 * (i >> 2) + 4 * n + (i & 3); }

__device__ __forceinline__ int opaque_tid() { int t = (int)threadIdx.x; asm volatile("" : "+v"(t)); return t; }
__device__ __forceinline__ int opaque_bid() { int t = (int)blockIdx.x; asm volatile("" : "+s"(t)); return t; }
struct Unit { int pm, pn; };
struct Gemm { const bf16_t* A; const bf16_t* Bt; int M, N, K; };

struct StaticOrder {
    int nM, nN, nwg, G, c;
    __host__ __device__ void init(int M_, int N_, int G_, int c_) { nM = M_ / BM; nN = N_ / BM; nwg = nM * nN; G = G_; c = c_; }
    __host__ __device__ bool next(int i, Unit& u) const {
        const long L = (long)i * G + c; if (L >= nwg) return false;
        int wgid = (int)L; { const int q = nwg / NXCD, r = nwg % NXCD, xcd = wgid % NXCD, off = wgid / NXCD; wgid = (xcd < r ? xcd * (q + 1) : r * (q + 1) + (xcd - r) * q) + off; }
        const int nig = WGM * nN, gid = wgid / nig, fm = gid * WGM, gsz = (nM - fm) < WGM ? (nM - fm) : WGM;
        u.pm = fm + ((wgid % nig) % gsz); u.pn = (wgid % nig) / gsz; return true;
    }
    __device__ __forceinline__ void a_ready(const Unit&) const {}
    __device__ __forceinline__ void done(const Unit&) const {}
};

__device__ __forceinline__ unsigned cvt_pk_bf16(float lo, float hi) { unsigned r; asm volatile("v_cvt_pk_bf16_f32 %0, %1, %2" : "=v"(r) : "v"(lo), "v"(hi)); return r; }
__device__ __forceinline__ float bf_lo(unsigned w) { return __uint_as_float(w << 16); }
__device__ __forceinline__ float bf_hi(unsigned w) { return __uint_as_float(w & 0xffff0000u); }
__device__ __forceinline__ float fast_sigmoid(float v) { return __builtin_amdgcn_rcpf(1.0f + __builtin_amdgcn_exp2f(-1.4426950408889634f * v)); }

struct EpiBf16 {
    static constexpr bool PERM = true, AFTER_DRAIN = false;
    bf16_t* O; int ldc;
    __device__ __forceinline__ void operator()(const f32x4 (&acc)[2][2][4][2], const Unit& u, int wr, int wc, int fr, int fq) const {
        const int row0 = u.pm * BM + wr * 64 + fr, col0 = u.pn * BM + wc * 32 + 8 * fq;
#pragma unroll
        for (int ai = 0; ai < 2; ++ai)
#pragma unroll
            for (int m = 0; m < 4; ++m) { bf16_t* rowp = O + (size_t)(row0 + ai * HALF + m * 16) * ldc + col0;
#pragma unroll
                for (int bj = 0; bj < 2; ++bj) { const f32x4 v0 = acc[ai][bj][m][0], v1 = acc[ai][bj][m][1];
                    u32x4 w; w.x = cvt_pk_bf16(v0[0], v0[1]); w.y = cvt_pk_bf16(v0[2], v0[3]); w.z = cvt_pk_bf16(v1[0], v1[1]); w.w = cvt_pk_bf16(v1[2], v1[3]);
                    *(u32x4*)(rowp + bj * HALF) = w; } }
    }
};
struct EpiGateRes {
    static constexpr bool PERM = false, AFTER_DRAIN = false;
    const float* base; float* out; const float* gate;
    __device__ __forceinline__ void operator()(const f32x4 (&acc)[2][2][4][2], const Unit& u, int wr, int wc, int fr, int fq) const {
        const int row0 = u.pm * BM + wr * 64 + fr, col0 = u.pn * BM + wc * 32 + 4 * fq;
        const float* gp = gate + (size_t)(u.pm >> 3) * MODW + col0;
        f32x4 gv[2][2];
#pragma unroll
        for (int bj = 0; bj < 2; ++bj)
#pragma unroll
            for (int n = 0; n < 2; ++n) gv[bj][n] = *(const f32x4*)(gp + bj * HALF + n * 16);
#pragma unroll
        for (int ai = 0; ai < 2; ++ai)
#pragma unroll
            for (int m = 0; m < 4; ++m) { const size_t off = (size_t)(row0 + ai * HALF + m * 16) * D + col0;
#pragma unroll
                for (int bj = 0; bj < 2; ++bj)
#pragma unroll
                    for (int n = 0; n < 2; ++n) { const f32x4 bs = *(const f32x4*)(base + off + bj * HALF + n * 16);
                        *(f32x4*)(out + off + bj * HALF + n * 16) = bs + gv[bj][n] * acc[ai][bj][m][n]; }
                asm volatile("" ::: "memory"); }
    }
};
struct EpiSigGate {
    static constexpr bool PERM = true, AFTER_DRAIN = false;
    const bf16_t* gsrc; bf16_t* O;
    __device__ __forceinline__ void operator()(const f32x4 (&acc)[2][2][4][2], const Unit& u, int wr, int wc, int fr, int fq) const {
        const int row0 = u.pm * BM + wr * 64 + fr, col0 = u.pn * BM + wc * 32 + 8 * fq;
#pragma unroll
        for (int ai = 0; ai < 2; ++ai)
#pragma unroll
            for (int m = 0; m < 4; ++m) { const size_t off = (size_t)(row0 + ai * HALF + m * 16) * D + col0;
#pragma unroll
                for (int bj = 0; bj < 2; ++bj) { const f32x4 v0 = acc[ai][bj][m][0], v1 = acc[ai][bj][m][1];
                    const u32x4 g = *(const u32x4*)(gsrc + off + bj * HALF);
                    u32x4 w;
                    w.x = cvt_pk_bf16(bf_lo(g.x) * fast_sigmoid(v0[0]), bf_hi(g.x) * fast_sigmoid(v0[1]));
                    w.y = cvt_pk_bf16(bf_lo(g.y) * fast_sigmoid(v0[2]), bf_hi(g.y) * fast_sigmoid(v0[3]));
                    w.z = cvt_pk_bf16(bf_lo(g.z) * fast_sigmoid(v1[0]), bf_hi(g.z) * fast_sigmoid(v1[1]));
                    w.w = cvt_pk_bf16(bf_lo(g.w) * fast_sigmoid(v1[2]), bf_hi(g.w) * fast_sigmoid(v1[3]));
                    *(u32x4*)(O + off + bj * HALF) = w; }
                asm volatile("" ::: "memory"); }
    }
};
template <int CTRL> __device__ __forceinline__ float dpp_ror(float v) { return __int_as_float(__builtin_amdgcn_update_dpp(0, __float_as_int(v), CTRL, 0xf, 0xf, false)); }
struct EpiConvGate {
    static constexpr bool PERM = true, AFTER_DRAIN = false;
    bf16_t* O; float* raw; const float* cw; const float* cb; PG8_LAS unsigned char* xlds;
    __device__ __forceinline__ void operator()(const f32x4 (&acc)[2][2][4][2], const Unit& u, int wr, int wc, int fr, int fq) const {
        const int wid = wr * 4 + wc;
        PG8_LAS f32x4* ex = (PG8_LAS f32x4*)xlds;
        if (fr >= 14) {
#pragma unroll
            for (int ai = 0; ai < 2; ++ai)
#pragma unroll
                for (int bj = 0; bj < 2; ++bj)
#pragma unroll
                    for (int n = 0; n < 2; ++n) ex[((((wid * 2 + ai) * 2 + bj) * 2 + n) * 4 + fq) * 2 + (fr - 14)] = acc[ai][bj][3][n];
        }
        asm volatile("s_waitcnt lgkmcnt(0)" ::: "memory"); __builtin_amdgcn_s_barrier(); asm volatile("" ::: "memory");
        const int gcol0 = u.pn * HALF + wc * 32 + 8 * fq;
        const int row0 = u.pm * BM + wr * 64 + fr;
        if (wr == 0 && fr < 2) {
#pragma unroll
            for (int bj = 0; bj < 2; ++bj)
#pragma unroll
                for (int n = 0; n < 2; ++n) *(f32x4*)(raw + ((size_t)u.pm * 4 + fr) * FF2 + bj * FF + gcol0 + 4 * n) = acc[0][bj][0][n];
        }
        if (wr == 1 && fr >= 14) {
#pragma unroll
            for (int bj = 0; bj < 2; ++bj)
#pragma unroll
                for (int n = 0; n < 2; ++n) *(f32x4*)(raw + ((size_t)u.pm * 4 + 2 + (fr - 14)) * FF2 + bj * FF + gcol0 + 4 * n) = acc[1][bj][3][n];
        }
        unsigned outpk[2][4][2];
#pragma unroll
        for (int n = 0; n < 2; ++n) {
            const int gc = gcol0 + 4 * n;
            const f32x4 wg0 = *(const f32x4*)(cw + gc), wg1 = *(const f32x4*)(cw + FF2 + gc), wg2 = *(const f32x4*)(cw + 2 * FF2 + gc), bg = *(const f32x4*)(cb + gc);
            const f32x4 wu0 = *(const f32x4*)(cw + FF + gc), wu1 = *(const f32x4*)(cw + FF2 + FF + gc), wu2 = *(const f32x4*)(cw + 2 * FF2 + FF + gc), bu = *(const f32x4*)(cb + FF + gc);
#pragma unroll
            for (int ai = 0; ai < 2; ++ai) {
                f32x4 pg = (f32x4){0.f, 0.f, 0.f, 0.f}, pu = (f32x4){0.f, 0.f, 0.f, 0.f};
                if (!(ai == 0 && wr == 0) && fr >= 14) {
                    const int sw = (wr == 1) ? wc : 4 + wc, sai = (wr == 1) ? ai : 0;
                    pg = ex[((((sw * 2 + sai) * 2 + 0) * 2 + n) * 4 + fq) * 2 + (fr - 14)];
                    pu = ex[((((sw * 2 + sai) * 2 + 1) * 2 + n) * 4 + fq) * 2 + (fr - 14)];
                }
#pragma unroll
                for (int m = 0; m < 4; ++m) {
                    const f32x4 cg = acc[ai][0][m][n], cu = acc[ai][1][m][n];
                    float o[4];
#pragma unroll
                    for (int e = 0; e < 4; ++e) {
                        const float pg1 = dpp_ror<0x121>(pg[e]), cg1 = dpp_ror<0x121>(cg[e]), pg2 = dpp_ror<0x122>(pg[e]), cg2 = dpp_ror<0x122>(cg[e]);
                        const float pu1 = dpp_ror<0x121>(pu[e]), cu1 = dpp_ror<0x121>(cu[e]), pu2 = dpp_ror<0x122>(pu[e]), cu2 = dpp_ror<0x122>(cu[e]);
                        const float g1 = (fr == 0) ? pg1 : cg1, g2 = (fr < 2) ? pg2 : cg2, u1 = (fr == 0) ? pu1 : cu1, u2 = (fr < 2) ? pu2 : cu2;
#if MK_DEBUG_NOTAPS
                        const float gg = bg[e] + wg2[e] * cg[e] + 0.f * (g1 + g2);
                        const float uu = bu[e] + wu2[e] * cu[e] + 0.f * (u1 + u2);
#else
                        const float gg = bg[e] + wg2[e] * cg[e] + wg1[e] * g1 + wg0[e] * g2;
                        const float uu = bu[e] + wu2[e] * cu[e] + wu1[e] * u1 + wu0[e] * u2;
#endif
                        o[e] = gg * fast_sigmoid(gg) * uu;
                    }
                    const unsigned p0 = cvt_pk_bf16(o[0], o[1]), p1 = cvt_pk_bf16(o[2], o[3]);
                    if (n == 0) { outpk[ai][m][0] = p0; outpk[ai][m][1] = p1; }
                    else { u32x4 w; w.x = outpk[ai][m][0]; w.y = outpk[ai][m][1]; w.z = p0; w.w = p1;
                        *(u32x4*)(O + (size_t)(row0 + ai * HALF + m * 16) * FF + gcol0) = w; }
                    pg = cg; pu = cu;
                }
            }
        }
    }
};

template <class Epi, class Sched, bool ALIGN_EPI = false, bool SP2 = false>
__device__ __forceinline__ void gemm_phase(PG8_LAS unsigned char* lds, const Gemm g, const Sched& S, const Epi& E) {
    const int tid = opaque_tid(), wid = __builtin_amdgcn_readfirstlane(tid >> 6), lane = tid & 63, wr = wid >> 2, wc = wid & 3, fr = lane & 15, fq = lane >> 4;
    const int K = g.K, nt = K / BK;
    unsigned voffA[2], voffB[2];
#pragma unroll
    for (int i = 0; i < 2; ++i) { int R, C; stage_rc(tid * 16 + i * 8192, R, C); const int Rb = Epi::PERM ? ((R & ~31) + perm32(R & 31)) : R;
        voffA[i] = (unsigned)(R * K + C) * 2u; voffB[i] = (unsigned)(Rb * K + C) * 2u; }
    const size_t kstep = (size_t)(BK * 2);
    const size_t hstep = (size_t)HALF * K * 2;
    const size_t tstep = 2 * hstep;
    const unsigned ldsw = (unsigned)wid * 1024u;
    const int aoff = lds_byte(wr * 64 + fr, fq * 8), boff = lds_byte(wc * 32 + fr, fq * 8);
#define PG8_SA(b, h) (((b) * 2 + (h)) * HTB)
#define PG8_SB(b, h) ((4 + (b) * 2 + (h)) * HTB)
#define PG8_STAGE(bufoff, gbase, voff) do { _Pragma("unroll") for (int _i = 0; _i < 2; ++_i) \
        __builtin_amdgcn_global_load_lds((const unsigned*)((const char*)(gbase) + (voff)[_i]), (PG8_LAS unsigned*)(lds + (bufoff) + ldsw + _i * 8192), 16, 0, 0); } while (0)
#define PG8_LDA(dst, b, h) do { _Pragma("unroll") for (int m = 0; m < 4; ++m) _Pragma("unroll") for (int k = 0; k < 2; ++k) dst[m][k] = *(const PG8_LAS bf16x8*)(lds + PG8_SA(b, h) + aoff + m * 2048 + k * 1024); } while (0)
#define PG8_LDB(dst, b, h) do { _Pragma("unroll") for (int n = 0; n < 2; ++n) _Pragma("unroll") for (int k = 0; k < 2; ++k) dst[n][k] = *(const PG8_LAS bf16x8*)(lds + PG8_SB(b, h) + boff + n * 2048 + k * 1024); } while (0)
#define PG8_MMA(ai, bj, At, Bt) do { __builtin_amdgcn_s_setprio(1); _Pragma("unroll") for (int m = 0; m < 4; ++m) _Pragma("unroll") for (int n = 0; n < 2; ++n) _Pragma("unroll") for (int k = 0; k < 2; ++k) \
        acc[ai][bj][m][n] = __builtin_amdgcn_mfma_f32_16x16x32_bf16(Bt[n][k], At[m][k], acc[ai][bj][m][n], 0, 0, 0); __builtin_amdgcn_s_setprio(0); } while (0)
#define PG8_WAIT_V(n) asm volatile("s_waitcnt vmcnt(" #n ")" ::: "memory")
#define PG8_WAIT_L(n) asm volatile("s_waitcnt lgkmcnt(" #n ")" ::: "memory")
#define PG8_BAR __builtin_amdgcn_s_barrier()
#define PG8_SCHED __builtin_amdgcn_sched_barrier(0)
    Unit cur, nxt; int ui = 0;
    if (!S.next(0, cur)) return;
    f32x4 acc[2][2][4][2];
#pragma unroll
    for (int a = 0; a < 2; ++a)
#pragma unroll
        for (int b = 0; b < 2; ++b)
#pragma unroll
            for (int m = 0; m < 4; ++m)
#pragma unroll
                for (int n = 0; n < 2; ++n) acc[a][b][m][n] = (f32x4){0.f, 0.f, 0.f, 0.f};
    bf16x8 At[4][2], B0[2][2], B1[2][2];
    const char* cA = (const char*)g.A + (size_t)cur.pm * tstep; const char* cB = (const char*)g.Bt + (size_t)cur.pn * tstep;
    S.a_ready(cur);
    if constexpr (SP2) {
        PG8_STAGE(PG8_SB(0, 0), cB, voffB); PG8_STAGE(PG8_SB(0, 1), cB + hstep, voffB); PG8_STAGE(PG8_SA(0, 0), cA, voffA); PG8_STAGE(PG8_SA(0, 1), cA + hstep, voffA);
        if (wr == 1) PG8_BAR;
        PG8_WAIT_V(2); PG8_BAR;
        PG8_STAGE(PG8_SB(1, 0), cB + kstep, voffB); PG8_STAGE(PG8_SA(1, 0), cA + kstep, voffA); PG8_STAGE(PG8_SB(1, 1), cB + hstep + kstep, voffB);
        PG8_WAIT_V(6); PG8_BAR;
    } else {
        PG8_STAGE(PG8_SB(0, 0), cB, voffB); PG8_STAGE(PG8_SA(0, 0), cA, voffA); PG8_STAGE(PG8_SB(0, 1), cB + hstep, voffB); PG8_STAGE(PG8_SA(0, 1), cA + hstep, voffA);
        if (wr == 1) PG8_BAR;
        PG8_WAIT_V(4); PG8_BAR;
        PG8_STAGE(PG8_SB(1, 0), cB + kstep, voffB); PG8_STAGE(PG8_SA(1, 0), cA + kstep, voffA); PG8_STAGE(PG8_SB(1, 1), cB + hstep + kstep, voffB);
        PG8_WAIT_V(6); PG8_BAR;
    }
    for (;;) {
        const bool has_next = S.next(ui + 1, nxt);
        const char* nA = has_next ? (const char*)g.A + (size_t)nxt.pm * tstep : cA; const char* nB = has_next ? (const char*)g.Bt + (size_t)nxt.pn * tstep : cB;
        for (int t = 0; t < nt; t += 2) {
            const bool last = (t == nt - 2);
            const char* a1 = cA + (size_t)(t + 1) * kstep;
            const char* a2 = last ? nA : cA + (size_t)(t + 2) * kstep; const char* b2 = last ? nB : cB + (size_t)(t + 2) * kstep;
            const char* a3 = a2 + kstep; const char* b3 = b2 + kstep;
            if (last && has_next) S.a_ready(nxt);
            if constexpr (SP2) {
            PG8_LDB(B0, 0, 0); PG8_LDB(B1, 0, 1); PG8_SCHED; PG8_LDA(At, 0, 0); PG8_STAGE(PG8_SA(1, 1), a1 + hstep, voffA);
            PG8_WAIT_V(8); PG8_WAIT_L(0); PG8_BAR; PG8_MMA(0, 0, At, B0); PG8_MMA(0, 1, At, B1); PG8_BAR; PG8_SCHED;
            PG8_LDA(At, 0, 1); PG8_STAGE(PG8_SB(0, 0), b2, voffB); PG8_STAGE(PG8_SB(0, 1), b2 + hstep, voffB); PG8_STAGE(PG8_SA(0, 0), a2, voffA);
            PG8_WAIT_V(8); PG8_WAIT_L(0); PG8_BAR; PG8_MMA(1, 0, At, B0); PG8_MMA(1, 1, At, B1); PG8_BAR; PG8_SCHED;
            PG8_LDB(B0, 1, 0); PG8_LDB(B1, 1, 1); PG8_SCHED; PG8_LDA(At, 1, 0); PG8_STAGE(PG8_SA(0, 1), a2 + hstep, voffA);
            PG8_WAIT_V(8); PG8_WAIT_L(0); PG8_BAR; PG8_MMA(0, 0, At, B0); PG8_MMA(0, 1, At, B1); PG8_BAR; PG8_SCHED;
            PG8_LDA(At, 1, 1); PG8_STAGE(PG8_SB(1, 0), b3, voffB); PG8_STAGE(PG8_SB(1, 1), b3 + hstep, voffB); PG8_STAGE(PG8_SA(1, 0), a3, voffA);
            PG8_WAIT_V(8); PG8_WAIT_L(0); PG8_BAR; PG8_MMA(1, 0, At, B0); PG8_MMA(1, 1, At, B1); PG8_BAR; PG8_SCHED;
            } else {
            PG8_LDB(B0, 0, 0); PG8_SCHED; PG8_LDA(At, 0, 0); PG8_STAGE(PG8_SA(1, 1), a1 + hstep, voffA);
            PG8_WAIT_L(8); PG8_BAR; PG8_WAIT_L(0); PG8_MMA(0, 0, At, B0); PG8_BAR; PG8_SCHED;
            PG8_LDB(B1, 0, 1); PG8_STAGE(PG8_SB(0, 0), b2, voffB);
            PG8_BAR; PG8_WAIT_L(0); PG8_MMA(0, 1, At, B1); PG8_BAR;
            PG8_LDA(At, 0, 1); PG8_STAGE(PG8_SA(0, 0), a2, voffA);
            PG8_BAR; PG8_WAIT_L(0); PG8_MMA(1, 0, At, B0); PG8_BAR; PG8_SCHED;
            PG8_STAGE(PG8_SB(0, 1), b2 + hstep, voffB);
            PG8_WAIT_V(6); PG8_BAR; PG8_MMA(1, 1, At, B1); PG8_BAR;
            PG8_LDB(B0, 1, 0); PG8_SCHED; PG8_LDA(At, 1, 0); PG8_STAGE(PG8_SA(0, 1), a2 + hstep, voffA);
            PG8_WAIT_L(8); PG8_BAR; PG8_WAIT_L(0); PG8_MMA(0, 0, At, B0); PG8_BAR; PG8_SCHED;
            PG8_LDB(B1, 1, 1); PG8_STAGE(PG8_SB(1, 0), b3, voffB);
            PG8_BAR; PG8_WAIT_L(0); PG8_MMA(0, 1, At, B1); PG8_BAR;
            PG8_LDA(At, 1, 1); PG8_STAGE(PG8_SA(1, 0), a3, voffA);
            PG8_BAR; PG8_WAIT_L(0); PG8_MMA(1, 0, At, B0); PG8_BAR; PG8_SCHED;
            PG8_STAGE(PG8_SB(1, 1), b3 + hstep, voffB);
            PG8_WAIT_V(6); PG8_BAR; PG8_MMA(1, 1, At, B1); PG8_BAR;
            }
        }
        if constexpr (ALIGN_EPI) { if (wr == 0) PG8_BAR; }
        if constexpr (!Epi::AFTER_DRAIN) { E(acc, cur, wr, wc, fr, fq); S.done(cur); }
        if (!has_next) break;
#pragma unroll
        for (int a = 0; a < 2; ++a)
#pragma unroll
            for (int b = 0; b < 2; ++b)
#pragma unroll
                for (int m = 0; m < 4; ++m)
#pragma unroll
                    for (int n = 0; n < 2; ++n) acc[a][b][m][n] = (f32x4){0.f, 0.f, 0.f, 0.f};
        cur = nxt; cA = nA; cB = nB; ++ui;
        if constexpr (ALIGN_EPI) { if (wr == 1) PG8_BAR; }
    }
    PG8_WAIT_V(0);
    if constexpr (!ALIGN_EPI) { if (wr == 0) PG8_BAR; }
    PG8_BAR;
    if constexpr (Epi::AFTER_DRAIN) { E.fused(acc, cur, wr, wc, fr, fq, lds, wid, lane); S.done(cur); }
#undef PG8_SA
#undef PG8_SB
#undef PG8_STAGE
#undef PG8_LDA
#undef PG8_LDB
#undef PG8_MMA
#undef PG8_WAIT_V
#undef PG8_WAIT_L
#undef PG8_BAR
#undef PG8_SCHED
}
}

constexpr size_t MiB = 1u << 20;
constexpr size_t WS_CTL = 0, CTL_ZERO_BYTES = 1 * MiB;
constexpr size_t WS_MOD = 1 * MiB;
constexpr size_t WS_S5T = 4 * MiB;
constexpr size_t WS_LSE = 8 * MiB;
constexpr size_t WS_RAW = 12 * MiB;
constexpr size_t WS_WAIN = 40 * MiB, WS_WAOUT = 152 * MiB, WS_WSIN = 168 * MiB, WS_WSGATE = 184 * MiB, WS_WSOUT = 200 * MiB, WS_WUP = 216 * MiB, WS_WDOWN = 392 * MiB;
constexpr size_t WS_H = 480 * MiB;
constexpr size_t WS_BIG = 608 * MiB;
constexpr size_t WS_END = 1504 * MiB;
static_assert(WS_WAIN + 2 * (size_t)AIN * D * 2 == WS_WAOUT && WS_WAOUT + 2 * (size_t)D * D * 2 == WS_WSIN && WS_WUP + 4 * (size_t)FF2 * D * 2 == WS_WDOWN && WS_WDOWN + 4 * (size_t)D * FF * 2 == WS_H, "weight map");
static_assert(WS_H + (size_t)M * D * 2 == WS_BIG && WS_BIG + (size_t)M * AIN * 2 == WS_END && WS_RAW + (size_t)(M / 256) * 4 * FF2 * 4 <= WS_WAIN, "activation map");
constexpr int S5T_WORDS = 2304;
constexpr int CW_BAR = 4096;
constexpr int RING_OFF = 0, RING_BYTES = 131072;
constexpr int LDSCTL_OFF = RING_BYTES, MISC_OFF = LDSCTL_OFF + 320;
constexpr int EXCH_OFF = RING_BYTES + 1024;
constexpr int LDS_BYTES = 147456;
static_assert(EXCH_OFF + 8192 <= LDS_BYTES && MISC_OFF + 128 <= EXCH_OFF, "LDS map");
constexpr int NWAVES = 8;

#define LAS __attribute__((address_space(3)))
typedef unsigned short bf16;
typedef float f32x4 __attribute__((ext_vector_type(4)));
typedef float f32x2 __attribute__((ext_vector_type(2)));
typedef short bf16x8 __attribute__((ext_vector_type(8)));
typedef short s16x4 __attribute__((ext_vector_type(4)));
typedef unsigned u32x4 __attribute__((ext_vector_type(4)));
typedef unsigned u32x2 __attribute__((ext_vector_type(2)));
#define LDS_WAIT() asm volatile("s_waitcnt lgkmcnt(0)" ::: "memory")
#define VM_WAIT() asm volatile("s_waitcnt vmcnt(0)" ::: "memory")
__device__ __forceinline__ unsigned f2bf(float f) { unsigned u = __builtin_bit_cast(unsigned, f); return (u + 0x7fffu + ((u >> 16) & 1u)) >> 16; }
__device__ __forceinline__ unsigned pk2(float lo, float hi) { return f2bf(lo) | (f2bf(hi) << 16); }
using pg8::cvt_pk_bf16; using pg8::bf_lo; using pg8::bf_hi;

#define XB_TMO      128
#define XB_XCNT(j)  (256  + 64 * (j))
#define XB_XSUB(j)  (1280 + 64 * (j))
#define XB_XGEN(j)  (2304 + 64 * (j))
#define XB_TOP      3328
#define XB_TOPGEN   3392
#define XCD_BAR_WORDS 3456
#define XB_SPIN_CAP (1u << 18)

__device__ __forceinline__ unsigned xb_ld(unsigned* p)              { return __hip_atomic_load(p, __ATOMIC_RELAXED, __HIP_MEMORY_SCOPE_AGENT); }
__device__ __forceinline__ unsigned xb_add(unsigned* p, unsigned v) { return __hip_atomic_fetch_add(p, v, __ATOMIC_RELAXED, __HIP_MEMORY_SCOPE_AGENT); }
__device__ __forceinline__ unsigned xb_xcc_id() { return (unsigned)__builtin_amdgcn_s_getreg((3 << 11) | 20) & 0xFu; }
#define XB_SPIN(cond, bar) do { unsigned _sp = 0; while (cond) { __builtin_amdgcn_s_sleep(1); \
    if ((++_sp & 255u) == 0u) { if (xb_ld(&(bar)[XB_TMO])) break; if (_sp > XB_SPIN_CAP) { atomicAdd(&(bar)[XB_TMO], 1u); break; } } } } while (0)

struct XcdBarrier {
    unsigned* bar; unsigned x;
    volatile LAS unsigned* st;
};

__device__ __forceinline__ XcdBarrier xcd_barrier_post(unsigned* bar, volatile LAS unsigned* st) {
    XcdBarrier b; b.bar = bar; b.x = xb_xcc_id(); b.st = st;
    if (threadIdx.x == 0) (void)xb_add(&bar[XB_XCNT(b.x)], 1u);
    return b;
}
__device__ __forceinline__ void xcd_barrier_complete(unsigned* bar, unsigned x, unsigned& nloc, unsigned& nx) {
    const unsigned G = gridDim.x * gridDim.y * gridDim.z;
    unsigned sum, cnt, mine, sp = 0u;
    for (;;) {
        sum = 0u; cnt = 0u; mine = 0u;
#pragma unroll
        for (unsigned j = 0; j < 16; ++j) { const unsigned c = xb_ld(&bar[XB_XCNT(j)]); sum += c; cnt += (c > 0u) ? 1u : 0u; mine = (j == x) ? c : mine; }
        if (sum == G) break;
        __builtin_amdgcn_s_sleep(1);
        if ((++sp & 255u) == 0u) { if (xb_ld(&bar[XB_TMO])) break; if (sp > XB_SPIN_CAP) { atomicAdd(&bar[XB_TMO], 1u); break; } }
    }
    nloc = mine > 0u ? mine : 1u; nx = cnt > 0u ? cnt : 1u;
}

__device__ __forceinline__ void xcd_barrier(const XcdBarrier& b) {
    asm volatile("s_waitcnt vmcnt(0)" ::: "memory");
    __syncthreads();
    if (threadIdx.x == 0) {
        unsigned* bar = b.bar;
        __builtin_amdgcn_s_waitcnt(0);
        unsigned nloc = b.st[0], nx = b.st[1];
        if (nloc == 0u) { xcd_barrier_complete(bar, b.x, nloc, nx); b.st[0] = nloc; b.st[1] = nx; }
        const unsigned old = xb_add(&bar[XB_XSUB(b.x)], 1u);
        const unsigned gen = old / nloc;
        if (old + 1u == (gen + 1u) * nloc) {
            __builtin_amdgcn_fence(__ATOMIC_RELEASE, "agent");
            asm volatile("s_waitcnt vmcnt(0)" ::: "memory");
            const unsigned og = xb_add(&bar[XB_TOP], 1u);
            const unsigned tg = og / nx;
            if (og + 1u == (tg + 1u) * nx) xb_add(&bar[XB_TOPGEN], 1u);
            else XB_SPIN(xb_ld(&bar[XB_TOPGEN]) == tg, bar);
            __builtin_amdgcn_fence(__ATOMIC_ACQUIRE, "agent");
            xb_add(&bar[XB_XGEN(b.x)], 1u);
            asm volatile("s_waitcnt vmcnt(0)" ::: "memory");
        } else {
            XB_SPIN(xb_ld(&bar[XB_XGEN(b.x)]) == gen, bar);
            __builtin_amdgcn_fence(__ATOMIC_ACQUIRE, "agent");
            asm volatile("s_waitcnt vmcnt(0)" ::: "memory");
        }
    }
    __syncthreads();
}

struct Frame {
    LAS unsigned char* lds;
    volatile LAS unsigned* MISC;
    unsigned* ctl;
    int tid, lane, wave;
    int vcu, G;
    unsigned char* ws; float* out;
};
__device__ __forceinline__ void frame_refresh(Frame& F, unsigned char* ws, float* out) {
    asm volatile("" : "+s"(ws)); asm volatile("" : "+s"(out)); F.ws = ws; F.out = out; F.ctl = (unsigned*)(ws + WS_CTL);
    F.tid = pg8::opaque_tid(); F.lane = F.tid & 63; F.wave = __builtin_amdgcn_readfirstlane(F.tid >> 6);
    const int bx = pg8::opaque_bid(); F.vcu = (F.G % 8 == 0) ? (bx % 8) * (F.G / 8) + bx / 8 : bx;
}
template <int CTRL> __device__ __forceinline__ float dpp_mov(float v) { return __int_as_float(__builtin_amdgcn_update_dpp(0, __float_as_int(v), CTRL, 0xf, 0xf, false)); }
__device__ __forceinline__ float wave_sum(float v) {
    v += dpp_mov<0xB1>(v);
    v += dpp_mov<0x4E>(v);
    v += dpp_mov<0x141>(v);
    v += dpp_mov<0x140>(v);
    const float s0 = __int_as_float(__builtin_amdgcn_readlane(__float_as_int(v), 0)), s1 = __int_as_float(__builtin_amdgcn_readlane(__float_as_int(v), 16));
    const float s2 = __int_as_float(__builtin_amdgcn_readlane(__float_as_int(v), 32)), s3 = __int_as_float(__builtin_amdgcn_readlane(__float_as_int(v), 48));
    return (s0 + s1) + (s2 + s3);
}
__device__ __forceinline__ float xrow_max(float v) {
    { const auto r = __builtin_amdgcn_permlane16_swap(__float_as_uint(v), __float_as_uint(v), false, false); v = fmaxf(__uint_as_float(r[0]), __uint_as_float(r[1])); }
    { const auto r = __builtin_amdgcn_permlane32_swap(__float_as_uint(v), __float_as_uint(v), false, false); v = fmaxf(__uint_as_float(r[0]), __uint_as_float(r[1])); }
    return v;
}
__device__ __forceinline__ float xrow_sum(float v) {
    { const auto r = __builtin_amdgcn_permlane16_swap(__float_as_uint(v), __float_as_uint(v), false, false); v = __uint_as_float(r[0]) + __uint_as_float(r[1]); }
    { const auto r = __builtin_amdgcn_permlane32_swap(__float_as_uint(v), __float_as_uint(v), false, false); v = __uint_as_float(r[0]) + __uint_as_float(r[1]); }
    return v;
}

__device__ __forceinline__ void p0_transpose_item(const float* W, int K, int N, bf16* WT, int k0, int n0, int dst_row0, LAS float* scr, int lane) {
#pragma unroll 8
    for (int i = 0; i < 32; ++i) { const int kk = 2 * i + (lane >> 5); scr[kk * 33 + (lane & 31)] = W[(size_t)(k0 + kk) * N + n0 + (lane & 31)]; }
    LDS_WAIT(); asm volatile("" ::: "memory");
    const int c = lane & 7;
#pragma unroll
    for (int j = 0; j < 4; ++j) { const int n = (lane >> 3) + 8 * j; const LAS float* s = scr + (8 * c) * 33 + n;
        u32x4 o; o.x = pk2(s[0 * 33], s[1 * 33]); o.y = pk2(s[2 * 33], s[3 * 33]); o.z = pk2(s[4 * 33], s[5 * 33]); o.w = pk2(s[6 * 33], s[7 * 33]);
        *(u32x4*)(WT + (size_t)(dst_row0 + n) * K + k0 + 8 * c) = o; }
    LDS_WAIT(); asm volatile("" ::: "memory");
}
struct P0In { const float *c, *ada_w, *ada_b, *attn_w_in, *attn_w_out, *ssm_w_in, *log_step, *a_re, *a_im, *b_re, *b_im, *c_re, *c_im, *ssm_w_gate, *ssm_w_out, *ffn_w_up, *ffn_w_down; };

__device__ __forceinline__ void p0_ada_unit(Frame& F, const P0In& in, int unit) {
    LAS float* csl = (LAS float*)(F.lds + RING_OFF);
    for (int idx = F.tid; idx < BATCH * D; idx += NWAVES * 64) { const int b = idx / D, k = idx % D; const float v = in.c[idx]; csl[k * 16 + b] = v / (1.0f + __expf(-v)); }
    __syncthreads();
    const int li = unit >> 6, c0 = (unit & 63) * 192 + F.lane;
    const float* W = in.ada_w + (size_t)li * D * MODW + c0;
    float acc[3][16];
#pragma unroll
    for (int c = 0; c < 3; ++c)
#pragma unroll
        for (int b = 0; b < 16; ++b) acc[c][b] = 0.f;
    const int kbeg = F.wave * 256;
#pragma unroll 4
    for (int k = kbeg; k < kbeg + 256; ++k) {
        const float w0 = W[(size_t)k * MODW], w1 = W[(size_t)k * MODW + 64], w2 = W[(size_t)k * MODW + 128];
        const LAS f32x4* cp = (const LAS f32x4*)(csl + k * 16);
        const f32x4 s0 = cp[0], s1 = cp[1], s2 = cp[2], s3 = cp[3];
        const float cs[16] = {s0[0], s0[1], s0[2], s0[3], s1[0], s1[1], s1[2], s1[3], s2[0], s2[1], s2[2], s2[3], s3[0], s3[1], s3[2], s3[3]};
#pragma unroll
        for (int b = 0; b < 16; ++b) { acc[0][b] += w0 * cs[b]; acc[1][b] += w1 * cs[b]; acc[2][b] += w2 * cs[b]; }
    }
    __syncthreads();
    LAS float* part = (LAS float*)(F.lds + RING_OFF);
#pragma unroll
    for (int c = 0; c < 3; ++c)
#pragma unroll
        for (int b = 0; b < 16; ++b) part[(F.wave * 16 + b) * 192 + c * 64 + F.lane] = acc[c][b];
    __syncthreads();
    float* mod = (float*)(F.ws + WS_MOD);
    for (int o = F.tid; o < 16 * 192; o += NWAVES * 64) { const int b = o / 192, cc = o % 192; float s = 0.f;
#pragma unroll
        for (int w = 0; w < 8; ++w) s += part[(w * 16 + b) * 192 + cc];
        const int n = (unit & 63) * 192 + cc; mod[((size_t)li * BATCH + b) * MODW + n] = s + in.ada_b[(size_t)li * MODW + n]; }
    __syncthreads();
}
__device__ __forceinline__ void s5_coef(const P0In& in, int jg, int p, float& lbr, float& lbi, float& cfr, float& cfi) {
    const float step = __expf(in.log_step[jg]);
    const float lr = in.a_re[(size_t)jg * SP + p], li = in.a_im[(size_t)jg * SP + p];
    const float mag = expf(lr * step), ang = li * step;
    lbr = mag * cosf(ang); lbi = mag * sinf(ang);
    const float nr = lbr - 1.0f, ni = lbi, den = lr * lr + li * li;
    cfr = (nr * lr + ni * li) / den; cfi = (ni * lr - nr * li) / den;
}
__device__ __forceinline__ void p0_s5_tables(Frame& F, const P0In& in, int jg) {
    unsigned* tab = (unsigned*)(F.ws + WS_S5T) + (size_t)jg * S5T_WORDS;
    const int t = F.tid;
    if (t < 64) {
        float lbr, lbi, cfr, cfi; s5_coef(in, jg, t, lbr, lbi, cfr, cfi);
        float ar = lbr, ai = lbi;
#pragma unroll
        for (int s = 0; s < 7; ++s) { const float nr = ar * ar - ai * ai, ni = 2.0f * ar * ai; ar = nr; ai = ni; }
        tab[t] = __float_as_uint(lbr); tab[64 + t] = __float_as_uint(lbi); tab[128 + t] = __float_as_uint(ar); tab[192 + t] = __float_as_uint(ai);
    }
    {
        const int tau = t >> 6, lane = t & 63, q = tau >> 1, part = tau & 1, p = 16 * q + (lane & 15), c0 = 4 * (lane >> 4);
        float lbr, lbi, cfr, cfi; s5_coef(in, jg, p, lbr, lbi, cfr, cfi);
        const float* br = in.b_re + ((size_t)jg * SP + p) * SG + c0; const float* bi = in.b_im + ((size_t)jg * SP + p) * SG + c0;
        float v[4];
#pragma unroll
        for (int j = 0; j < 4; ++j) v[j] = part ? (cfr * bi[j] + cfi * br[j]) : (cfr * br[j] - cfi * bi[j]);
        tab[256 + (tau * 64 + lane) * 2 + 0] = pk2(v[0], v[1]); tab[256 + (tau * 64 + lane) * 2 + 1] = pk2(v[2], v[3]);
    }
    if (t < 256) {
        const int q = t >> 6, lane = t & 63, c = lane & 15, g4 = lane >> 4;
        const float* cr = in.c_re + ((size_t)jg * SG + c) * SP + 16 * q + 4 * g4; const float* ci = in.c_im + ((size_t)jg * SG + c) * SP + 16 * q + 4 * g4;
        unsigned* o = tab + 1280 + (q * 64 + lane) * 4;
        o[0] = pk2(cr[0], cr[1]); o[1] = pk2(cr[2], cr[3]); o[2] = pk2(-ci[0], -ci[1]); o[3] = pk2(-ci[2], -ci[3]);
    }
}
__device__ __forceinline__ void p0_prologue(Frame& F, const P0In& in) {
    for (int u = F.vcu; u < 256; u += F.G) p0_ada_unit(F, in, u);
    for (int u = F.vcu; u < 2 * NG; u += F.G) p0_s5_tables(F, in, u);
    LAS float* scr = (LAS float*)(F.lds + RING_OFF + F.wave * 16384);
    const int gw = F.vcu * NWAVES + F.wave, NGW = F.G * NWAVES;
    constexpr int I_AIN = (D / 64) * (AIN / 32), I_DD = (D / 64) * (D / 32), I_UP = (D / 64) * (FF2 / 32), I_DN = (FF / 64) * (D / 32);
    constexpr int C0 = 2 * I_AIN, C1 = C0 + 2 * I_DD, C2 = C1 + 2 * I_DD, C3 = C2 + 2 * I_DD, C4 = C3 + 2 * I_DD, C5 = C4 + 4 * I_UP, C6 = C5 + 4 * I_DN;
    for (int it = gw; it < C6; it += NGW) {
        const float* W; bf16* WT; int K, N, r; bool up = false;
        if (it < C0)      { r = it;      const int j = r / I_AIN; r -= j * I_AIN; K = D; N = AIN; W = in.attn_w_in + (size_t)j * D * AIN;  WT = (bf16*)(F.ws + WS_WAIN) + (size_t)j * AIN * D; }
        else if (it < C1) { r = it - C0; const int j = r / I_DD;  r -= j * I_DD;  K = D; N = D;   W = in.attn_w_out + (size_t)j * D * D;   WT = (bf16*)(F.ws + WS_WAOUT) + (size_t)j * D * D; }
        else if (it < C2) { r = it - C1; const int j = r / I_DD;  r -= j * I_DD;  K = D; N = D;   W = in.ssm_w_in + (size_t)j * D * D;     WT = (bf16*)(F.ws + WS_WSIN) + (size_t)j * D * D; }
        else if (it < C3) { r = it - C2; const int j = r / I_DD;  r -= j * I_DD;  K = D; N = D;   W = in.ssm_w_gate + (size_t)j * D * D;   WT = (bf16*)(F.ws + WS_WSGATE) + (size_t)j * D * D; }
        else if (it < C4) { r = it - C3; const int j = r / I_DD;  r -= j * I_DD;  K = D; N = D;   W = in.ssm_w_out + (size_t)j * D * D;    WT = (bf16*)(F.ws + WS_WSOUT) + (size_t)j * D * D; }
        else if (it < C5) { r = it - C4; const int j = r / I_UP;  r -= j * I_UP;  K = D; N = FF2; W = in.ffn_w_up + (size_t)j * D * FF2;   WT = (bf16*)(F.ws + WS_WUP) + (size_t)j * FF2 * D; up = true; }
        else              { r = it - C5; const int j = r / I_DN;  r -= j * I_DN;  K = FF; N = D;  W = in.ffn_w_down + (size_t)j * FF * D;  WT = (bf16*)(F.ws + WS_WDOWN) + (size_t)j * D * FF; }
        const int nblk = N / 32, kb = r / nblk, nb = r % nblk, n0 = 32 * nb;
        int drow = n0;
        if (up) { const int half = n0 >= FF ? 1 : 0, nn = n0 - half * FF; drow = 256 * (nn >> 7) + 128 * half + (nn & 127); }
        p0_transpose_item(W, K, N, WT, 64 * kb, n0, drow, scr, F.lane);
    }
}

__device__ __forceinline__ void norm_mod_phase(Frame& F, const float* xin, bf16* hout, const float* gain, const float* modl, int sh_off, int sc_off) {
    const int gw = F.vcu * NWAVES + F.wave, NGW = F.G * NWAVES;
    for (int blk = gw; blk < M / 16; blk += NGW) {
        const int row0 = blk * 16, b = row0 / T;
        f32x4 A[8], Bv[8];
#pragma unroll
        for (int j = 0; j < 8; ++j) { const int col = 4 * F.lane + 256 * j;
            const f32x4 g = *(const f32x4*)(gain + col), sc = *(const f32x4*)(modl + (size_t)b * MODW + sc_off + col);
            A[j] = g * (sc + 1.0f); Bv[j] = *(const f32x4*)(modl + (size_t)b * MODW + sh_off + col); }
        f32x4 cur[8], nxt[8];
#pragma unroll
        for (int j = 0; j < 8; ++j) cur[j] = *(const f32x4*)(xin + (size_t)row0 * D + 4 * F.lane + 256 * j);
        for (int r = 0; r < 16; ++r) {
            const int rn = (r + 1 < 16) ? r + 1 : r;
#pragma unroll
            for (int j = 0; j < 8; ++j) nxt[j] = *(const f32x4*)(xin + (size_t)(row0 + rn) * D + 4 * F.lane + 256 * j);
            float ss = 0.f;
#pragma unroll
            for (int j = 0; j < 8; ++j) ss += (cur[j][0] * cur[j][0] + cur[j][1] * cur[j][1]) + (cur[j][2] * cur[j][2] + cur[j][3] * cur[j][3]);
            const float rstd = __builtin_amdgcn_rsqf(wave_sum(ss) * (1.0f / D) + EPS);
            unsigned long long* o8 = (unsigned long long*)(hout + (size_t)(row0 + r) * D) + F.lane;
#pragma unroll
            for (int j = 0; j < 8; ++j) { const f32x4 v = cur[j] * rstd * A[j] + Bv[j];
                o8[64 * j] = (unsigned long long)cvt_pk_bf16(v[0], v[1]) | ((unsigned long long)cvt_pk_bf16(v[2], v[3]) << 32); }
#pragma unroll
            for (int j = 0; j < 8; ++j) cur[j] = nxt[j];
        }
    }
}
__device__ __forceinline__ void final_norm_phase(Frame& F, const float* xin, float* out, const float* gain) {
    const int gw = F.vcu * NWAVES + F.wave, NGW = F.G * NWAVES;
    f32x4 A[8];
#pragma unroll
    for (int j = 0; j < 8; ++j) A[j] = *(const f32x4*)(gain + 4 * F.lane + 256 * j);
    for (int blk = gw; blk < M / 16; blk += NGW) {
        const int row0 = blk * 16;
        for (int r = 0; r < 16; ++r) {
            f32x4 cur[8];
#pragma unroll
            for (int j = 0; j < 8; ++j) cur[j] = *(const f32x4*)(xin + (size_t)(row0 + r) * D + 4 * F.lane + 256 * j);
            float ss = 0.f;
#pragma unroll
            for (int j = 0; j < 8; ++j) ss += (cur[j][0] * cur[j][0] + cur[j][1] * cur[j][1]) + (cur[j][2] * cur[j][2] + cur[j][3] * cur[j][3]);
            const float rstd = __builtin_amdgcn_rsqf(wave_sum(ss) * (1.0f / D) + EPS);
#pragma unroll
            for (int j = 0; j < 8; ++j) *(f32x4*)(out + (size_t)(row0 + r) * D + 4 * F.lane + 256 * j) = cur[j] * rstd * A[j];
        }
    }
}

__device__ __forceinline__ void conv_fix_phase(Frame& F, const float* raw, bf16* aout, const float* cw, const float* cb) {
    const int gt = (F.vcu * NWAVES + F.wave) * 64 + F.lane, NT = F.G * NWAVES * 64;
    constexpr int C4 = FF / 4, NITEM = 112 * 2 * C4;
    for (int it = gt; it < NITEM; it += NT) {
        const int c4 = it % C4, rr = (it / C4) & 1, bi = it / (2 * C4), pm = (bi / 7) * 8 + 1 + (bi % 7), gc = 4 * c4;
        const float* r_m2 = raw + ((size_t)(pm - 1) * 4 + 2) * FF2; const float* r_m1 = raw + ((size_t)(pm - 1) * 4 + 3) * FF2;
        const float* r_0 = raw + ((size_t)pm * 4 + 0) * FF2;       const float* r_1 = raw + ((size_t)pm * 4 + 1) * FF2;
        const float* pc = rr ? r_1 : r_0; const float* p1 = rr ? r_0 : r_m1; const float* p2 = rr ? r_m1 : r_m2;
        float o[4];
        const f32x4 cg = *(const f32x4*)(pc + gc), g1 = *(const f32x4*)(p1 + gc), g2 = *(const f32x4*)(p2 + gc);
        const f32x4 cu = *(const f32x4*)(pc + FF + gc), u1 = *(const f32x4*)(p1 + FF + gc), u2 = *(const f32x4*)(p2 + FF + gc);
        const f32x4 wg0 = *(const f32x4*)(cw + gc), wg1 = *(const f32x4*)(cw + FF2 + gc), wg2 = *(const f32x4*)(cw + 2 * FF2 + gc), bg = *(const f32x4*)(cb + gc);
        const f32x4 wu0 = *(const f32x4*)(cw + FF + gc), wu1 = *(const f32x4*)(cw + FF2 + FF + gc), wu2 = *(const f32x4*)(cw + 2 * FF2 + FF + gc), bu = *(const f32x4*)(cb + FF + gc);
#pragma unroll
        for (int e = 0; e < 4; ++e) { const float gg = bg[e] + wg2[e] * cg[e] + wg1[e] * g1[e] + wg0[e] * g2[e], uu = bu[e] + wu2[e] * cu[e] + wu1[e] * u1[e] + wu0[e] * u2[e];
            o[e] = gg * pg8::fast_sigmoid(gg) * uu; }
        u32x2 w; w.x = cvt_pk_bf16(o[0], o[1]); w.y = cvt_pk_bf16(o[2], o[3]);
        *(u32x2*)(aout + (size_t)(pm * 256 + rr) * FF + gc) = w;
    }
}

namespace att {
constexpr int SLOT = 32768, K_OFF = 0, V_OFF = 65536;
__device__ __forceinline__ int kswz(int row, int colB) { return row * 256 + (colB ^ ((row & 15) << 4)); }
__device__ __forceinline__ int vperm(int k) { return (k & ~0xC) | ((k & 4) << 1) | ((k & 8) >> 1); }
__device__ __forceinline__ int voff(int row, int ch) { return 256 * row + 16 * (ch ^ (((row & 3) << 2) | ((row >> 2) & 3))); }
__device__ __forceinline__ s16x4 tr_read(int addr) { s16x4 r; asm volatile("ds_read_b64_tr_b16 %0, %1" : "=&v"(r) : "v"(addr) : "memory"); return r; }
struct Stg { u32x4 k[4], v[4]; };
}
__device__ __forceinline__ void attn_phase(Frame& F, bf16* proj, bf16* obuf, float* lse) {
    using namespace att;
    const int tid = F.tid, lane = F.lane, w = F.wave, q16 = lane & 15, g4 = lane >> 4;
    const int skey = tid >> 4, sch = tid & 15;
    for (int unit = F.vcu; unit < BATCH * NH; unit += F.G) {
        const int b = unit >> 4, h = unit & 15;
        const float c1 = 0.08838834764831845f * 1.4426950408889634f;
        const float slope2 = exp2f(-0.5f * (float)(h + 1)) * 1.4426950408889634f;
        Stg st;
#define ATT_DECODE(bu, grp, dil, cls, n) const int grp = 2 - ((bu) >> 4), dil = 1 << (2 * grp), nbk = 16 >> (2 * grp), cls = ((bu) & 15) / nbk, n = ((bu) & 15) % nbk
#define ATT_LOAD(bu) do { ATT_DECODE(bu, grp_, dil_, cls_, n_); _Pragma("unroll") for (int i = 0; i < 4; ++i) { \
            const size_t row_ = (size_t)b * T + (size_t)(128 * n_ + skey + 32 * i) * dil_ + cls_; const bf16* rp_ = proj + row_ * AIN + h * HD + sch * 8; \
            st.k[i] = *(const u32x4*)(rp_ + QK_COLS + grp_ * (NH * HD)); st.v[i] = *(const u32x4*)(rp_ + 2 * QK_COLS); } } while (0)
#define ATT_WRITE(slot) do { _Pragma("unroll") for (int i = 0; i < 4; ++i) { const int key_ = skey + 32 * i; \
            *(LAS u32x4*)(F.lds + K_OFF + (slot) * SLOT + kswz(key_, sch * 16)) = st.k[i]; *(LAS u32x4*)(F.lds + V_OFF + (slot) * SLOT + voff(vperm(key_), sch)) = st.v[i]; } } while (0)
        ATT_LOAD(0);
        for (int i = tid; i < SLOT / 16; i += NWAVES * 64) *(LAS u32x4*)(F.lds + V_OFF + SLOT + i * 16) = (u32x4){0u, 0u, 0u, 0u};
        ATT_WRITE(0);
        __syncthreads();
        for (int bu = 0; bu < 48; ++bu) {
            ATT_DECODE(bu, grp, dil, cls, n);
            const int cur = bu & 1, prev = cur ^ 1;
            const size_t rowq = (size_t)b * T + (size_t)(128 * n + 16 * w + q16) * dil + cls;
            bf16* qp = proj + rowq * AIN + grp * (NH * HD) + h * HD;
            bf16x8 qf[4];
#pragma unroll
            for (int ks = 0; ks < 4; ++ks) qf[ks] = *(const bf16x8*)(qp + 32 * ks + 8 * g4);
            if (bu + 1 < 48) ATT_LOAD(bu + 1);
            f32x4 s[9];
            int kx[4];
#pragma unroll
            for (int ks = 0; ks < 4; ++ks) kx[ks] = q16 * 256 + ((64 * ks + 16 * g4) ^ (q16 << 4));
#pragma unroll
            for (int t = 0; t < 9; ++t) { const int kt = w + t; const int base = K_OFF + ((kt < 8) ? prev : cur) * SLOT + (kt & 7) * 4096;
                s[t] = (f32x4){0.f, 0.f, 0.f, 0.f};
#pragma unroll
                for (int ks = 0; ks < 4; ++ks) { const bf16x8 kf = *(const LAS bf16x8*)(F.lds + base + kx[ks]); s[t] = __builtin_amdgcn_mfma_f32_16x16x32_bf16(kf, qf[ks], s[t], 0, 0, 0); }
                if (t & 1) __builtin_amdgcn_sched_barrier(0); }
            const float c2 = slope2 * (float)dil;
            float mx = -__builtin_inff();
#pragma unroll
            for (int t = 0; t < 9; ++t) { const bool tv = (n > 0) || (t >= 8 - w);
#pragma unroll
                for (int i = 0; i < 4; ++i) { const int kk = 4 * g4 + i; const float dist = (float)(128 - 16 * t + q16 - kk);
                    bool valid = tv; if (t == 0) valid = valid && (kk >= q16); if (t == 8) valid = valid && (kk <= q16);
                    const float z = valid ? (s[t][i] * c1 - c2 * dist) : -__builtin_inff(); s[t][i] = z; mx = fmaxf(mx, z); } }
            mx = xrow_max(mx);
            float l = 0.f;
#pragma unroll
            for (int t = 0; t < 9; ++t)
#pragma unroll
                for (int i = 0; i < 4; ++i) { const float p = __builtin_amdgcn_exp2f(s[t][i] - mx); s[t][i] = p; l += p; }
            l = xrow_sum(l);
            f32x4 o[8];
#pragma unroll
            for (int dt = 0; dt < 8; ++dt) o[dt] = (f32x4){0.f, 0.f, 0.f, 0.f};
            const int lq = (lane >> 2) & 3, lp = lane & 3;
            const int vmask = (lq << 2) | (2 * (g4 & 1) + (g4 >> 1));
            const int vlane = 256 * (8 * (g4 & 1) + 4 * (g4 >> 1) + lq) + 8 * (lp & 1), vpart = ((lp >> 1) ^ vmask) << 4;
#pragma unroll
            for (int pr = 0; pr < 5; ++pr) {
                const int ta = 2 * pr, tb = (pr < 4) ? 2 * pr + 1 : 2 * pr;
                const int kta = w + ta, ktb = w + tb;
                const int basea = V_OFF + ((kta < 8) ? prev : cur) * SLOT + (kta & 7) * 4096 + vlane, baseb = V_OFF + ((ktb < 8) ? prev : cur) * SLOT + (ktb & 7) * 4096 + vlane;
                u32x4 pw; pw.x = cvt_pk_bf16(s[ta][0], s[ta][1]); pw.y = cvt_pk_bf16(s[ta][2], s[ta][3]);
                if (pr < 4) { pw.z = cvt_pk_bf16(s[tb][0], s[tb][1]); pw.w = cvt_pk_bf16(s[tb][2], s[tb][3]); } else { pw.z = 0u; pw.w = 0u; }
                const bf16x8 pa = __builtin_bit_cast(bf16x8, pw);
#pragma unroll
                for (int dh = 0; dh < 2; ++dh) {
                    s16x4 va[4], vb[4];
#pragma unroll
                    for (int d = 0; d < 4; ++d) { const int dt = 4 * dh + d; va[d] = tr_read(basea + (vpart ^ (dt << 5))); vb[d] = tr_read(baseb + (vpart ^ (dt << 5))); }
                    asm volatile("s_waitcnt lgkmcnt(0)" ::: "memory"); __builtin_amdgcn_sched_barrier(0);
#pragma unroll
                    for (int d = 0; d < 4; ++d) { const int dt = 4 * dh + d; const bf16x8 vf = (bf16x8){va[d][0], va[d][1], va[d][2], va[d][3], vb[d][0], vb[d][1], vb[d][2], vb[d][3]};
                        o[dt] = __builtin_amdgcn_mfma_f32_16x16x32_bf16(vf, pa, o[dt], 0, 0, 0); }
                    __builtin_amdgcn_sched_barrier(0);
                }
            }
            const float inv = 1.0f / l, lse2 = mx + __builtin_amdgcn_logf(l);
            if (grp > 0) {
#pragma unroll
                for (int dt = 0; dt < 8; ++dt) { u32x2 wv; wv.x = cvt_pk_bf16(o[dt][0] * inv, o[dt][1] * inv); wv.y = cvt_pk_bf16(o[dt][2] * inv, o[dt][3] * inv);
                    *(u32x2*)(qp + 16 * dt + 4 * g4) = wv; }
                if (g4 == 0) lse[((size_t)(grp - 1) * M + rowq) * NH + h] = lse2;
            } else {
                const float l1 = lse[((size_t)0 * M + rowq) * NH + h], l2 = lse[((size_t)1 * M + rowq) * NH + h];
                const float mm = fmaxf(lse2, fmaxf(l1, l2));
                float w0 = __builtin_amdgcn_exp2f(lse2 - mm), w1 = __builtin_amdgcn_exp2f(l1 - mm), w2 = __builtin_amdgcn_exp2f(l2 - mm);
                const float wi = 1.0f / (w0 + w1 + w2); w0 *= wi * inv; w1 *= wi; w2 *= wi;
                const bf16* o1p = proj + rowq * AIN + 1 * (NH * HD) + h * HD; const bf16* o2p = proj + rowq * AIN + 2 * (NH * HD) + h * HD;
                bf16* op = obuf + rowq * D + h * HD;
#pragma unroll
                for (int dt = 0; dt < 8; ++dt) { const u32x2 a1 = *(const u32x2*)(o1p + 16 * dt + 4 * g4), a2 = *(const u32x2*)(o2p + 16 * dt + 4 * g4);
                    const float r0 = w0 * o[dt][0] + w1 * bf_lo(a1.x) + w2 * bf_lo(a2.x), r1 = w0 * o[dt][1] + w1 * bf_hi(a1.x) + w2 * bf_hi(a2.x);
                    const float r2 = w0 * o[dt][2] + w1 * bf_lo(a1.y) + w2 * bf_lo(a2.y), r3 = w0 * o[dt][3] + w1 * bf_hi(a1.y) + w2 * bf_hi(a2.y);
                    u32x2 wv; wv.x = cvt_pk_bf16(r0, r1); wv.y = cvt_pk_bf16(r2, r3); *(u32x2*)(op + 16 * dt + 4 * g4) = wv; }
            }
            if (bu == 31) VM_WAIT();
            __syncthreads();
            if (bu == 31) { __builtin_amdgcn_fence(__ATOMIC_ACQUIRE, "agent"); }
            if (bu + 1 < 48) ATT_WRITE(prev);
            __syncthreads();
        }
#undef ATT_DECODE
#undef ATT_LOAD
#undef ATT_WRITE
    }
}

template <int CTRL> __device__ __forceinline__ float dpp_shr0(float v) { return __int_as_float(__builtin_amdgcn_update_dpp(0, __float_as_int(v), CTRL, 0xf, 0xf, true)); }
__device__ __forceinline__ float gelu_tanh(float v) {
    const float inner = 0.7978845608028654f * (v + 0.044715f * v * v * v);
    return v * __builtin_amdgcn_rcpf(1.0f + __builtin_amdgcn_exp2f(-2.8853900817779268f * inner));
}
__device__ __forceinline__ void s5_phase(Frame& F, const bf16* U, bf16* Gout, const unsigned* tabl, const float* dskip) {
    const int lane = F.lane, vs = lane & 15, g4 = lane >> 4;
    for (int unit = F.vcu; unit < BATCH * (NG / 8); unit += F.G) {
        const int b = unit >> 4, g = (unit & 15) * 8 + F.wave;
        const unsigned* tab = tabl + (size_t)g * S5T_WORDS;
        float lr[4][4], li[4][4], xr[4][4], xi[4][4];
#pragma unroll
        for (int q = 0; q < 4; ++q)
#pragma unroll
            for (int i = 0; i < 4; ++i) { const int p = 16 * q + 4 * g4 + i; lr[q][i] = __uint_as_float(tab[p]); li[q][i] = __uint_as_float(tab[64 + p]); xr[q][i] = 0.f; xi[q][i] = 0.f; }
        s16x4 bbf[8];
#pragma unroll
        for (int tau = 0; tau < 8; ++tau) bbf[tau] = *(const s16x4*)(tab + 256 + (tau * 64 + lane) * 2);
        const size_t row0 = (size_t)b * T + 128 * vs;
        const bf16* up = U + row0 * D + g * SG + 4 * g4;
        const f32x4 zero4 = (f32x4){0.f, 0.f, 0.f, 0.f};
#pragma unroll 4
        for (int tt = 0; tt < 128; ++tt) {
            const s16x4 ub = *(const s16x4*)(up + (size_t)tt * D);
#pragma unroll
            for (int q = 0; q < 4; ++q) {
                const f32x4 br = __builtin_amdgcn_mfma_f32_16x16x16bf16_1k(bbf[2 * q], ub, zero4, 0, 0, 0), bi = __builtin_amdgcn_mfma_f32_16x16x16bf16_1k(bbf[2 * q + 1], ub, zero4, 0, 0, 0);
#pragma unroll
                for (int i = 0; i < 4; ++i) { const float nr = lr[q][i] * xr[q][i] - li[q][i] * xi[q][i] + br[i], ni = lr[q][i] * xi[q][i] + li[q][i] * xr[q][i] + bi[i]; xr[q][i] = nr; xi[q][i] = ni; }
            }
        }
        {
            float ar[4][4], ai[4][4];
#pragma unroll
            for (int q = 0; q < 4; ++q)
#pragma unroll
                for (int i = 0; i < 4; ++i) { const int p = 16 * q + 4 * g4 + i; ar[q][i] = __uint_as_float(tab[128 + p]); ai[q][i] = __uint_as_float(tab[192 + p]); }
#define S5_STEP(CTRL) do { _Pragma("unroll") for (int q = 0; q < 4; ++q) _Pragma("unroll") for (int i = 0; i < 4; ++i) { \
                const float nbr = dpp_shr0<CTRL>(xr[q][i]), nbi = dpp_shr0<CTRL>(xi[q][i]); \
                xr[q][i] += ar[q][i] * nbr - ai[q][i] * nbi; xi[q][i] += ar[q][i] * nbi + ai[q][i] * nbr; \
                const float sr = ar[q][i] * ar[q][i] - ai[q][i] * ai[q][i], si = 2.0f * ar[q][i] * ai[q][i]; ar[q][i] = sr; ai[q][i] = si; } } while (0)
            S5_STEP(0x111); S5_STEP(0x112); S5_STEP(0x114); S5_STEP(0x118);
#undef S5_STEP
#pragma unroll
            for (int q = 0; q < 4; ++q)
#pragma unroll
                for (int i = 0; i < 4; ++i) { xr[q][i] = dpp_shr0<0x111>(xr[q][i]); xi[q][i] = dpp_shr0<0x111>(xi[q][i]); }
        }
        bf16x8 cmf[4];
#pragma unroll
        for (int q = 0; q < 4; ++q) cmf[q] = *(const bf16x8*)(tab + 1280 + (q * 64 + lane) * 4);
        const f32x4 dsk = *(const f32x4*)(dskip + g * SG + 4 * g4);
        bf16* gp = Gout + row0 * D + g * SG + 4 * g4;
#pragma unroll 4
        for (int tt = 0; tt < 128; ++tt) {
            const u32x2 uw = *(const u32x2*)(up + (size_t)tt * D);
            const s16x4 ub = __builtin_bit_cast(s16x4, uw);
            f32x4 y = zero4;
#pragma unroll
            for (int q = 0; q < 4; ++q) {
                const f32x4 br = __builtin_amdgcn_mfma_f32_16x16x16bf16_1k(bbf[2 * q], ub, zero4, 0, 0, 0), bi = __builtin_amdgcn_mfma_f32_16x16x16bf16_1k(bbf[2 * q + 1], ub, zero4, 0, 0, 0);
#pragma unroll
                for (int i = 0; i < 4; ++i) { const float nr = lr[q][i] * xr[q][i] - li[q][i] * xi[q][i] + br[i], ni = lr[q][i] * xi[q][i] + li[q][i] * xr[q][i] + bi[i]; xr[q][i] = nr; xi[q][i] = ni; }
                u32x4 xw; xw.x = cvt_pk_bf16(xr[q][0], xr[q][1]); xw.y = cvt_pk_bf16(xr[q][2], xr[q][3]); xw.z = cvt_pk_bf16(xi[q][0], xi[q][1]); xw.w = cvt_pk_bf16(xi[q][2], xi[q][3]);
                y = __builtin_amdgcn_mfma_f32_16x16x32_bf16(cmf[q], __builtin_bit_cast(bf16x8, xw), y, 0, 0, 0);
            }
            const float v0 = y[0] + dsk[0] * bf_lo(uw.x), v1 = y[1] + dsk[1] * bf_hi(uw.x), v2 = y[2] + dsk[2] * bf_lo(uw.y), v3 = y[3] + dsk[3] * bf_hi(uw.y);
            u32x2 ow; ow.x = cvt_pk_bf16(gelu_tanh(v0), gelu_tanh(v1)); ow.y = cvt_pk_bf16(gelu_tanh(v2), gelu_tanh(v3));
            *(u32x2*)(gp + (size_t)tt * D) = ow;
        }
    }
}

constexpr int NPH_PAIR = 17, NPHASE = 2 + 2 * NPH_PAIR;
struct Args { const float* in[24]; float* out; unsigned char* ws; int ph_lo, ph_hi; };
__device__ __forceinline__ const float* argp(const Args& a, int i) { asm volatile("" : "+s"(i)); return a.in[i]; }
__global__ void __launch_bounds__(NWAVES * 64, 2) fwd_kernel(Args args) {
    extern __shared__ __attribute__((aligned(16))) unsigned char lds[];
    Frame F;
    F.lds = (LAS unsigned char*)lds;
    F.MISC = (volatile LAS unsigned*)(F.lds + MISC_OFF);
    F.tid = threadIdx.x; F.lane = F.tid & 63; F.wave = __builtin_amdgcn_readfirstlane(F.tid >> 6);
    F.G = gridDim.x; { const int bx = blockIdx.x; F.vcu = (F.G % 8 == 0) ? (bx % 8) * (F.G / 8) + bx / 8 : bx; }
    F.ws = args.ws; F.ctl = (unsigned*)(F.ws + WS_CTL);
    for (int u = F.tid; u < (EXCH_OFF - LDSCTL_OFF) / 4; u += NWAVES * 64) ((LAS unsigned*)(F.lds + LDSCTL_OFF))[u] = 0u;
    __syncthreads();
#if MK_ONE_LAUNCH
    XcdBarrier bar = xcd_barrier_post(F.ctl + CW_BAR, F.MISC + 8);
#define GRID_BAR() xcd_barrier(bar)
#else
#define GRID_BAR() do { } while (0)
#endif
    const int lo = args.ph_lo, hi = args.ph_hi;
#define IN(k) (lo <= (k) && (k) < hi && (frame_refresh(F, args.ws, args.out), true))
#define SEAM(k) do { if (lo <= (k) && (k) + 1 < hi) GRID_BAR(); } while (0)
#define xres (F.out)
#define Hb ((bf16*)(F.ws + WS_H))
#define BIG ((bf16*)(F.ws + WS_BIG))
#define ring (F.lds + RING_OFF)
#define moda ((const float*)(F.ws + WS_MOD) + (size_t)la * BATCH * MODW)
#define mods ((const float*)(F.ws + WS_MOD) + (size_t)ls * BATCH * MODW)
#define xa ((pr == 0) ? argp(args, 0) : (const float*)F.out)

    if (IN(0)) {
        P0In pin{argp(args, 1), argp(args, 2), argp(args, 3), argp(args, 6), argp(args, 7), argp(args, 8), argp(args, 9), argp(args, 10), argp(args, 11), argp(args, 12), argp(args, 13), argp(args, 14), argp(args, 15),
                 argp(args, 17), argp(args, 18), argp(args, 19), argp(args, 22)};
        p0_prologue(F, pin);
    }
    SEAM(0);
    for (int pr = 0; pr < 2; ++pr) {
        const int pb = 1 + NPH_PAIR * pr, la = 2 * pr, ls = 2 * pr + 1;
        if (IN(pb + 0)) norm_mod_phase(F, xa, Hb, argp(args, 4) + (size_t)la * D, moda, 0, D);
        SEAM(pb + 0);
        if (IN(pb + 1)) { pg8::Gemm g{Hb, (const bf16*)(F.ws + WS_WAIN) + (size_t)pr * AIN * D, M, AIN, D}; pg8::StaticOrder S; S.init(M, AIN, F.G, pg8::opaque_bid());
            pg8::EpiBf16 E{BIG, AIN}; pg8::gemm_phase<pg8::EpiBf16, pg8::StaticOrder, true, true>(ring, g, S, E); }
        SEAM(pb + 1);
        if (IN(pb + 2)) attn_phase(F, BIG, Hb, (float*)(F.ws + WS_LSE));
        SEAM(pb + 2);
        if (IN(pb + 3)) { pg8::Gemm g{Hb, (const bf16*)(F.ws + WS_WAOUT) + (size_t)pr * D * D, M, D, D}; pg8::StaticOrder S; S.init(M, D, F.G, pg8::opaque_bid());
            pg8::EpiGateRes E{xa, xres, moda + 2 * D}; pg8::gemm_phase<pg8::EpiGateRes, pg8::StaticOrder, true, true>(ring, g, S, E); }
        SEAM(pb + 3);
        if (IN(pb + 4)) norm_mod_phase(F, xres, Hb, argp(args, 5) + (size_t)la * D, moda, 3 * D, 4 * D);
        SEAM(pb + 4);
        if (IN(pb + 5)) { pg8::Gemm g{Hb, (const bf16*)(F.ws + WS_WUP) + (size_t)la * FF2 * D, M, FF2, D}; pg8::StaticOrder S; S.init(M, FF2, F.G, pg8::opaque_bid());
            pg8::EpiConvGate E{BIG, (float*)(F.ws + WS_RAW), argp(args, 20) + (size_t)la * 3 * FF2, argp(args, 21) + (size_t)la * FF2, F.lds + EXCH_OFF};
            pg8::gemm_phase<pg8::EpiConvGate, pg8::StaticOrder, true, true>(ring, g, S, E); }
        SEAM(pb + 5);
        if (IN(pb + 6)) conv_fix_phase(F, (const float*)(F.ws + WS_RAW), BIG, argp(args, 20) + (size_t)la * 3 * FF2, argp(args, 21) + (size_t)la * FF2);
        SEAM(pb + 6);
        if (IN(pb + 7)) { pg8::Gemm g{BIG, (const bf16*)(F.ws + WS_WDOWN) + (size_t)la * D * FF, M, D, FF}; pg8::StaticOrder S; S.init(M, D, F.G, pg8::opaque_bid());
            pg8::EpiGateRes E{xres, xres, moda + 5 * D}; pg8::gemm_phase<pg8::EpiGateRes, pg8::StaticOrder, true, true>(ring, g, S, E); }
        SEAM(pb + 7);
        if (IN(pb + 8)) norm_mod_phase(F, xres, Hb, argp(args, 4) + (size_t)ls * D, mods, 0, D);
        SEAM(pb + 8);
        if (IN(pb + 9)) { pg8::Gemm g{Hb, (const bf16*)(F.ws + WS_WSIN) + (size_t)pr * D * D, M, D, D}; pg8::StaticOrder S; S.init(M, D, F.G, pg8::opaque_bid());
            pg8::EpiBf16 E{BIG, D}; pg8::gemm_phase<pg8::EpiBf16, pg8::StaticOrder, true, true>(ring, g, S, E); }
        SEAM(pb + 9);
        if (IN(pb + 10)) s5_phase(F, BIG, Hb, (const unsigned*)(F.ws + WS_S5T) + (size_t)pr * NG * S5T_WORDS, argp(args, 16) + (size_t)pr * D);
        SEAM(pb + 10);
        if (IN(pb + 11)) { pg8::Gemm g{Hb, (const bf16*)(F.ws + WS_WSGATE) + (size_t)pr * D * D, M, D, D}; pg8::StaticOrder S; S.init(M, D, F.G, pg8::opaque_bid());
            pg8::EpiSigGate E{Hb, BIG + (size_t)M * D}; pg8::gemm_phase<pg8::EpiSigGate, pg8::StaticOrder, true, true>(ring, g, S, E); }
        SEAM(pb + 11);
        if (IN(pb + 12)) { pg8::Gemm g{BIG + (size_t)M * D, (const bf16*)(F.ws + WS_WSOUT) + (size_t)pr * D * D, M, D, D}; pg8::StaticOrder S; S.init(M, D, F.G, pg8::opaque_bid());
            pg8::EpiGateRes E{xres, xres, mods + 2 * D}; pg8::gemm_phase<pg8::EpiGateRes, pg8::StaticOrder, true, true>(ring, g, S, E); }
        SEAM(pb + 12);
        if (IN(pb + 13)) norm_mod_phase(F, xres, Hb, argp(args, 5) + (size_t)ls * D, mods, 3 * D, 4 * D);
        SEAM(pb + 13);
        if (IN(pb + 14)) { pg8::Gemm g{Hb, (const bf16*)(F.ws + WS_WUP) + (size_t)ls * FF2 * D, M, FF2, D}; pg8::StaticOrder S; S.init(M, FF2, F.G, pg8::opaque_bid());
            pg8::EpiConvGate E{BIG, (float*)(F.ws + WS_RAW), argp(args, 20) + (size_t)ls * 3 * FF2, argp(args, 21) + (size_t)ls * FF2, F.lds + EXCH_OFF};
            pg8::gemm_phase<pg8::EpiConvGate, pg8::StaticOrder, true, true>(ring, g, S, E); }
        SEAM(pb + 14);
        if (IN(pb + 15)) conv_fix_phase(F, (const float*)(F.ws + WS_RAW), BIG, argp(args, 20) + (size_t)ls * 3 * FF2, argp(args, 21) + (size_t)ls * FF2);
        SEAM(pb + 15);
        if (IN(pb + 16)) { pg8::Gemm g{BIG, (const bf16*)(F.ws + WS_WDOWN) + (size_t)ls * D * FF, M, D, FF}; pg8::StaticOrder S; S.init(M, D, F.G, pg8::opaque_bid());
            pg8::EpiGateRes E{xres, xres, mods + 5 * D}; pg8::gemm_phase<pg8::EpiGateRes, pg8::StaticOrder, true, true>(ring, g, S, E); }
        SEAM(pb + 16);
    }
    if (IN(NPHASE - 1)) final_norm_phase(F, xres, xres, argp(args, 23));
#undef IN
#undef xres
#undef Hb
#undef BIG
#undef ring
#undef moda
#undef mods
#undef xa
#undef SEAM
#undef GRID_BAR
}

extern "C" void kernel_launch(void* const* d_in, const int* in_sizes, int n_in, void* d_out, int out_size, void* d_ws, size_t ws_size, hipStream_t stream) {
    static int grid = 0;
    if (grid == 0) {
        if (n_in != 24 || in_sizes[0] != M * D || out_size != M * D || ws_size < WS_END) { fprintf(stderr, "kernel_launch: shape mismatch: n_in %d in0 %d out %d ws %zu (need %zu)\n", n_in, n_in > 0 ? in_sizes[0] : -1, out_size, ws_size, (size_t)WS_END); grid = -1; return; }
        int dev = 0, cus = 0, per_cu = 0;
        if (hipGetDevice(&dev) != hipSuccess || hipDeviceGetAttribute(&cus, hipDeviceAttributeMultiprocessorCount, dev) != hipSuccess) { grid = -1; return; }
        if (hipFuncSetAttribute((const void*)fwd_kernel, hipFuncAttributeMaxDynamicSharedMemorySize, LDS_BYTES) != hipSuccess) { fprintf(stderr, "kernel_launch: hipFuncSetAttribute failed\n"); grid = -1; return; }
        if (hipOccupancyMaxActiveBlocksPerMultiprocessor(&per_cu, (const void*)fwd_kernel, NWAVES * 64, LDS_BYTES) != hipSuccess || per_cu < 1) { fprintf(stderr, "kernel_launch: occupancy query says %d\n", per_cu); }
        (void)hipGetLastError();
        grid = cus;
    }
    if (grid < 0) return;
    if (hipMemsetAsync((char*)d_ws + WS_CTL, 0, CTL_ZERO_BYTES, stream) != hipSuccess) return;
    Args a{};
    for (int i = 0; i < 24; ++i) a.in[i] = (const float*)d_in[i];
    a.out = (float*)d_out; a.ws = (unsigned char*)d_ws;
#if MK_ONE_LAUNCH
    a.ph_lo = 0; a.ph_hi = NPHASE;
    hipLaunchKernelGGL(fwd_kernel, dim3(grid), dim3(NWAVES * 64), LDS_BYTES, stream, a);
#else
    for (int p = 0; p < NPHASE; ++p) { a.ph_lo = p; a.ph_hi = p + 1;
#if MK_DEBUG_CHECKS
        debug_checks(p, true, d_in, (float*)d_out, (unsigned char*)d_ws, stream);
#endif
        hipLaunchKernelGGL(fwd_kernel, dim3(grid), dim3(NWAVES * 64), LDS_BYTES, stream, a);
#if MK_DEBUG_CHECKS
        debug_checks(p, false, d_in, (float*)d_out, (unsigned char*)d_ws, stream);
#endif
    }
#endif
    const hipError_t le = hipPeekAtLastError();
    if (le != hipSuccess) fprintf(stderr, "kernel_launch: launch failed: %s\n", hipGetErrorName(le));
}
```

```cpp
#include <hip/hip_runtime.h>
#include <cstdio>
#include <cstdint>

#ifndef MK_ONE_LAUNCH
#define MK_ONE_LAUNCH 1
#endif
#ifndef MK_DEBUG_CHECKS
#define MK_DEBUG_CHECKS 0
#endif
#ifndef MK_REPEAT_MASK
#define MK_REPEAT_MASK 0
#endif
#ifndef MK_DRY_MASK
#define MK_DRY_MASK 0
#endif
#ifndef MK_DEBUG_NOTAPS
#define MK_DEBUG_NOTAPS 0
#endif

constexpr int BATCH = 16, T = 2048, D = 2048, M = BATCH * T, DEPTH = 4;
constexpr int NH = 16, HD = 128, QK_COLS = 3 * NH * HD, V_COLS = NH * HD, AIN = 2 * QK_COLS + V_COLS;
constexpr int SG = 16, NG = D / SG, SP = 64;
constexpr int FF = 5632, FF2 = 2 * FF;
constexpr int MODW = 6 * D;
constexpr float EPS = 1e-6f;
constexpr int KPAD = 64, DP = D + KPAD, FFP = FF + KPAD;

namespace pg8 {
#define PG8_LAS __attribute__((address_space(3)))
typedef unsigned short bf16_t;
typedef short bf16x8 __attribute__((ext_vector_type(8)));
typedef float f32x4 __attribute__((ext_vector_type(4)));
typedef unsigned u32x4 __attribute__((ext_vector_type(4)));
typedef unsigned u32x2 __attribute__((ext_vector_type(2)));
constexpr int BM = 256, BK = 64, HALF = 128, HTB = HALF * BK * 2  , STAGE_BYTES = 8 * HTB, NXCD = 8, WGM = 8;

__host__ __device__ __forceinline__ int lds_byte(int r, int c) { const int st = (r >> 4) * 2 + (c >> 5), rr = r & 15, cc = c & 31, ob = rr * 64 + cc * 2; return st * 1024 + (ob ^ (((ob >> 9) & 1) << 5)); }
__host__ __device__ __forceinline__ void stage_rc(int b, int& R, int& C) { const int st = b / 1024, sb = b % 1024, swz = sb ^ (((sb >> 9) & 1) << 5); R = (st >> 1) * 16 + swz / 64; C = (st & 1) * 32 + (swz % 64) / 2; }
__host__ __device__ __forceinline__ int perm32(int rho) { const int n = rho >> 4, i = rho & 15; return 8 * (i >> 2) + 4 * n + (i & 3); }

__device__ __forceinline__ int opaque_tid() { int t = (int)threadIdx.x; asm volatile("" : "+v"(t)); return t; }
__device__ __forceinline__ int opaque_bid() { int t = (int)blockIdx.x; asm volatile("" : "+s"(t)); return t; }
struct Unit { int pm, pn; };
struct Gemm { const bf16_t* A; const bf16_t* Bt; int M, N, K, ldk; };

struct StaticOrder {
    int nM, nN, nwg, G, c;
    __host__ __device__ void init(int M_, int N_, int G_, int c_) { nM = M_ / BM; nN = N_ / BM; nwg = nM * nN; G = G_; c = c_; }
    __host__ __device__ bool next(int i, Unit& u) const {
        const long L = (long)i * G + c; if (L >= nwg) return false;
        int wgid = (int)L; { const int q = nwg / NXCD, r = nwg % NXCD, xcd = wgid % NXCD, off = wgid / NXCD; wgid = (xcd < r ? xcd * (q + 1) : r * (q + 1) + (xcd - r) * q) + off; }
        const int nig = WGM * nN, gid = wgid / nig, fm = gid * WGM, gsz = (nM - fm) < WGM ? (nM - fm) : WGM;
        u.pm = fm + ((wgid % nig) % gsz); u.pn = (wgid % nig) / gsz; return true;
    }
    __device__ __forceinline__ void a_ready(const Unit&) const {}
    __device__ __forceinline__ void done(const Unit&) const {}
};
#if MK_DRY_MASK
struct SameTileOrder : StaticOrder {
    __host__ __device__ bool next(int i, Unit& u) const { const bool ok = StaticOrder::next(i, u); u.pm = 0; u.pn = 0; return ok; }
};
#endif

__device__ __forceinline__ unsigned cvt_pk_bf16(float lo, float hi) { unsigned r; asm volatile("v_cvt_pk_bf16_f32 %0, %1, %2" : "=v"(r) : "v"(lo), "v"(hi)); return r; }
__device__ __forceinline__ float bf_lo(unsigned w) { return __uint_as_float(w << 16); }
__device__ __forceinline__ float bf_hi(unsigned w) { return __uint_as_float(w & 0xffff0000u); }
__device__ __forceinline__ float fast_sigmoid(float v) { return __builtin_amdgcn_rcpf(1.0f + __builtin_amdgcn_exp2f(-1.4426950408889634f * v)); }

struct EpiBf16 {
    static constexpr bool PERM = true, AFTER_DRAIN = false;
    bf16_t* O; int ldc;
    __device__ __forceinline__ void operator()(const f32x4 (&acc)[2][2][4][2], const Unit& u, int wr, int wc, int fr, int fq) const {
        const int row0 = u.pm * BM + wr * 64 + fr, col0 = u.pn * BM + wc * 32 + 8 * fq;
#pragma unroll
        for (int ai = 0; ai < 2; ++ai)
#pragma unroll
            for (int m = 0; m < 4; ++m) { bf16_t* rowp = O + (size_t)(row0 + ai * HALF + m * 16) * ldc + col0;
#pragma unroll
                for (int bj = 0; bj < 2; ++bj) { const f32x4 v0 = acc[ai][bj][m][0], v1 = acc[ai][bj][m][1];
                    u32x4 w; w.x = cvt_pk_bf16(v0[0], v0[1]); w.y = cvt_pk_bf16(v0[2], v0[3]); w.z = cvt_pk_bf16(v1[0], v1[1]); w.w = cvt_pk_bf16(v1[2], v1[3]);
                    *(u32x4*)(rowp + bj * HALF) = w; } }
    }
};
#if MK_DRY_MASK
struct EpiNull {
    static constexpr bool PERM = true, AFTER_DRAIN = false;
    __device__ __forceinline__ void operator()(const f32x4 (&acc)[2][2][4][2], const Unit& u, int wr, int wc, int fr, int fq) const {
#pragma unroll
        for (int ai = 0; ai < 2; ++ai)
#pragma unroll
            for (int bj = 0; bj < 2; ++bj)
#pragma unroll
                for (int m = 0; m < 4; ++m)
#pragma unroll
                    for (int n = 0; n < 2; ++n) asm volatile("" :: "v"(acc[ai][bj][m][n]));
    }
};
#endif
constexpr size_t QK_PART = (size_t)BATCH * NH * 3 * T * HD;
struct EpiQKV {
    static constexpr bool PERM = true, AFTER_DRAIN = false;
    bf16_t* O;
    __device__ __forceinline__ void operator()(const f32x4 (&acc)[2][2][4][2], const Unit& u, int wr, int wc, int fr, int fq) const {
        const int part = u.pn >> 3, b = u.pm >> 3, t0 = (u.pm & 7) * BM + wr * 64 + fr, d0 = wc * 32 + 8 * fq;
        const int grp = part < 3 ? part : (part < 6 ? part - 3 : 0), sh = 2 * grp;
#pragma unroll
        for (int bj = 0; bj < 2; ++bj) { const int h = 2 * (u.pn & 7) + bj;
            bf16_t* hb = (part < 6) ? O + (part >= 3 ? QK_PART : 0) + ((size_t)((b * NH + h) * 3 + grp) * T) * HD + d0 : O + 2 * QK_PART + ((size_t)(b * NH + h) * T) * HD + d0;
#pragma unroll
            for (int ai = 0; ai < 2; ++ai)
#pragma unroll
                for (int m = 0; m < 4; ++m) { const int t = t0 + ai * HALF + m * 16;
                    const int pos = (part < 6) ? ((t & ((1 << sh) - 1)) * (T >> sh) + (t >> sh)) : t;
                    const f32x4 v0 = acc[ai][bj][m][0], v1 = acc[ai][bj][m][1];
                    u32x4 w; w.x = cvt_pk_bf16(v0[0], v0[1]); w.y = cvt_pk_bf16(v0[2], v0[3]); w.z = cvt_pk_bf16(v1[0], v1[1]); w.w = cvt_pk_bf16(v1[2], v1[3]);
                    *(u32x4*)(hb + (size_t)pos * HD) = w; } }
    }
};
struct EpiGateRes {
    static constexpr bool PERM = false, AFTER_DRAIN = false;
    const float* base; float* out; const float* gate;
    __device__ __forceinline__ void operator()(const f32x4 (&acc)[2][2][4][2], const Unit& u, int wr, int wc, int fr, int fq) const {
        const int row0 = u.pm * BM + wr * 64 + fr, col0 = u.pn * BM + wc * 32 + 4 * fq;
        const float* gp = gate + (size_t)(u.pm >> 3) * MODW + col0;
        f32x4 gv[2][2];
#pragma unroll
        for (int bj = 0; bj < 2; ++bj)
#pragma unroll
            for (int n = 0; n < 2; ++n) gv[bj][n] = *(const f32x4*)(gp + bj * HALF + n * 16);
        const float* bp = base + (size_t)row0 * D + col0; float* op = out + (size_t)row0 * D + col0;
        f32x4 b0[2][2][2], b1[2][2][2];
#define EGR_LOAD(dst, ai, m0, nm) do { _Pragma("unroll") for (int m = 0; m < (nm); ++m) _Pragma("unroll") for (int bj = 0; bj < 2; ++bj) _Pragma("unroll") for (int n = 0; n < 2; ++n) \
            dst[m][bj][n] = *(const f32x4*)(bp + (size_t)((ai) * HALF + ((m0) + m) * 16) * D + bj * HALF + n * 16); } while (0)
#define EGR_STORE(src, ai, m0, nm) do { _Pragma("unroll") for (int m = 0; m < (nm); ++m) _Pragma("unroll") for (int bj = 0; bj < 2; ++bj) _Pragma("unroll") for (int n = 0; n < 2; ++n) \
            *(f32x4*)(op + (size_t)((ai) * HALF + ((m0) + m) * 16) * D + bj * HALF + n * 16) = src[m][bj][n] + gv[bj][n] * acc[ai][bj][(m0) + m][n]; } while (0)
        EGR_LOAD(b0, 0, 0, 2); asm volatile("" ::: "memory");
        EGR_LOAD(b1, 0, 2, 2); asm volatile("" ::: "memory");
        EGR_STORE(b0, 0, 0, 2); asm volatile("" ::: "memory");
        EGR_LOAD(b0, 1, 0, 2); asm volatile("" ::: "memory");
        EGR_STORE(b1, 0, 2, 2); asm volatile("" ::: "memory");
        EGR_LOAD(b1, 1, 2, 2); asm volatile("" ::: "memory");
        EGR_STORE(b0, 1, 0, 2); asm volatile("" ::: "memory");
        EGR_STORE(b1, 1, 2, 2);
#undef EGR_LOAD
#undef EGR_STORE
    }
};
struct EpiSigGate {
    static constexpr bool PERM = true, AFTER_DRAIN = false;
    const bf16_t* gsrc; bf16_t* O;
    __device__ __forceinline__ void operator()(const f32x4 (&acc)[2][2][4][2], const Unit& u, int wr, int wc, int fr, int fq) const {
        const int row0 = u.pm * BM + wr * 64 + fr, col0 = u.pn * BM + wc * 32 + 8 * fq;
#pragma unroll
        for (int ai = 0; ai < 2; ++ai)
#pragma unroll
            for (int m = 0; m < 4; ++m) { const size_t off = (size_t)(row0 + ai * HALF + m * 16) * DP + col0;
#pragma unroll
                for (int bj = 0; bj < 2; ++bj) { const f32x4 v0 = acc[ai][bj][m][0], v1 = acc[ai][bj][m][1];
                    const u32x4 g = *(const u32x4*)(gsrc + off + bj * HALF);
                    u32x4 w;
                    w.x = cvt_pk_bf16(bf_lo(g.x) * fast_sigmoid(v0[0]), bf_hi(g.x) * fast_sigmoid(v0[1]));
                    w.y = cvt_pk_bf16(bf_lo(g.y) * fast_sigmoid(v0[2]), bf_hi(g.y) * fast_sigmoid(v0[3]));
                    w.z = cvt_pk_bf16(bf_lo(g.z) * fast_sigmoid(v1[0]), bf_hi(g.z) * fast_sigmoid(v1[1]));
                    w.w = cvt_pk_bf16(bf_lo(g.w) * fast_sigmoid(v1[2]), bf_hi(g.w) * fast_sigmoid(v1[3]));
                    *(u32x4*)(O + off + bj * HALF) = w; }
                asm volatile("" ::: "memory"); }
    }
};
template <int CTRL> __device__ __forceinline__ float dpp_ror(float v) { return __int_as_float(__builtin_amdgcn_update_dpp(0, __float_as_int(v), CTRL, 0xf, 0xf, false)); }
struct EpiConvGate {
    static constexpr bool PERM = true, AFTER_DRAIN = false;
    bf16_t* O; float* raw; const float* cw; const float* cb; PG8_LAS unsigned char* xlds;
    __device__ __forceinline__ void operator()(const f32x4 (&acc)[2][2][4][2], const Unit& u, int wr, int wc, int fr, int fq) const {
        const int wid = wr * 4 + wc;
        PG8_LAS f32x4* ex = (PG8_LAS f32x4*)xlds;
        if (fr >= 14) {
#pragma unroll
            for (int ai = 0; ai < 2; ++ai)
#pragma unroll
                for (int bj = 0; bj < 2; ++bj)
#pragma unroll
                    for (int n = 0; n < 2; ++n) ex[((((wid * 2 + ai) * 2 + bj) * 2 + n) * 4 + fq) * 2 + (fr - 14)] = acc[ai][bj][3][n];
        }
        asm volatile("s_waitcnt lgkmcnt(0)" ::: "memory"); __builtin_amdgcn_s_barrier(); asm volatile("" ::: "memory");
        const int gcol0 = u.pn * HALF + wc * 32 + 8 * fq;
        const int row0 = u.pm * BM + wr * 64 + fr;
        if (wr == 0 && fr < 2) {
#pragma unroll
            for (int bj = 0; bj < 2; ++bj)
#pragma unroll
                for (int n = 0; n < 2; ++n) *(f32x4*)(raw + ((size_t)u.pm * 4 + fr) * FF2 + bj * FF + gcol0 + 4 * n) = acc[0][bj][0][n];
        }
        if (wr == 1 && fr >= 14) {
#pragma unroll
            for (int bj = 0; bj < 2; ++bj)
#pragma unroll
                for (int n = 0; n < 2; ++n) *(f32x4*)(raw + ((size_t)u.pm * 4 + 2 + (fr - 14)) * FF2 + bj * FF + gcol0 + 4 * n) = acc[1][bj][3][n];
        }
        unsigned outpk[2][4][2];
#pragma unroll
        for (int n = 0; n < 2; ++n) {
            const int gc = gcol0 + 4 * n;
            const f32x4 wg0 = *(const f32x4*)(cw + gc), wg1 = *(const f32x4*)(cw + FF2 + gc), wg2 = *(const f32x4*)(cw + 2 * FF2 + gc), bg = *(const f32x4*)(cb + gc);
            const f32x4 wu0 = *(const f32x4*)(cw + FF + gc), wu1 = *(const f32x4*)(cw + FF2 + FF + gc), wu2 = *(const f32x4*)(cw + 2 * FF2 + FF + gc), bu = *(const f32x4*)(cb + FF + gc);
#pragma unroll
            for (int ai = 0; ai < 2; ++ai) {
                f32x4 pg = (f32x4){0.f, 0.f, 0.f, 0.f}, pu = (f32x4){0.f, 0.f, 0.f, 0.f};
                if (!(ai == 0 && wr == 0) && fr >= 14) {
                    const int sw = (wr == 1) ? wc : 4 + wc, sai = (wr == 1) ? ai : 0;
                    pg = ex[((((sw * 2 + sai) * 2 + 0) * 2 + n) * 4 + fq) * 2 + (fr - 14)];
                    pu = ex[((((sw * 2 + sai) * 2 + 1) * 2 + n) * 4 + fq) * 2 + (fr - 14)];
                }
                f32x4 pg1, pg2, pu1, pu2;
#pragma unroll
                for (int e = 0; e < 4; ++e) { pg1[e] = dpp_ror<0x121>(pg[e]); pg2[e] = dpp_ror<0x122>(pg[e]); pu1[e] = dpp_ror<0x121>(pu[e]); pu2[e] = dpp_ror<0x122>(pu[e]); }
#pragma unroll
                for (int m = 0; m < 4; ++m) {
                    const f32x4 cg = acc[ai][0][m][n], cu = acc[ai][1][m][n];
                    float o[4];
                    f32x4 cg1, cg2, cu1, cu2;
#pragma unroll
                    for (int e = 0; e < 4; ++e) { cg1[e] = dpp_ror<0x121>(cg[e]); cg2[e] = dpp_ror<0x122>(cg[e]); cu1[e] = dpp_ror<0x121>(cu[e]); cu2[e] = dpp_ror<0x122>(cu[e]); }
#pragma unroll
                    for (int e = 0; e < 4; ++e) {
                        const float g1 = (fr == 0) ? pg1[e] : cg1[e], g2 = (fr < 2) ? pg2[e] : cg2[e], u1 = (fr == 0) ? pu1[e] : cu1[e], u2 = (fr < 2) ? pu2[e] : cu2[e];
#if MK_DEBUG_NOTAPS
                        const float gg = bg[e] + wg2[e] * cg[e] + 0.f * (g1 + g2);
                        const float uu = bu[e] + wu2[e] * cu[e] + 0.f * (u1 + u2);
#else
                        const float gg = bg[e] + wg2[e] * cg[e] + wg1[e] * g1 + wg0[e] * g2;
                        const float uu = bu[e] + wu2[e] * cu[e] + wu1[e] * u1 + wu0[e] * u2;
#endif
                        o[e] = gg * fast_sigmoid(gg) * uu;
                    }
                    pg1 = cg1; pg2 = cg2; pu1 = cu1; pu2 = cu2;
                    const unsigned p0 = cvt_pk_bf16(o[0], o[1]), p1 = cvt_pk_bf16(o[2], o[3]);
                    if (n == 0) { outpk[ai][m][0] = p0; outpk[ai][m][1] = p1; }
                    else { u32x4 w; w.x = outpk[ai][m][0]; w.y = outpk[ai][m][1]; w.z = p0; w.w = p1;
                        *(u32x4*)(O + (size_t)(row0 + ai * HALF + m * 16) * FFP + gcol0) = w; }
                }
            }
        }
    }
};

template <class Epi, class Sched, bool ALIGN_EPI = false, bool SP2 = false>
__device__ __forceinline__ void gemm_phase(PG8_LAS unsigned char* lds, const Gemm g, const Sched& S, const Epi& E) {
    const int tid = opaque_tid(), wid = __builtin_amdgcn_readfirstlane(tid >> 6), lane = tid & 63, wr = wid >> 2, wc = wid & 3, fr = lane & 15, fq = lane >> 4;
    const int K = g.K, nt = K / BK, ldk = g.ldk;
    unsigned voffA[2], voffB[2];
#pragma unroll
    for (int i = 0; i < 2; ++i) { int R, C; stage_rc(tid * 16 + i * 8192, R, C); const int Rb = Epi::PERM ? ((R & ~31) + perm32(R & 31)) : R;
        voffA[i] = (unsigned)(R * ldk + C) * 2u; voffB[i] = (unsigned)(Rb * ldk + C) * 2u; }
    const size_t kstep = (size_t)(BK * 2);
    const size_t hstep = (size_t)HALF * ldk * 2;
    const size_t tstep = 2 * hstep;
    const unsigned ldsw = (unsigned)wid * 1024u;
    const int aoff = lds_byte(wr * 64 + fr, fq * 8), boff = lds_byte(wc * 32 + fr, fq * 8);
#define PG8_SA(b, h) (((b) * 2 + (h)) * HTB)
#define PG8_SB(b, h) ((4 + (b) * 2 + (h)) * HTB)
#define PG8_STAGE(bufoff, gbase, voff) do { _Pragma("unroll") for (int _i = 0; _i < 2; ++_i) \
        __builtin_amdgcn_global_load_lds((const unsigned*)((const char*)(gbase) + (voff)[_i]), (PG8_LAS unsigned*)(lds + (bufoff) + ldsw + _i * 8192), 16, 0, 0); } while (0)
#define PG8_LDA(dst, b, h) do { _Pragma("unroll") for (int m = 0; m < 4; ++m) _Pragma("unroll") for (int k = 0; k < 2; ++k) dst[m][k] = *(const PG8_LAS bf16x8*)(lds + PG8_SA(b, h) + aoff + m * 2048 + k * 1024); } while (0)
#define PG8_LDB(dst, b, h) do { _Pragma("unroll") for (int n = 0; n < 2; ++n) _Pragma("unroll") for (int k = 0; k < 2; ++k) dst[n][k] = *(const PG8_LAS bf16x8*)(lds + PG8_SB(b, h) + boff + n * 2048 + k * 1024); } while (0)
#define PG8_MMA(ai, bj, At, Bt) do { __builtin_amdgcn_s_setprio(1); _Pragma("unroll") for (int m = 0; m < 4; ++m) _Pragma("unroll") for (int n = 0; n < 2; ++n) _Pragma("unroll") for (int k = 0; k < 2; ++k) \
        acc[ai][bj][m][n] = __builtin_amdgcn_mfma_f32_16x16x32_bf16(Bt[n][k], At[m][k], acc[ai][bj][m][n], 0, 0, 0); __builtin_amdgcn_s_setprio(0); } while (0)
#define PG8_WAIT_V(n) asm volatile("s_waitcnt vmcnt(" #n ")" ::: "memory")
#define PG8_WAIT_L(n) asm volatile("s_waitcnt lgkmcnt(" #n ")" ::: "memory")
#define PG8_BAR __builtin_amdgcn_s_barrier()
#define PG8_SCHED __builtin_amdgcn_sched_barrier(0)
    Unit cur, nxt; int ui = 0;
    if (!S.next(0, cur)) return;
    f32x4 acc[2][2][4][2];
#pragma unroll
    for (int a = 0; a < 2; ++a)
#pragma unroll
        for (int b = 0; b < 2; ++b)
#pragma unroll
            for (int m = 0; m < 4; ++m)
#pragma unroll
                for (int n = 0; n < 2; ++n) acc[a][b][m][n] = (f32x4){0.f, 0.f, 0.f, 0.f};
    bf16x8 At[4][2], B0[2][2], B1[2][2];
    const char* cA = (const char*)g.A + (size_t)cur.pm * tstep; const char* cB = (const char*)g.Bt + (size_t)cur.pn * tstep;
    S.a_ready(cur);
    if constexpr (SP2) {
        PG8_STAGE(PG8_SB(0, 0), cB, voffB); PG8_STAGE(PG8_SB(0, 1), cB + hstep, voffB); PG8_STAGE(PG8_SA(0, 0), cA, voffA); PG8_STAGE(PG8_SA(0, 1), cA + hstep, voffA);
        if (wr == 1) PG8_BAR;
        PG8_WAIT_V(2); PG8_BAR;
        PG8_STAGE(PG8_SB(1, 0), cB + kstep, voffB); PG8_STAGE(PG8_SA(1, 0), cA + kstep, voffA); PG8_STAGE(PG8_SB(1, 1), cB + hstep + kstep, voffB);
        PG8_WAIT_V(6); PG8_BAR;
    } else {
        PG8_STAGE(PG8_SB(0, 0), cB, voffB); PG8_STAGE(PG8_SA(0, 0), cA, voffA); PG8_STAGE(PG8_SB(0, 1), cB + hstep, voffB); PG8_STAGE(PG8_SA(0, 1), cA + hstep, voffA);
        if (wr == 1) PG8_BAR;
        PG8_WAIT_V(4); PG8_BAR;
        PG8_STAGE(PG8_SB(1, 0), cB + kstep, voffB); PG8_STAGE(PG8_SA(1, 0), cA + kstep, voffA); PG8_STAGE(PG8_SB(1, 1), cB + hstep + kstep, voffB);
        PG8_WAIT_V(6); PG8_BAR;
    }
    for (;;) {
        const bool has_next = S.next(ui + 1, nxt);
        const char* nA = has_next ? (const char*)g.A + (size_t)nxt.pm * tstep : cA; const char* nB = has_next ? (const char*)g.Bt + (size_t)nxt.pn * tstep : cB;
        for (int t = 0; t < nt; t += 2) {
            const bool last = (t == nt - 2);
            const char* a1 = cA + (size_t)(t + 1) * kstep;
            const char* a2 = last ? nA : cA + (size_t)(t + 2) * kstep; const char* b2 = last ? nB : cB + (size_t)(t + 2) * kstep;
            const char* a3 = a2 + kstep; const char* b3 = b2 + kstep;
            if (last && has_next) S.a_ready(nxt);
            if constexpr (SP2) {
            PG8_LDB(B0, 0, 0); PG8_LDB(B1, 0, 1); PG8_SCHED; PG8_LDA(At, 0, 0); PG8_STAGE(PG8_SA(1, 1), a1 + hstep, voffA);
            PG8_WAIT_V(8); PG8_WAIT_L(0); PG8_BAR; PG8_MMA(0, 0, At, B0); PG8_MMA(0, 1, At, B1); PG8_BAR; PG8_SCHED;
            PG8_LDA(At, 0, 1); PG8_STAGE(PG8_SB(0, 0), b2, voffB); PG8_STAGE(PG8_SB(0, 1), b2 + hstep, voffB); PG8_STAGE(PG8_SA(0, 0), a2, voffA);
            PG8_WAIT_V(8); PG8_WAIT_L(0); PG8_BAR; PG8_MMA(1, 0, At, B0); PG8_MMA(1, 1, At, B1); PG8_BAR; PG8_SCHED;
            PG8_LDB(B0, 1, 0); PG8_LDB(B1, 1, 1); PG8_SCHED; PG8_LDA(At, 1, 0); PG8_STAGE(PG8_SA(0, 1), a2 + hstep, voffA);
            PG8_WAIT_V(8); PG8_WAIT_L(0); PG8_BAR; PG8_MMA(0, 0, At, B0); PG8_MMA(0, 1, At, B1); PG8_BAR; PG8_SCHED;
            PG8_LDA(At, 1, 1); PG8_STAGE(PG8_SB(1, 0), b3, voffB); PG8_STAGE(PG8_SB(1, 1), b3 + hstep, voffB); PG8_STAGE(PG8_SA(1, 0), a3, voffA);
            PG8_WAIT_V(8); PG8_WAIT_L(0); PG8_BAR; PG8_MMA(1, 0, At, B0); PG8_MMA(1, 1, At, B1); PG8_BAR; PG8_SCHED;
            } else {
            PG8_LDB(B0, 0, 0); PG8_SCHED; PG8_LDA(At, 0, 0); PG8_STAGE(PG8_SA(1, 1), a1 + hstep, voffA);
            PG8_WAIT_L(8); PG8_BAR; PG8_WAIT_L(0); PG8_MMA(0, 0, At, B0); PG8_BAR; PG8_SCHED;
            PG8_LDB(B1, 0, 1); PG8_STAGE(PG8_SB(0, 0), b2, voffB);
            PG8_BAR; PG8_WAIT_L(0); PG8_MMA(0, 1, At, B1); PG8_BAR;
            PG8_LDA(At, 0, 1); PG8_STAGE(PG8_SA(0, 0), a2, voffA);
            PG8_BAR; PG8_WAIT_L(0); PG8_MMA(1, 0, At, B0); PG8_BAR; PG8_SCHED;
            PG8_STAGE(PG8_SB(0, 1), b2 + hstep, voffB);
            PG8_WAIT_V(6); PG8_BAR; PG8_MMA(1, 1, At, B1); PG8_BAR;
            PG8_LDB(B0, 1, 0); PG8_SCHED; PG8_LDA(At, 1, 0); PG8_STAGE(PG8_SA(0, 1), a2 + hstep, voffA);
            PG8_WAIT_L(8); PG8_BAR; PG8_WAIT_L(0); PG8_MMA(0, 0, At, B0); PG8_BAR; PG8_SCHED;
            PG8_LDB(B1, 1, 1); PG8_STAGE(PG8_SB(1, 0), b3, voffB);
            PG8_BAR; PG8_WAIT_L(0); PG8_MMA(0, 1, At, B1); PG8_BAR;
            PG8_LDA(At, 1, 1); PG8_STAGE(PG8_SA(1, 0), a3, voffA);
            PG8_BAR; PG8_WAIT_L(0); PG8_MMA(1, 0, At, B0); PG8_BAR; PG8_SCHED;
            PG8_STAGE(PG8_SB(1, 1), b3 + hstep, voffB);
            PG8_WAIT_V(6); PG8_BAR; PG8_MMA(1, 1, At, B1); PG8_BAR;
            }
        }
        if constexpr (ALIGN_EPI) { if (wr == 0) PG8_BAR; }
        if constexpr (!Epi::AFTER_DRAIN) { E(acc, cur, wr, wc, fr, fq); S.done(cur); }
        if (!has_next) break;
#pragma unroll
        for (int a = 0; a < 2; ++a)
#pragma unroll
            for (int b = 0; b < 2; ++b)
#pragma unroll
                for (int m = 0; m < 4; ++m)
#pragma unroll
                    for (int n = 0; n < 2; ++n) acc[a][b][m][n] = (f32x4){0.f, 0.f, 0.f, 0.f};
        cur = nxt; cA = nA; cB = nB; ++ui;
        if constexpr (ALIGN_EPI) { if (wr == 1) PG8_BAR; }
    }
    PG8_WAIT_V(0);
    if constexpr (!ALIGN_EPI) { if (wr == 0) PG8_BAR; }
    PG8_BAR;
    if constexpr (Epi::AFTER_DRAIN) { E.fused(acc, cur, wr, wc, fr, fq, lds, wid, lane); S.done(cur); }
#undef PG8_SA
#undef PG8_SB
#undef PG8_STAGE
#undef PG8_LDA
#undef PG8_LDB
#undef PG8_MMA
#undef PG8_WAIT_V
#undef PG8_WAIT_L
#undef PG8_BAR
#undef PG8_SCHED
}
}

constexpr size_t MiB = 1u << 20;
constexpr size_t WS_CTL = 0, CTL_ZERO_BYTES = 1 * MiB;
constexpr size_t WS_MOD = 1 * MiB;
constexpr size_t WS_S5T = 4 * MiB;
constexpr size_t WS_LSE = 8 * MiB;
constexpr size_t WS_RAW = 12 * MiB;
constexpr size_t W_AIN_B = (size_t)AIN * DP * 2, W_DD_B = (size_t)D * DP * 2, W_UP_B = (size_t)FF2 * DP * 2, W_DN_B = (size_t)D * FFP * 2;
constexpr size_t WS_WAIN = 40 * MiB, WS_WAOUT = WS_WAIN + 2 * W_AIN_B, WS_WSIN = WS_WAOUT + 2 * W_DD_B, WS_WSGATE = WS_WSIN + 2 * W_DD_B, WS_WSOUT = WS_WSGATE + 2 * W_DD_B, WS_WUP = WS_WSOUT + 2 * W_DD_B, WS_WDOWN = WS_WUP + 4 * W_UP_B;
constexpr size_t WS_H = 492 * MiB;
constexpr size_t WS_BIG = 624 * MiB;
constexpr size_t WS_END = 1520 * MiB;
static_assert(WS_WDOWN + 4 * W_DN_B <= WS_H && WS_H + (size_t)M * DP * 2 <= WS_BIG && WS_BIG + (size_t)M * AIN * 2 <= WS_END && (size_t)M * FFP * 2 <= 512 * MiB && WS_RAW + (size_t)(M / 256) * 4 * FF2 * 4 <= WS_WAIN, "d_ws map");
constexpr int S5T_WORDS = 2304;
constexpr int CW_BAR = 4096;
constexpr int RING_OFF = 0, RING_BYTES = 131072;
constexpr int LDSCTL_OFF = RING_BYTES, MISC_OFF = LDSCTL_OFF + 320;
constexpr int EXCH_OFF = RING_BYTES + 1024;
constexpr int LDS_BYTES = 147456;
static_assert(EXCH_OFF + 8192 <= LDS_BYTES && MISC_OFF + 128 <= EXCH_OFF, "LDS map");
constexpr int NWAVES = 8;

#define LAS __attribute__((address_space(3)))
typedef unsigned short bf16;
typedef float f32x4 __attribute__((ext_vector_type(4)));
typedef float f32x2 __attribute__((ext_vector_type(2)));
typedef short bf16x8 __attribute__((ext_vector_type(8)));
typedef short s16x4 __attribute__((ext_vector_type(4)));
typedef unsigned u32x4 __attribute__((ext_vector_type(4)));
typedef unsigned u32x2 __attribute__((ext_vector_type(2)));
#define LDS_WAIT() asm volatile("s_waitcnt lgkmcnt(0)" ::: "memory")
#define VM_WAIT() asm volatile("s_waitcnt vmcnt(0)" ::: "memory")
__device__ __forceinline__ unsigned f2bf(float f) { unsigned u = __builtin_bit_cast(unsigned, f); return (u + 0x7fffu + ((u >> 16) & 1u)) >> 16; }
__device__ __forceinline__ unsigned pk2(float lo, float hi) { return f2bf(lo) | (f2bf(hi) << 16); }
using pg8::cvt_pk_bf16; using pg8::bf_lo; using pg8::bf_hi;

#define XB_TMO      128
#define XB_XCNT(j)  (256  + 64 * (j))
#define XB_XSUB(j)  (1280 + 64 * (j))
#define XB_XGEN(j)  (2304 + 64 * (j))
#define XB_TOP      3328
#define XB_TOPGEN   3392
#define XCD_BAR_WORDS 3456
#define XB_SPIN_CAP (1u << 18)

__device__ __forceinline__ unsigned xb_ld(unsigned* p)              { return __hip_atomic_load(p, __ATOMIC_RELAXED, __HIP_MEMORY_SCOPE_AGENT); }
__device__ __forceinline__ unsigned xb_add(unsigned* p, unsigned v) { return __hip_atomic_fetch_add(p, v, __ATOMIC_RELAXED, __HIP_MEMORY_SCOPE_AGENT); }
__device__ __forceinline__ unsigned xb_xcc_id() { return (unsigned)__builtin_amdgcn_s_getreg((3 << 11) | 20) & 0xFu; }
#define XB_SPIN(cond, bar) do { unsigned _sp = 0; while (cond) { __builtin_amdgcn_s_sleep(1); \
    if ((++_sp & 255u) == 0u) { if (xb_ld(&(bar)[XB_TMO])) break; if (_sp > XB_SPIN_CAP) { atomicAdd(&(bar)[XB_TMO], 1u); break; } } } } while (0)

struct XcdBarrier {
    unsigned* bar; unsigned x;
    volatile LAS unsigned* st;
};

__device__ __forceinline__ XcdBarrier xcd_barrier_post(unsigned* bar, volatile LAS unsigned* st) {
    XcdBarrier b; b.bar = bar; b.x = xb_xcc_id(); b.st = st;
    if (threadIdx.x == 0) (void)xb_add(&bar[XB_XCNT(b.x)], 1u);
    return b;
}
__device__ __forceinline__ void xcd_barrier_complete(unsigned* bar, unsigned x, unsigned& nloc, unsigned& nx) {
    const unsigned G = gridDim.x * gridDim.y * gridDim.z;
    unsigned sum, cnt, mine, sp = 0u;
    for (;;) {
        sum = 0u; cnt = 0u; mine = 0u;
#pragma unroll
        for (unsigned j = 0; j < 16; ++j) { const unsigned c = xb_ld(&bar[XB_XCNT(j)]); sum += c; cnt += (c > 0u) ? 1u : 0u; mine = (j == x) ? c : mine; }
        if (sum == G) break;
        __builtin_amdgcn_s_sleep(1);
        if ((++sp & 255u) == 0u) { if (xb_ld(&bar[XB_TMO])) break; if (sp > XB_SPIN_CAP) { atomicAdd(&bar[XB_TMO], 1u); break; } }
    }
    nloc = mine > 0u ? mine : 1u; nx = cnt > 0u ? cnt : 1u;
}

__device__ __forceinline__ void xcd_barrier(const XcdBarrier& b) {
    asm volatile("s_waitcnt vmcnt(0)" ::: "memory");
    __syncthreads();
    if (threadIdx.x == 0) {
        unsigned* bar = b.bar;
        __builtin_amdgcn_s_waitcnt(0);
        unsigned nloc = b.st[0], nx = b.st[1];
        if (nloc == 0u) { xcd_barrier_complete(bar, b.x, nloc, nx); b.st[0] = nloc; b.st[1] = nx; }
        const unsigned old = xb_add(&bar[XB_XSUB(b.x)], 1u);
        const unsigned gen = old / nloc;
        if (old + 1u == (gen + 1u) * nloc) {
            __builtin_amdgcn_fence(__ATOMIC_RELEASE, "agent");
            asm volatile("s_waitcnt vmcnt(0)" ::: "memory");
            const unsigned og = xb_add(&bar[XB_TOP], 1u);
            const unsigned tg = og / nx;
            if (og + 1u == (tg + 1u) * nx) xb_add(&bar[XB_TOPGEN], 1u);
            else XB_SPIN(xb_ld(&bar[XB_TOPGEN]) == tg, bar);
            __builtin_amdgcn_fence(__ATOMIC_ACQUIRE, "agent");
            xb_add(&bar[XB_XGEN(b.x)], 1u);
            asm volatile("s_waitcnt vmcnt(0)" ::: "memory");
        } else {
            XB_SPIN(xb_ld(&bar[XB_XGEN(b.x)]) == gen, bar);
            __builtin_amdgcn_fence(__ATOMIC_ACQUIRE, "agent");
            asm volatile("s_waitcnt vmcnt(0)" ::: "memory");
        }
    }
    __syncthreads();
}

struct Frame {
    LAS unsigned char* lds;
    volatile LAS unsigned* MISC;
    unsigned* ctl;
    int tid, lane, wave;
    int vcu, G;
    unsigned char* ws; float* out;
};
__device__ __forceinline__ void frame_refresh(Frame& F, unsigned char* ws, float* out) {
    asm volatile("" : "+s"(ws)); asm volatile("" : "+s"(out)); F.ws = ws; F.out = out; F.ctl = (unsigned*)(ws + WS_CTL);
    F.tid = pg8::opaque_tid(); F.lane = F.tid & 63; F.wave = __builtin_amdgcn_readfirstlane(F.tid >> 6);
    const int bx = pg8::opaque_bid(); F.vcu = (F.G % 8 == 0) ? (bx % 8) * (F.G / 8) + bx / 8 : bx;
}
template <int CTRL> __device__ __forceinline__ float dpp_mov(float v) { return __int_as_float(__builtin_amdgcn_update_dpp(0, __float_as_int(v), CTRL, 0xf, 0xf, false)); }
__device__ __forceinline__ float wave_sum(float v) {
    v += dpp_mov<0xB1>(v);
    v += dpp_mov<0x4E>(v);
    v += dpp_mov<0x141>(v);
    v += dpp_mov<0x140>(v);
    const float s0 = __int_as_float(__builtin_amdgcn_readlane(__float_as_int(v), 0)), s1 = __int_as_float(__builtin_amdgcn_readlane(__float_as_int(v), 16));
    const float s2 = __int_as_float(__builtin_amdgcn_readlane(__float_as_int(v), 32)), s3 = __int_as_float(__builtin_amdgcn_readlane(__float_as_int(v), 48));
    return (s0 + s1) + (s2 + s3);
}
__device__ __forceinline__ float xrow_max(float v) {
    { const auto r = __builtin_amdgcn_permlane16_swap(__float_as_uint(v), __float_as_uint(v), false, false); v = fmaxf(__uint_as_float(r[0]), __uint_as_float(r[1])); }
    { const auto r = __builtin_amdgcn_permlane32_swap(__float_as_uint(v), __float_as_uint(v), false, false); v = fmaxf(__uint_as_float(r[0]), __uint_as_float(r[1])); }
    return v;
}
__device__ __forceinline__ float xrow_sum(float v) {
    { const auto r = __builtin_amdgcn_permlane16_swap(__float_as_uint(v), __float_as_uint(v), false, false); v = __uint_as_float(r[0]) + __uint_as_float(r[1]); }
    { const auto r = __builtin_amdgcn_permlane32_swap(__float_as_uint(v), __float_as_uint(v), false, false); v = __uint_as_float(r[0]) + __uint_as_float(r[1]); }
    return v;
}

__device__ __forceinline__ void p0_transpose_item(const float* W, int K, int N, bf16* WT, int k0, int n0, int dst_row0, LAS float* scr, int lane) {
#pragma unroll 8
    for (int i = 0; i < 32; ++i) { const int kk = 2 * i + (lane >> 5); scr[kk * 33 + (lane & 31)] = W[(size_t)(k0 + kk) * N + n0 + (lane & 31)]; }
    LDS_WAIT(); asm volatile("" ::: "memory");
    const int c = lane & 7;
#pragma unroll
    for (int j = 0; j < 4; ++j) { const int n = (lane >> 3) + 8 * j; const LAS float* s = scr + (8 * c) * 33 + n;
        u32x4 o; o.x = pk2(s[0 * 33], s[1 * 33]); o.y = pk2(s[2 * 33], s[3 * 33]); o.z = pk2(s[4 * 33], s[5 * 33]); o.w = pk2(s[6 * 33], s[7 * 33]);
        *(u32x4*)(WT + (size_t)(dst_row0 + n) * (K + KPAD) + k0 + 8 * c) = o; }
    LDS_WAIT(); asm volatile("" ::: "memory");
}
struct P0In { const float *c, *ada_w, *ada_b, *attn_w_in, *attn_w_out, *ssm_w_in, *log_step, *a_re, *a_im, *b_re, *b_im, *c_re, *c_im, *ssm_w_gate, *ssm_w_out, *ffn_w_up, *ffn_w_down; };

__device__ __forceinline__ void p0_ada_unit(Frame& F, const P0In& in, int unit) {
    LAS float* csl = (LAS float*)(F.lds + RING_OFF);
    for (int idx = F.tid; idx < BATCH * D; idx += NWAVES * 64) { const int b = idx / D, k = idx % D; const float v = in.c[idx]; csl[k * 16 + b] = v / (1.0f + __expf(-v)); }
    __syncthreads();
    const int li = unit >> 6, c0 = (unit & 63) * 192 + F.lane;
    const float* W = in.ada_w + (size_t)li * D * MODW + c0;
    float acc[3][16];
#pragma unroll
    for (int c = 0; c < 3; ++c)
#pragma unroll
        for (int b = 0; b < 16; ++b) acc[c][b] = 0.f;
    const int kbeg = F.wave * 256;
#pragma unroll 4
    for (int k = kbeg; k < kbeg + 256; ++k) {
        const float w0 = W[(size_t)k * MODW], w1 = W[(size_t)k * MODW + 64], w2 = W[(size_t)k * MODW + 128];
        const LAS f32x4* cp = (const LAS f32x4*)(csl + k * 16);
        const f32x4 s0 = cp[0], s1 = cp[1], s2 = cp[2], s3 = cp[3];
        const float cs[16] = {s0[0], s0[1], s0[2], s0[3], s1[0], s1[1], s1[2], s1[3], s2[0], s2[1], s2[2], s2[3], s3[0], s3[1], s3[2], s3[3]};
#pragma unroll
        for (int b = 0; b < 16; ++b) { acc[0][b] += w0 * cs[b]; acc[1][b] += w1 * cs[b]; acc[2][b] += w2 * cs[b]; }
    }
    __syncthreads();
    LAS float* part = (LAS float*)(F.lds + RING_OFF);
#pragma unroll
    for (int c = 0; c < 3; ++c)
#pragma unroll
        for (int b = 0; b < 16; ++b) part[(F.wave * 16 + b) * 192 + c * 64 + F.lane] = acc[c][b];
    __syncthreads();
    float* mod = (float*)(F.ws + WS_MOD);
    for (int o = F.tid; o < 16 * 192; o += NWAVES * 64) { const int b = o / 192, cc = o % 192; float s = 0.f;
#pragma unroll
        for (int w = 0; w < 8; ++w) s += part[(w * 16 + b) * 192 + cc];
        const int n = (unit & 63) * 192 + cc; mod[((size_t)li * BATCH + b) * MODW + n] = s + in.ada_b[(size_t)li * MODW + n]; }
    __syncthreads();
}
__device__ __forceinline__ void s5_coef(const P0In& in, int jg, int p, float& lbr, float& lbi, float& cfr, float& cfi) {
    const float step = __expf(in.log_step[jg]);
    const float lr = in.a_re[(size_t)jg * SP + p], li = in.a_im[(size_t)jg * SP + p];
    const float mag = expf(lr * step), ang = li * step;
    lbr = mag * cosf(ang); lbi = mag * sinf(ang);
    const float nr = lbr - 1.0f, ni = lbi, den = lr * lr + li * li;
    cfr = (nr * lr + ni * li) / den; cfi = (ni * lr - nr * li) / den;
}
__device__ __forceinline__ void p0_s5_tables(Frame& F, const P0In& in, int jg) {
    unsigned* tab = (unsigned*)(F.ws + WS_S5T) + (size_t)jg * S5T_WORDS;
    const int t = F.tid;
    if (t < 64) {
        float lbr, lbi, cfr, cfi; s5_coef(in, jg, t, lbr, lbi, cfr, cfi);
        float ar = lbr, ai = lbi;
#pragma unroll
        for (int s = 0; s < 7; ++s) { const float nr = ar * ar - ai * ai, ni = 2.0f * ar * ai; ar = nr; ai = ni; }
        tab[t] = __float_as_uint(lbr); tab[64 + t] = __float_as_uint(lbi); tab[128 + t] = __float_as_uint(ar); tab[192 + t] = __float_as_uint(ai);
    }
    {
        const int tau = t >> 6, lane = t & 63, q = tau >> 1, part = tau & 1, p = 16 * q + (lane & 15), c0 = 4 * (lane >> 4);
        float lbr, lbi, cfr, cfi; s5_coef(in, jg, p, lbr, lbi, cfr, cfi);
        const float* br = in.b_re + ((size_t)jg * SP + p) * SG + c0; const float* bi = in.b_im + ((size_t)jg * SP + p) * SG + c0;
        float v[4];
#pragma unroll
        for (int j = 0; j < 4; ++j) v[j] = part ? (cfr * bi[j] + cfi * br[j]) : (cfr * br[j] - cfi * bi[j]);
        tab[256 + (tau * 64 + lane) * 2 + 0] = pk2(v[0], v[1]); tab[256 + (tau * 64 + lane) * 2 + 1] = pk2(v[2], v[3]);
    }
    if (t < 256) {
        const int q = t >> 6, lane = t & 63, c = lane & 15, g4 = lane >> 4;
        const float* cr = in.c_re + ((size_t)jg * SG + c) * SP + 16 * q + 4 * g4; const float* ci = in.c_im + ((size_t)jg * SG + c) * SP + 16 * q + 4 * g4;
        unsigned* o = tab + 1280 + (q * 64 + lane) * 4;
        o[0] = pk2(cr[0], cr[1]); o[1] = pk2(cr[2], cr[3]); o[2] = pk2(-ci[0], -ci[1]); o[3] = pk2(-ci[2], -ci[3]);
    }
}
__device__ __forceinline__ void p0_prologue(Frame& F, const P0In& in) {
    for (int u = F.vcu; u < 256; u += F.G) p0_ada_unit(F, in, u);
    for (int u = F.vcu; u < 2 * NG; u += F.G) p0_s5_tables(F, in, u);
    LAS float* scr = (LAS float*)(F.lds + RING_OFF + F.wave * 16384);
    const int gw = F.vcu * NWAVES + F.wave, NGW = F.G * NWAVES;
    constexpr int I_AIN = (D / 64) * (AIN / 32), I_DD = (D / 64) * (D / 32), I_UP = (D / 64) * (FF2 / 32), I_DN = (FF / 64) * (D / 32);
    constexpr int C0 = 2 * I_AIN, C1 = C0 + 2 * I_DD, C2 = C1 + 2 * I_DD, C3 = C2 + 2 * I_DD, C4 = C3 + 2 * I_DD, C5 = C4 + 4 * I_UP, C6 = C5 + 4 * I_DN;
    for (int it = gw; it < C6; it += NGW) {
        const float* W; bf16* WT; int K, N, r; bool up = false;
        if (it < C0)      { r = it;      const int j = r / I_AIN; r -= j * I_AIN; K = D; N = AIN; W = in.attn_w_in + (size_t)j * D * AIN;  WT = (bf16*)(F.ws + WS_WAIN + j * W_AIN_B); }
        else if (it < C1) { r = it - C0; const int j = r / I_DD;  r -= j * I_DD;  K = D; N = D;   W = in.attn_w_out + (size_t)j * D * D;   WT = (bf16*)(F.ws + WS_WAOUT + j * W_DD_B); }
        else if (it < C2) { r = it - C1; const int j = r / I_DD;  r -= j * I_DD;  K = D; N = D;   W = in.ssm_w_in + (size_t)j * D * D;     WT = (bf16*)(F.ws + WS_WSIN + j * W_DD_B); }
        else if (it < C3) { r = it - C2; const int j = r / I_DD;  r -= j * I_DD;  K = D; N = D;   W = in.ssm_w_gate + (size_t)j * D * D;   WT = (bf16*)(F.ws + WS_WSGATE + j * W_DD_B); }
        else if (it < C4) { r = it - C3; const int j = r / I_DD;  r -= j * I_DD;  K = D; N = D;   W = in.ssm_w_out + (size_t)j * D * D;    WT = (bf16*)(F.ws + WS_WSOUT + j * W_DD_B); }
        else if (it < C5) { r = it - C4; const int j = r / I_UP;  r -= j * I_UP;  K = D; N = FF2; W = in.ffn_w_up + (size_t)j * D * FF2;   WT = (bf16*)(F.ws + WS_WUP + j * W_UP_B); up = true; }
        else              { r = it - C5; const int j = r / I_DN;  r -= j * I_DN;  K = FF; N = D;  W = in.ffn_w_down + (size_t)j * FF * D;  WT = (bf16*)(F.ws + WS_WDOWN + j * W_DN_B); }
        const int nblk = N / 32, kb = r / nblk, nb = r % nblk, n0 = 32 * nb;
        int drow = n0;
        if (up) { const int half = n0 >= FF ? 1 : 0, nn = n0 - half * FF; drow = 256 * (nn >> 7) + 128 * half + (nn & 127); }
        p0_transpose_item(W, K, N, WT, 64 * kb, n0, drow, scr, F.lane);
    }
}

__device__ __forceinline__ void norm_mod_phase(Frame& F, const float* xin, bf16* hout, const float* gain, const float* modl, int sh_off, int sc_off) {
    const int gw = F.vcu * NWAVES + F.wave, NGW = F.G * NWAVES;
    for (int blk = gw; blk < M / 16; blk += NGW) {
        const int row0 = blk * 16, b = row0 / T;
        f32x4 A[8], Bv[8];
#pragma unroll
        for (int j = 0; j < 8; ++j) { const int col = 4 * F.lane + 256 * j;
            const f32x4 g = *(const f32x4*)(gain + col), sc = *(const f32x4*)(modl + (size_t)b * MODW + sc_off + col);
            A[j] = g * (sc + 1.0f); Bv[j] = *(const f32x4*)(modl + (size_t)b * MODW + sh_off + col); }
        f32x4 cur[8], nxt[8];
#pragma unroll
        for (int j = 0; j < 8; ++j) cur[j] = *(const f32x4*)(xin + (size_t)row0 * D + 4 * F.lane + 256 * j);
        for (int r = 0; r < 16; ++r) {
            const int rn = (r + 1 < 16) ? r + 1 : r;
#pragma unroll
            for (int j = 0; j < 8; ++j) nxt[j] = *(const f32x4*)(xin + (size_t)(row0 + rn) * D + 4 * F.lane + 256 * j);
            float ss = 0.f;
#pragma unroll
            for (int j = 0; j < 8; ++j) ss += (cur[j][0] * cur[j][0] + cur[j][1] * cur[j][1]) + (cur[j][2] * cur[j][2] + cur[j][3] * cur[j][3]);
            const float rstd = __builtin_amdgcn_rsqf(wave_sum(ss) * (1.0f / D) + EPS);
            unsigned long long* o8 = (unsigned long long*)(hout + (size_t)(row0 + r) * DP) + F.lane;
#pragma unroll
            for (int j = 0; j < 8; ++j) { const f32x4 v = cur[j] * rstd * A[j] + Bv[j];
                o8[64 * j] = (unsigned long long)cvt_pk_bf16(v[0], v[1]) | ((unsigned long long)cvt_pk_bf16(v[2], v[3]) << 32); }
#pragma unroll
            for (int j = 0; j < 8; ++j) cur[j] = nxt[j];
        }
    }
}
__device__ __forceinline__ void final_norm_phase(Frame& F, const float* xin, float* out, const float* gain) {
    const int gw = F.vcu * NWAVES + F.wave, NGW = F.G * NWAVES;
    f32x4 A[8];
#pragma unroll
    for (int j = 0; j < 8; ++j) A[j] = *(const f32x4*)(gain + 4 * F.lane + 256 * j);
    for (int blk = gw; blk < M / 16; blk += NGW) {
        const int row0 = blk * 16;
        for (int r = 0; r < 16; ++r) {
            f32x4 cur[8];
#pragma unroll
            for (int j = 0; j < 8; ++j) cur[j] = *(const f32x4*)(xin + (size_t)(row0 + r) * D + 4 * F.lane + 256 * j);
            float ss = 0.f;
#pragma unroll
            for (int j = 0; j < 8; ++j) ss += (cur[j][0] * cur[j][0] + cur[j][1] * cur[j][1]) + (cur[j][2] * cur[j][2] + cur[j][3] * cur[j][3]);
            const float rstd = __builtin_amdgcn_rsqf(wave_sum(ss) * (1.0f / D) + EPS);
#pragma unroll
            for (int j = 0; j < 8; ++j) *(f32x4*)(out + (size_t)(row0 + r) * D + 4 * F.lane + 256 * j) = cur[j] * rstd * A[j];
        }
    }
}

__device__ __forceinline__ void conv_fix_phase(Frame& F, const float* raw, bf16* aout, const float* cw, const float* cb) {
    const int gt = (F.vcu * NWAVES + F.wave) * 64 + F.lane, NT = F.G * NWAVES * 64;
    constexpr int C4 = FF / 4, NITEM = 112 * 2 * C4;
    for (int it = gt; it < NITEM; it += NT) {
        const int c4 = it % C4, rr = (it / C4) & 1, bi = it / (2 * C4), pm = (bi / 7) * 8 + 1 + (bi % 7), gc = 4 * c4;
        const float* r_m2 = raw + ((size_t)(pm - 1) * 4 + 2) * FF2; const float* r_m1 = raw + ((size_t)(pm - 1) * 4 + 3) * FF2;
        const float* r_0 = raw + ((size_t)pm * 4 + 0) * FF2;       const float* r_1 = raw + ((size_t)pm * 4 + 1) * FF2;
        const float* pc = rr ? r_1 : r_0; const float* p1 = rr ? r_0 : r_m1; const float* p2 = rr ? r_m1 : r_m2;
        float o[4];
        const f32x4 cg = *(const f32x4*)(pc + gc), g1 = *(const f32x4*)(p1 + gc), g2 = *(const f32x4*)(p2 + gc);
        const f32x4 cu = *(const f32x4*)(pc + FF + gc), u1 = *(const f32x4*)(p1 + FF + gc), u2 = *(const f32x4*)(p2 + FF + gc);
        const f32x4 wg0 = *(const f32x4*)(cw + gc), wg1 = *(const f32x4*)(cw + FF2 + gc), wg2 = *(const f32x4*)(cw + 2 * FF2 + gc), bg = *(const f32x4*)(cb + gc);
        const f32x4 wu0 = *(const f32x4*)(cw + FF + gc), wu1 = *(const f32x4*)(cw + FF2 + FF + gc), wu2 = *(const f32x4*)(cw + 2 * FF2 + FF + gc), bu = *(const f32x4*)(cb + FF + gc);
#pragma unroll
        for (int e = 0; e < 4; ++e) { const float gg = bg[e] + wg2[e] * cg[e] + wg1[e] * g1[e] + wg0[e] * g2[e], uu = bu[e] + wu2[e] * cu[e] + wu1[e] * u1[e] + wu0[e] * u2[e];
            o[e] = gg * pg8::fast_sigmoid(gg) * uu; }
        u32x2 w; w.x = cvt_pk_bf16(o[0], o[1]); w.y = cvt_pk_bf16(o[2], o[3]);
        *(u32x2*)(aout + (size_t)(pm * 256 + rr) * FFP + gc) = w;
    }
}

namespace att {
constexpr int SLOT = 32768, K_OFF = 0, V_OFF = 65536;
__device__ __forceinline__ int kswz(int row, int colB) { return row * 256 + (colB ^ ((row & 15) << 4)); }
__device__ __forceinline__ int vperm(int k) { return (k & ~0xC) | ((k & 4) << 1) | ((k & 8) >> 1); }
__device__ __forceinline__ int voff(int row, int ch) { return 256 * row + 16 * (ch ^ (((row & 3) << 2) | ((row >> 2) & 3))); }
__device__ __forceinline__ s16x4 tr_read(int addr) { s16x4 r; asm volatile("ds_read_b64_tr_b16 %0, %1" : "=&v"(r) : "v"(addr) : "memory"); return r; }
struct Stg { u32x4 k[4], v[4]; };
}
__device__ __forceinline__ void attn_phase(Frame& F, bf16* proj, bf16* obuf, float* lse) {
    using namespace att;
    const int w = F.wave;
    for (int unit = F.vcu; unit < BATCH * NH; unit += F.G) {
        const int b = unit >> 4, h = unit & 15;
        bf16* qbase = proj + (size_t)unit * 3 * T * HD; const bf16* kbase = proj + pg8::QK_PART + (size_t)unit * 3 * T * HD; const bf16* vbase = proj + 2 * pg8::QK_PART + (size_t)unit * T * HD;
        const float c1 = 0.08838834764831845f * 1.4426950408889634f;
        const float slope2 = exp2f(-0.5f * (float)(h + 1)) * 1.4426950408889634f;
        Stg st;
        int tid = F.tid;
#define ATT_LANE() asm volatile("" : "+v"(tid)); const int lane = tid & 63, q16 = lane & 15, g4 = lane >> 4, skey = tid >> 4, sch = tid & 15
#define ATT_DECODE(bu, grp, dil, cls, n) const int grp = 2 - ((bu) >> 4), dil = 1 << (2 * grp), nbk = 16 >> (2 * grp), cls = ((bu) & 15) / nbk, n = ((bu) & 15) % nbk
#define ATT_LOAD(bu) do { ATT_DECODE(bu, grp_, dil_, cls_, n_); const bf16* kb_ = kbase + (size_t)grp_ * T * HD + (size_t)(cls_ * (T >> (2 * grp_)) + 128 * n_) * HD + sch * 8; \
            _Pragma("unroll") for (int i = 0; i < 4; ++i) { const int key_ = skey + 32 * i; \
            st.k[i] = *(const u32x4*)(kb_ + (size_t)key_ * HD); st.v[i] = *(const u32x4*)(vbase + (size_t)((128 * n_ + key_) * dil_ + cls_) * HD + sch * 8); } } while (0)
#define ATT_WRITE(slot) do { _Pragma("unroll") for (int i = 0; i < 4; ++i) { const int key_ = skey + 32 * i; \
            *(LAS u32x4*)(F.lds + K_OFF + (slot) * SLOT + kswz(key_, sch * 16)) = st.k[i]; *(LAS u32x4*)(F.lds + V_OFF + (slot) * SLOT + voff(vperm(key_), sch)) = st.v[i]; } } while (0)
        { ATT_LANE(); (void)q16; (void)g4; (void)lane;
        ATT_LOAD(0);
        { unsigned z0 = 0u; asm volatile("" : "+v"(z0));
          for (int i = tid; i < SLOT / 16; i += NWAVES * 64) *(LAS u32x4*)(F.lds + V_OFF + SLOT + i * 16) = (u32x4){z0, z0, z0, z0}; }
        ATT_WRITE(0); }
        __syncthreads();
        for (int bu = 0; bu < 48; ++bu) {
            ATT_LANE();
            ATT_DECODE(bu, grp, dil, cls, n);
            const int cur = bu & 1, prev = cur ^ 1;
            const int cpq = 128 * n + 16 * w + q16;
            const size_t rowq = (size_t)b * T + (size_t)cpq * dil + cls;
            bf16* qp = qbase + ((size_t)grp * T + cls * (T >> (2 * grp)) + cpq) * HD;
            bf16x8 qf[4];
#pragma unroll
            for (int ks = 0; ks < 4; ++ks) qf[ks] = *(const bf16x8*)(qp + 32 * ks + 8 * g4);
            if (bu + 1 < 48) ATT_LOAD(bu + 1);
            f32x4 s[9];
            int kx[4];
#pragma unroll
            for (int ks = 0; ks < 4; ++ks) kx[ks] = q16 * 256 + ((64 * ks + 16 * g4) ^ (q16 << 4));
            const int ring0 = prev * SLOT;
#pragma unroll
            for (int t = 0; t < 9; ++t) { const int base = K_OFF + (((w + t) * 4096 + ring0) & 0xFFFF);
                s[t] = (f32x4){0.f, 0.f, 0.f, 0.f};
#pragma unroll
                for (int ks = 0; ks < 4; ++ks) { const bf16x8 kf = *(const LAS bf16x8*)(F.lds + base + kx[ks]); s[t] = __builtin_amdgcn_mfma_f32_16x16x32_bf16(kf, qf[ks], s[t], 0, 0, 0); }
                if (t & 1) __builtin_amdgcn_sched_barrier(0); }
            const float c2 = slope2 * (float)dil;
            float mx = -__builtin_inff();
#pragma unroll
            for (int t = 0; t < 9; ++t) { const bool tv = (n > 0) || (t >= 8 - w);
#pragma unroll
                for (int i = 0; i < 4; ++i) { const int kk = 4 * g4 + i; const float dist = (float)(128 - 16 * t + q16 - kk);
                    bool valid = tv; if (t == 0) valid = valid && (kk >= q16); if (t == 8) valid = valid && (kk <= q16);
                    const float z = valid ? (s[t][i] * c1 - c2 * dist) : -__builtin_inff(); s[t][i] = z; mx = fmaxf(mx, z); } }
            mx = xrow_max(mx);
            float l = 0.f;
            u32x2 pp[10];
#pragma unroll
            for (int t = 0; t < 9; ++t) { float p[4];
#pragma unroll
                for (int i = 0; i < 4; ++i) { p[i] = __builtin_amdgcn_exp2f(s[t][i] - mx); l += p[i]; }
                pp[t].x = cvt_pk_bf16(p[0], p[1]); pp[t].y = cvt_pk_bf16(p[2], p[3]); }
            pp[9].x = 0u; pp[9].y = 0u;
            l = xrow_sum(l);
            f32x4 o[8];
#pragma unroll
            for (int dt = 0; dt < 8; ++dt) o[dt] = (f32x4){0.f, 0.f, 0.f, 0.f};
            const int lq = (lane >> 2) & 3, lp = lane & 3;
            const int vmask = (lq << 2) | (2 * (g4 & 1) + (g4 >> 1));
            const int vlane = 256 * (8 * (g4 & 1) + 4 * (g4 >> 1) + lq) + 8 * (lp & 1), vpart = ((lp >> 1) ^ vmask) << 4;
#pragma unroll
            for (int pr = 0; pr < 5; ++pr) {
                const int ta = 2 * pr, tb = (pr < 4) ? 2 * pr + 1 : 2 * pr;
                const int basea = V_OFF + (((w + ta) * 4096 + ring0) & 0xFFFF) + vlane, baseb = V_OFF + (((w + tb) * 4096 + ring0) & 0xFFFF) + vlane;
                u32x4 pw; pw.x = pp[2 * pr].x; pw.y = pp[2 * pr].y; pw.z = pp[2 * pr + 1].x; pw.w = pp[2 * pr + 1].y;
                const bf16x8 pa = __builtin_bit_cast(bf16x8, pw);
#pragma unroll
                for (int dh = 0; dh < 2; ++dh) {
                    s16x4 va[4], vb[4];
#pragma unroll
                    for (int d = 0; d < 4; ++d) { const int dt = 4 * dh + d; va[d] = tr_read(basea + (vpart ^ (dt << 5))); vb[d] = tr_read(baseb + (vpart ^ (dt << 5))); }
                    asm volatile("s_waitcnt lgkmcnt(0)" ::: "memory"); __builtin_amdgcn_sched_barrier(0);
#pragma unroll
                    for (int d = 0; d < 4; ++d) { const int dt = 4 * dh + d; const bf16x8 vf = (bf16x8){va[d][0], va[d][1], va[d][2], va[d][3], vb[d][0], vb[d][1], vb[d][2], vb[d][3]};
                        o[dt] = __builtin_amdgcn_mfma_f32_16x16x32_bf16(vf, pa, o[dt], 0, 0, 0); }
                    __builtin_amdgcn_sched_barrier(0);
                }
            }
            const float inv = 1.0f / l, lse2 = mx + __builtin_amdgcn_logf(l);
            if (grp > 0) {
#pragma unroll
                for (int dt = 0; dt < 8; ++dt) { u32x2 wv; wv.x = cvt_pk_bf16(o[dt][0] * inv, o[dt][1] * inv); wv.y = cvt_pk_bf16(o[dt][2] * inv, o[dt][3] * inv);
                    *(u32x2*)(qp + 16 * dt + 4 * g4) = wv; }
                if (g4 == 0) lse[((size_t)(grp - 1) * M + rowq) * NH + h] = lse2;
            } else {
                const float l1 = lse[((size_t)0 * M + rowq) * NH + h], l2 = lse[((size_t)1 * M + rowq) * NH + h];
                const float mm = fmaxf(lse2, fmaxf(l1, l2));
                float w0 = __builtin_amdgcn_exp2f(lse2 - mm), w1 = __builtin_amdgcn_exp2f(l1 - mm), w2 = __builtin_amdgcn_exp2f(l2 - mm);
                const float wi = 1.0f / (w0 + w1 + w2); w0 *= wi * inv; w1 *= wi; w2 *= wi;
                const int tq = cpq;
                const bf16* o1p = qbase + ((size_t)1 * T + (tq & 3) * (T >> 2) + (tq >> 2)) * HD; const bf16* o2p = qbase + ((size_t)2 * T + (tq & 15) * (T >> 4) + (tq >> 4)) * HD;
                bf16* op = obuf + rowq * DP + h * HD;
#pragma unroll
                for (int dt = 0; dt < 8; ++dt) { const u32x2 a1 = *(const u32x2*)(o1p + 16 * dt + 4 * g4), a2 = *(const u32x2*)(o2p + 16 * dt + 4 * g4);
                    const float r0 = w0 * o[dt][0] + w1 * bf_lo(a1.x) + w2 * bf_lo(a2.x), r1 = w0 * o[dt][1] + w1 * bf_hi(a1.x) + w2 * bf_hi(a2.x);
                    const float r2 = w0 * o[dt][2] + w1 * bf_lo(a1.y) + w2 * bf_lo(a2.y), r3 = w0 * o[dt][3] + w1 * bf_hi(a1.y) + w2 * bf_hi(a2.y);
                    u32x2 wv; wv.x = cvt_pk_bf16(r0, r1); wv.y = cvt_pk_bf16(r2, r3); *(u32x2*)(op + 16 * dt + 4 * g4) = wv;
                    if ((dt & 3) == 3) __builtin_amdgcn_sched_barrier(0); }
            }
            if (bu == 31) VM_WAIT();
            __syncthreads();
            if (bu == 31) { __builtin_amdgcn_fence(__ATOMIC_ACQUIRE, "agent"); }
            if (bu + 1 < 48) ATT_WRITE(prev);
            __syncthreads();
        }
#undef ATT_DECODE
#undef ATT_LANE
#undef ATT_LOAD
#undef ATT_WRITE
    }
}

template <int CTRL> __device__ __forceinline__ float dpp_shr0(float v) { return __int_as_float(__builtin_amdgcn_update_dpp(0, __float_as_int(v), CTRL, 0xf, 0xf, true)); }
__device__ __forceinline__ float gelu_tanh(float v) {
    const float inner = 0.7978845608028654f * (v + 0.044715f * v * v * v);
    return v * __builtin_amdgcn_rcpf(1.0f + __builtin_amdgcn_exp2f(-2.8853900817779268f * inner));
}
__device__ __forceinline__ void s5_phase(Frame& F, const bf16* U, bf16* Gout, const unsigned* tabl, const float* dskip) {
    typedef __attribute__((address_space(1))) const bf16 gcbf; typedef __attribute__((address_space(1))) bf16 gbf;
    int tid = F.tid;
#define S5_LANE() asm volatile("" : "+v"(tid)); const int lane = tid & 63, vs = lane & 15, g4 = lane >> 4; (void)vs
    for (int unit = F.vcu; unit < BATCH * (NG / 8); unit += F.G) {
        const int b = unit >> 4, g = (unit & 15) * 8 + F.wave;
        const unsigned* tab = tabl + (size_t)g * S5T_WORDS;
        float lr[4][4], li[4][4], xr[4][4], xi[4][4];
        s16x4 bbf[8];
        { S5_LANE();
#pragma unroll
        for (int q = 0; q < 4; ++q)
#pragma unroll
            for (int i = 0; i < 4; ++i) { const int p = 16 * q + 4 * g4 + i; lr[q][i] = __uint_as_float(tab[p]); li[q][i] = __uint_as_float(tab[64 + p]); xr[q][i] = 0.f; xi[q][i] = 0.f; }
#pragma unroll
        for (int tau = 0; tau < 8; ++tau) bbf[tau] = *(const s16x4*)(tab + 256 + (tau * 64 + lane) * 2); }
        const f32x4 zero4 = (f32x4){0.f, 0.f, 0.f, 0.f};
        { S5_LANE();
        gcbf* upt = (gcbf*)(U + ((size_t)b * T + 128 * vs) * D + g * SG + 4 * g4);
#pragma unroll 2
        for (int tt = 0; tt < 128; ++tt, upt += D) {
            const s16x4 ub = *(const __attribute__((address_space(1))) s16x4*)upt;
#pragma unroll
            for (int q = 0; q < 4; ++q) {
                const f32x4 br = __builtin_amdgcn_mfma_f32_16x16x16bf16_1k(bbf[2 * q], ub, zero4, 0, 0, 0), bi = __builtin_amdgcn_mfma_f32_16x16x16bf16_1k(bbf[2 * q + 1], ub, zero4, 0, 0, 0);
#pragma unroll
                for (int i = 0; i < 4; ++i) { const float nr = lr[q][i] * xr[q][i] - li[q][i] * xi[q][i] + br[i], ni = lr[q][i] * xi[q][i] + li[q][i] * xr[q][i] + bi[i]; xr[q][i] = nr; xi[q][i] = ni; }
            }
        } }
        {
            S5_LANE();
            float ar[4][4], ai[4][4];
#pragma unroll
            for (int q = 0; q < 4; ++q)
#pragma unroll
                for (int i = 0; i < 4; ++i) { const int p = 16 * q + 4 * g4 + i; ar[q][i] = __uint_as_float(tab[128 + p]); ai[q][i] = __uint_as_float(tab[192 + p]); }
#define S5_STEP(CTRL) do { _Pragma("unroll") for (int q = 0; q < 4; ++q) _Pragma("unroll") for (int i = 0; i < 4; ++i) { \
                const float nbr = dpp_shr0<CTRL>(xr[q][i]), nbi = dpp_shr0<CTRL>(xi[q][i]); \
                xr[q][i] += ar[q][i] * nbr - ai[q][i] * nbi; xi[q][i] += ar[q][i] * nbi + ai[q][i] * nbr; \
                const float sr = ar[q][i] * ar[q][i] - ai[q][i] * ai[q][i], si = 2.0f * ar[q][i] * ai[q][i]; ar[q][i] = sr; ai[q][i] = si; } } while (0)
            S5_STEP(0x111); S5_STEP(0x112); S5_STEP(0x114); S5_STEP(0x118);
#undef S5_STEP
#pragma unroll
            for (int q = 0; q < 4; ++q)
#pragma unroll
                for (int i = 0; i < 4; ++i) { xr[q][i] = dpp_shr0<0x111>(xr[q][i]); xi[q][i] = dpp_shr0<0x111>(xi[q][i]); }
        }
        { S5_LANE();
        bf16x8 cmf[4];
#pragma unroll
        for (int q = 0; q < 4; ++q) cmf[q] = *(const bf16x8*)(tab + 1280 + (q * 64 + lane) * 4);
        const f32x4 dsk = *(const f32x4*)(dskip + g * SG + 4 * g4);
        gcbf* upt = (gcbf*)(U + ((size_t)b * T + 128 * vs) * D + g * SG + 4 * g4);
        gbf* gp = (gbf*)(Gout + ((size_t)b * T + 128 * vs) * DP + g * SG + 4 * g4);
#pragma unroll 1
        for (int tt = 0; tt < 128; ++tt, upt += D, gp += DP) {
            const u32x2 uw = *(const __attribute__((address_space(1))) u32x2*)upt;
            const s16x4 ub = __builtin_bit_cast(s16x4, uw);
            f32x4 y = zero4;
#pragma unroll
            for (int q = 0; q < 4; ++q) {
                const f32x4 br = __builtin_amdgcn_mfma_f32_16x16x16bf16_1k(bbf[2 * q], ub, zero4, 0, 0, 0), bi = __builtin_amdgcn_mfma_f32_16x16x16bf16_1k(bbf[2 * q + 1], ub, zero4, 0, 0, 0);
#pragma unroll
                for (int i = 0; i < 4; ++i) { const float nr = lr[q][i] * xr[q][i] - li[q][i] * xi[q][i] + br[i], ni = lr[q][i] * xi[q][i] + li[q][i] * xr[q][i] + bi[i]; xr[q][i] = nr; xi[q][i] = ni; }
                u32x4 xw; xw.x = cvt_pk_bf16(xr[q][0], xr[q][1]); xw.y = cvt_pk_bf16(xr[q][2], xr[q][3]); xw.z = cvt_pk_bf16(xi[q][0], xi[q][1]); xw.w = cvt_pk_bf16(xi[q][2], xi[q][3]);
                y = __builtin_amdgcn_mfma_f32_16x16x32_bf16(cmf[q], __builtin_bit_cast(bf16x8, xw), y, 0, 0, 0);
            }
            const float v0 = y[0] + dsk[0] * bf_lo(uw.x), v1 = y[1] + dsk[1] * bf_hi(uw.x), v2 = y[2] + dsk[2] * bf_lo(uw.y), v3 = y[3] + dsk[3] * bf_hi(uw.y);
            u32x2 ow; ow.x = cvt_pk_bf16(gelu_tanh(v0), gelu_tanh(v1)); ow.y = cvt_pk_bf16(gelu_tanh(v2), gelu_tanh(v3));
            *(__attribute__((address_space(1))) u32x2*)gp = ow;
        } }
    }
#undef S5_LANE
}

constexpr int NPH_PAIR = 17, NPHASE = 2 + 2 * NPH_PAIR;
struct Args { const float* in[24]; float* out; unsigned char* ws; int ph_lo, ph_hi, dry, pad; };
__device__ __forceinline__ const float* argp(const Args& a, int i) { asm volatile("" : "+s"(i)); return a.in[i]; }
__global__ void __launch_bounds__(NWAVES * 64, 2) fwd_kernel(Args args) {
    extern __shared__ __attribute__((aligned(16))) unsigned char lds[];
    Frame F;
    F.lds = (LAS unsigned char*)lds;
    F.MISC = (volatile LAS unsigned*)(F.lds + MISC_OFF);
    F.tid = threadIdx.x; F.lane = F.tid & 63; F.wave = __builtin_amdgcn_readfirstlane(F.tid >> 6);
    F.G = gridDim.x; { const int bx = blockIdx.x; F.vcu = (F.G % 8 == 0) ? (bx % 8) * (F.G / 8) + bx / 8 : bx; }
    F.ws = args.ws; F.ctl = (unsigned*)(F.ws + WS_CTL);
    for (int u = F.tid; u < (EXCH_OFF - LDSCTL_OFF) / 4; u += NWAVES * 64) ((LAS unsigned*)(F.lds + LDSCTL_OFF))[u] = 0u;
    __syncthreads();
#if MK_ONE_LAUNCH
    XcdBarrier bar = xcd_barrier_post(F.ctl + CW_BAR, F.MISC + 8);
#define GRID_BAR() xcd_barrier(bar)
#else
#define GRID_BAR() do { } while (0)
#endif
    const int lo = args.ph_lo, hi = args.ph_hi;
#define IN(k) (lo <= (k) && (k) < hi && (frame_refresh(F, args.ws, args.out), true))
#define SEAM(k) do { if (lo <= (k) && (k) + 1 < hi) GRID_BAR(); } while (0)
#define xres (F.out)
#if MK_DRY_MASK
#define xout (args.dry ? (float*)(F.ws + WS_BIG + 512 * MiB) : F.out)
#else
#define xout (F.out)
#endif
#define Hb ((bf16*)(F.ws + WS_H))
#define BIG ((bf16*)(F.ws + WS_BIG))
#define ring (F.lds + RING_OFF)
#define moda ((const float*)(F.ws + WS_MOD) + (size_t)la * BATCH * MODW)
#define mods ((const float*)(F.ws + WS_MOD) + (size_t)ls * BATCH * MODW)
#define xa ((pr == 0) ? argp(args, 0) : (const float*)F.out)

    if (IN(0)) {
        P0In pin{argp(args, 1), argp(args, 2), argp(args, 3), argp(args, 6), argp(args, 7), argp(args, 8), argp(args, 9), argp(args, 10), argp(args, 11), argp(args, 12), argp(args, 13), argp(args, 14), argp(args, 15),
                 argp(args, 17), argp(args, 18), argp(args, 19), argp(args, 22)};
        p0_prologue(F, pin);
    }
    SEAM(0);
    for (int pr = 0; pr < 2; ++pr) {
        const int pb = 1 + NPH_PAIR * pr, la = 2 * pr, ls = 2 * pr + 1;
        if (IN(pb + 0)) norm_mod_phase(F, xa, Hb, argp(args, 4) + (size_t)la * D, moda, 0, D);
        SEAM(pb + 0);
        if (IN(pb + 1)) { pg8::Gemm g{Hb, (const bf16*)(F.ws + WS_WAIN + pr * W_AIN_B), M, AIN, D, DP}; pg8::StaticOrder S; S.init(M, AIN, F.G, pg8::opaque_bid());
#if MK_DRY_MASK
            if (args.dry) { pg8::EpiNull E0; pg8::SameTileOrder S1; S1.init(M, AIN, F.G, pg8::opaque_bid()); pg8::gemm_phase<pg8::EpiNull, pg8::SameTileOrder, true, true>(ring, g, S1, E0); } else
#endif
            { pg8::EpiQKV E{BIG}; pg8::gemm_phase<pg8::EpiQKV, pg8::StaticOrder, true, true>(ring, g, S, E); } }
        SEAM(pb + 1);
#if MK_DRY_MASK
        if (IN(pb + 2)) { if (args.dry) attn_phase(F, BIG, (bf16*)F.out, (float*)(F.ws + WS_RAW)); else attn_phase(F, BIG, Hb, (float*)(F.ws + WS_LSE)); }
#else
        if (IN(pb + 2)) attn_phase(F, BIG, Hb, (float*)(F.ws + WS_LSE));
#endif
        SEAM(pb + 2);
        if (IN(pb + 3)) { pg8::Gemm g{Hb, (const bf16*)(F.ws + WS_WAOUT + pr * W_DD_B), M, D, D, DP}; pg8::StaticOrder S; S.init(M, D, F.G, pg8::opaque_bid());
            pg8::EpiGateRes E{xa, xout, moda + 2 * D}; pg8::gemm_phase<pg8::EpiGateRes, pg8::StaticOrder, true, true>(ring, g, S, E); }
        SEAM(pb + 3);
        if (IN(pb + 4)) norm_mod_phase(F, xres, Hb, argp(args, 5) + (size_t)la * D, moda, 3 * D, 4 * D);
        SEAM(pb + 4);
        if (IN(pb + 5)) { pg8::Gemm g{Hb, (const bf16*)(F.ws + WS_WUP + la * W_UP_B), M, FF2, D, DP}; pg8::StaticOrder S; S.init(M, FF2, F.G, pg8::opaque_bid());
            pg8::EpiConvGate E{BIG, (float*)(F.ws + WS_RAW), argp(args, 20) + (size_t)la * 3 * FF2, argp(args, 21) + (size_t)la * FF2, F.lds + EXCH_OFF};
            pg8::gemm_phase<pg8::EpiConvGate, pg8::StaticOrder, true, true>(ring, g, S, E); }
        SEAM(pb + 5);
        if (IN(pb + 6)) conv_fix_phase(F, (const float*)(F.ws + WS_RAW), BIG, argp(args, 20) + (size_t)la * 3 * FF2, argp(args, 21) + (size_t)la * FF2);
        SEAM(pb + 6);
        if (IN(pb + 7)) { pg8::Gemm g{BIG, (const bf16*)(F.ws + WS_WDOWN + la * W_DN_B), M, D, FF, FFP}; pg8::StaticOrder S; S.init(M, D, F.G, pg8::opaque_bid());
            pg8::EpiGateRes E{xres, xout, moda + 5 * D}; pg8::gemm_phase<pg8::EpiGateRes, pg8::StaticOrder, true, true>(ring, g, S, E); }
        SEAM(pb + 7);
        if (IN(pb + 8)) norm_mod_phase(F, xres, Hb, argp(args, 4) + (size_t)ls * D, mods, 0, D);
        SEAM(pb + 8);
        if (IN(pb + 9)) { pg8::Gemm g{Hb, (const bf16*)(F.ws + WS_WSIN + pr * W_DD_B), M, D, D, DP}; pg8::StaticOrder S; S.init(M, D, F.G, pg8::opaque_bid());
            pg8::EpiBf16 E{BIG, D}; pg8::gemm_phase<pg8::EpiBf16, pg8::StaticOrder, true, true>(ring, g, S, E); }
        SEAM(pb + 9);
        if (IN(pb + 10)) s5_phase(F, BIG, Hb, (const unsigned*)(F.ws + WS_S5T) + (size_t)pr * NG * S5T_WORDS, argp(args, 16) + (size_t)pr * D);
        SEAM(pb + 10);
        if (IN(pb + 11)) { pg8::Gemm g{Hb, (const bf16*)(F.ws + WS_WSGATE + pr * W_DD_B), M, D, D, DP}; pg8::StaticOrder S; S.init(M, D, F.G, pg8::opaque_bid());
            pg8::EpiSigGate E{Hb, (bf16*)(F.ws + WS_BIG + 128 * MiB)}; pg8::gemm_phase<pg8::EpiSigGate, pg8::StaticOrder, true, true>(ring, g, S, E); }
        SEAM(pb + 11);
        if (IN(pb + 12)) { pg8::Gemm g{(const bf16*)(F.ws + WS_BIG + 128 * MiB), (const bf16*)(F.ws + WS_WSOUT + pr * W_DD_B), M, D, D, DP}; pg8::StaticOrder S; S.init(M, D, F.G, pg8::opaque_bid());
            pg8::EpiGateRes E{xres, xout, mods + 2 * D}; pg8::gemm_phase<pg8::EpiGateRes, pg8::StaticOrder, true, true>(ring, g, S, E); }
        SEAM(pb + 12);
        if (IN(pb + 13)) norm_mod_phase(F, xres, Hb, argp(args, 5) + (size_t)ls * D, mods, 3 * D, 4 * D);
        SEAM(pb + 13);
        if (IN(pb + 14)) { pg8::Gemm g{Hb, (const bf16*)(F.ws + WS_WUP + ls * W_UP_B), M, FF2, D, DP}; pg8::StaticOrder S; S.init(M, FF2, F.G, pg8::opaque_bid());
            pg8::EpiConvGate E{BIG, (float*)(F.ws + WS_RAW), argp(args, 20) + (size_t)ls * 3 * FF2, argp(args, 21) + (size_t)ls * FF2, F.lds + EXCH_OFF};
            pg8::gemm_phase<pg8::EpiConvGate, pg8::StaticOrder, true, true>(ring, g, S, E); }
        SEAM(pb + 14);
        if (IN(pb + 15)) conv_fix_phase(F, (const float*)(F.ws + WS_RAW), BIG, argp(args, 20) + (size_t)ls * 3 * FF2, argp(args, 21) + (size_t)ls * FF2);
        SEAM(pb + 15);
        if (IN(pb + 16)) { pg8::Gemm g{BIG, (const bf16*)(F.ws + WS_WDOWN + ls * W_DN_B), M, D, FF, FFP}; pg8::StaticOrder S; S.init(M, D, F.G, pg8::opaque_bid());
            pg8::EpiGateRes E{xres, xout, mods + 5 * D}; pg8::gemm_phase<pg8::EpiGateRes, pg8::StaticOrder, true, true>(ring, g, S, E); }
        SEAM(pb + 16);
    }
    if (IN(NPHASE - 1)) final_norm_phase(F, xres, xout, argp(args, 23));
#undef IN
#undef xres
#undef xout
#undef Hb
#undef BIG
#undef ring
#undef moda
#undef mods
#undef xa
#undef SEAM
#undef GRID_BAR
}

extern "C" void kernel_launch(void* const* d_in, const int* in_sizes, int n_in, void* d_out, int out_size, void* d_ws, size_t ws_size, hipStream_t stream) {
    static int grid = 0;
    if (grid == 0) {
        if (n_in != 24 || in_sizes[0] != M * D || out_size != M * D || ws_size < WS_END) { fprintf(stderr, "kernel_launch: shape mismatch: n_in %d in0 %d out %d ws %zu (need %zu)\n", n_in, n_in > 0 ? in_sizes[0] : -1, out_size, ws_size, (size_t)WS_END); grid = -1; return; }
        int dev = 0, cus = 0, per_cu = 0;
        if (hipGetDevice(&dev) != hipSuccess || hipDeviceGetAttribute(&cus, hipDeviceAttributeMultiprocessorCount, dev) != hipSuccess) { grid = -1; return; }
        if (hipFuncSetAttribute((const void*)fwd_kernel, hipFuncAttributeMaxDynamicSharedMemorySize, LDS_BYTES) != hipSuccess) { fprintf(stderr, "kernel_launch: hipFuncSetAttribute failed\n"); grid = -1; return; }
        if (hipOccupancyMaxActiveBlocksPerMultiprocessor(&per_cu, (const void*)fwd_kernel, NWAVES * 64, LDS_BYTES) != hipSuccess || per_cu < 1) { fprintf(stderr, "kernel_launch: occupancy query says %d\n", per_cu); }
        (void)hipGetLastError();
        grid = cus;
    }
    if (grid < 0) return;
    if (hipMemsetAsync((char*)d_ws + WS_CTL, 0, CTL_ZERO_BYTES, stream) != hipSuccess) return;
    Args a{};
    for (int i = 0; i < 24; ++i) a.in[i] = (const float*)d_in[i];
    a.out = (float*)d_out; a.ws = (unsigned char*)d_ws;
#if MK_ONE_LAUNCH
    a.ph_lo = 0; a.ph_hi = NPHASE;
    hipLaunchKernelGGL(fwd_kernel, dim3(grid), dim3(NWAVES * 64), LDS_BYTES, stream, a);
#else
    for (int p = 0; p < NPHASE; ++p) { a.ph_lo = p; a.ph_hi = p + 1;
#if MK_DEBUG_CHECKS
        debug_checks(p, true, d_in, (float*)d_out, (unsigned char*)d_ws, stream);
#endif
        { const int kbit = (p == 0) ? 17 : (p == NPHASE - 1 ? 18 : (p - 1) % NPH_PAIR); const int nrep = ((MK_REPEAT_MASK >> kbit) & 1) ? 2 : 1;
          for (int r = 0; r < nrep; ++r) hipLaunchKernelGGL(fwd_kernel, dim3(grid), dim3(NWAVES * 64), LDS_BYTES, stream, a);
          if (((MK_DRY_MASK >> kbit) & 1) && !(kbit == 2 && p > NPH_PAIR)) { a.dry = 1; hipLaunchKernelGGL(fwd_kernel, dim3(grid), dim3(NWAVES * 64), LDS_BYTES, stream, a); a.dry = 0; } }
#if MK_DEBUG_CHECKS
        debug_checks(p, false, d_in, (float*)d_out, (unsigned char*)d_ws, stream);
#endif
    }
#endif
    const hipError_t le = hipPeekAtLastError();
    if (le != hipSuccess) fprintf(stderr, "kernel_launch: launch failed: %s\n", hipGetErrorName(le));
}
```

```cpp
#include <hip/hip_runtime.h>
#include <cstdio>
#include <cstdint>

#ifndef MK_ONE_LAUNCH
#define MK_ONE_LAUNCH 1
#endif
#ifndef MK_DEBUG_CHECKS
#define MK_DEBUG_CHECKS 0
#endif
#ifndef MK_REPEAT_MASK
#define MK_REPEAT_MASK 0
#endif
#ifndef MK_DRY_MASK
#define MK_DRY_MASK 0
#endif
#ifndef MK_DOUBLE_BAR
#define MK_DOUBLE_BAR 0
#endif
#ifndef MK_DEBUG_NOTAPS
#define MK_DEBUG_NOTAPS 0
#endif

constexpr int BATCH = 16, T = 2048, D = 2048, M = BATCH * T, DEPTH = 4;
constexpr int NH = 16, HD = 128, QK_COLS = 3 * NH * HD, V_COLS = NH * HD, AIN = 2 * QK_COLS + V_COLS;
constexpr int SG = 16, NG = D / SG, SP = 64;
constexpr int FF = 5632, FF2 = 2 * FF;
constexpr int MODW = 6 * D;
constexpr float EPS = 1e-6f;
constexpr int KPAD = 64, DP = D + KPAD, FFP = FF + KPAD;

namespace pg8 {
#define PG8_LAS __attribute__((address_space(3)))
typedef unsigned short bf16_t;
typedef short bf16x8 __attribute__((ext_vector_type(8)));
typedef float f32x4 __attribute__((ext_vector_type(4)));
typedef unsigned u32x4 __attribute__((ext_vector_type(4)));
typedef unsigned u32x2 __attribute__((ext_vector_type(2)));
constexpr int BM = 256, BK = 64, HALF = 128, HTB = HALF * BK * 2  , STAGE_BYTES = 8 * HTB, NXCD = 8, WGM = 4;

__host__ __device__ __forceinline__ int lds_byte(int r, int c) { const int st = (r >> 4) * 2 + (c >> 5), rr = r & 15, cc = c & 31, ob = rr * 64 + cc * 2; return st * 1024 + (ob ^ (((ob >> 9) & 1) << 5)); }
__host__ __device__ __forceinline__ void stage_rc(int b, int& R, int& C) { const int st = b / 1024, sb = b % 1024, swz = sb ^ (((sb >> 9) & 1) << 5); R = (st >> 1) * 16 + swz / 64; C = (st & 1) * 32 + (swz % 64) / 2; }
__host__ __device__ __forceinline__ int perm32(int rho) { const int n = rho >> 4, i = rho & 15; return 8 * (i >> 2) + 4 * n + (i & 3); }

__device__ __forceinline__ int opaque_tid() { int t = (int)threadIdx.x; asm volatile("" : "+v"(t)); return t; }
__device__ __forceinline__ int opaque_bid() { int t = (int)blockIdx.x; asm volatile("" : "+s"(t)); return t; }
struct Unit { int pm, pn; };
struct Gemm { const bf16_t* A; const bf16_t* Bt; int M, N, K, ldk; };

struct StaticOrder {
    int nM, nN, nwg, G, c;
    __host__ __device__ void init(int M_, int N_, int G_, int c_) { nM = M_ / BM; nN = N_ / BM; nwg = nM * nN; G = G_; c = c_; }
    __host__ __device__ bool next(int i, Unit& u) const {
        const long L = (long)i * G + c; if (L >= nwg) return false;
        int wgid = (int)L; { const int q = nwg / NXCD, r = nwg % NXCD, xcd = wgid % NXCD, off = wgid / NXCD; wgid = (xcd < r ? xcd * (q + 1) : r * (q + 1) + (xcd - r) * q) + off; }
        const int nig = WGM * nN, gid = wgid / nig, fm = gid * WGM, gsz = (nM - fm) < WGM ? (nM - fm) : WGM;
        u.pm = fm + ((wgid % nig) % gsz); u.pn = (wgid % nig) / gsz; return true;
    }
    __device__ __forceinline__ void a_ready(const Unit&) const {}
    __device__ __forceinline__ void done(const Unit&) const {}
};
#if MK_DRY_MASK
struct SameTileOrder : StaticOrder {
    __host__ __device__ bool next(int i, Unit& u) const { const bool ok = StaticOrder::next(i, u); u.pm = 0; u.pn = 0; return ok; }
};
#endif

__device__ __forceinline__ unsigned cvt_pk_bf16(float lo, float hi) { unsigned r; asm volatile("v_cvt_pk_bf16_f32 %0, %1, %2" : "=v"(r) : "v"(lo), "v"(hi)); return r; }
__device__ __forceinline__ float bf_lo(unsigned w) { return __uint_as_float(w << 16); }
__device__ __forceinline__ float bf_hi(unsigned w) { return __uint_as_float(w & 0xffff0000u); }
__device__ __forceinline__ float fast_sigmoid(float v) { return __builtin_amdgcn_rcpf(1.0f + __builtin_amdgcn_exp2f(-1.4426950408889634f * v)); }

struct EpiBf16 {
    static constexpr bool PERM = true, AFTER_DRAIN = false;
    bf16_t* O; int ldc;
    __device__ __forceinline__ void operator()(const f32x4 (&acc)[2][2][4][2], const Unit& u, int wr, int wc, int fr, int fq) const {
        const int row0 = u.pm * BM + wr * 64 + fr, col0 = u.pn * BM + wc * 32 + 8 * fq;
#pragma unroll
        for (int ai = 0; ai < 2; ++ai)
#pragma unroll
            for (int m = 0; m < 4; ++m) { bf16_t* rowp = O + (size_t)(row0 + ai * HALF + m * 16) * ldc + col0;
#pragma unroll
                for (int bj = 0; bj < 2; ++bj) { const f32x4 v0 = acc[ai][bj][m][0], v1 = acc[ai][bj][m][1];
                    u32x4 w; w.x = cvt_pk_bf16(v0[0], v0[1]); w.y = cvt_pk_bf16(v0[2], v0[3]); w.z = cvt_pk_bf16(v1[0], v1[1]); w.w = cvt_pk_bf16(v1[2], v1[3]);
                    *(u32x4*)(rowp + bj * HALF) = w; } }
    }
};
#if MK_DRY_MASK
struct EpiNull {
    static constexpr bool PERM = true, AFTER_DRAIN = false;
    __device__ __forceinline__ void operator()(const f32x4 (&acc)[2][2][4][2], const Unit& u, int wr, int wc, int fr, int fq) const {
#pragma unroll
        for (int ai = 0; ai < 2; ++ai)
#pragma unroll
            for (int bj = 0; bj < 2; ++bj)
#pragma unroll
                for (int m = 0; m < 4; ++m)
#pragma unroll
                    for (int n = 0; n < 2; ++n) asm volatile("" :: "v"(acc[ai][bj][m][n]));
    }
};
#endif
constexpr size_t QK_PART = (size_t)BATCH * NH * 3 * T * HD;
struct EpiQKV {
    static constexpr bool PERM = true, AFTER_DRAIN = false;
    bf16_t* O;
    __device__ __forceinline__ void operator()(const f32x4 (&acc)[2][2][4][2], const Unit& u, int wr, int wc, int fr, int fq) const {
        const int part = u.pn >> 3, b = u.pm >> 3, t0 = (u.pm & 7) * BM + wr * 64 + fr, d0 = wc * 32 + 8 * fq;
        const int grp = part < 3 ? part : (part < 6 ? part - 3 : 0), sh = 2 * grp;
#pragma unroll
        for (int bj = 0; bj < 2; ++bj) { const int h = 2 * (u.pn & 7) + bj;
            bf16_t* hb = (part < 6) ? O + (part >= 3 ? QK_PART : 0) + ((size_t)((b * NH + h) * 3 + grp) * T) * HD + d0 : O + 2 * QK_PART + ((size_t)(b * NH + h) * T) * HD + d0;
#pragma unroll
            for (int ai = 0; ai < 2; ++ai)
#pragma unroll
                for (int m = 0; m < 4; ++m) { const int t = t0 + ai * HALF + m * 16;
                    const int pos = (part < 6) ? ((t & ((1 << sh) - 1)) * (T >> sh) + (t >> sh)) : t;
                    const f32x4 v0 = acc[ai][bj][m][0], v1 = acc[ai][bj][m][1];
                    u32x4 w; w.x = cvt_pk_bf16(v0[0], v0[1]); w.y = cvt_pk_bf16(v0[2], v0[3]); w.z = cvt_pk_bf16(v1[0], v1[1]); w.w = cvt_pk_bf16(v1[2], v1[3]);
                    *(u32x4*)(hb + (size_t)pos * HD) = w; } }
    }
};
struct EpiGateRes {
    static constexpr bool PERM = false, AFTER_DRAIN = false;
    const float* base; float* out; const float* gate;
    __device__ __forceinline__ void operator()(const f32x4 (&acc)[2][2][4][2], const Unit& u, int wr, int wc, int fr, int fq) const {
        const int row0 = u.pm * BM + wr * 64 + fr, col0 = u.pn * BM + wc * 32 + 4 * fq;
        const float* gp = gate + (size_t)(u.pm >> 3) * MODW + col0;
        f32x4 gv[2][2];
#pragma unroll
        for (int bj = 0; bj < 2; ++bj)
#pragma unroll
            for (int n = 0; n < 2; ++n) gv[bj][n] = *(const f32x4*)(gp + bj * HALF + n * 16);
        const float* bp = base + (size_t)row0 * D + col0; float* op = out + (size_t)row0 * D + col0;
        f32x4 b0[2][2][2], b1[2][2][2];
#define EGR_LOAD(dst, ai, m0, nm) do { _Pragma("unroll") for (int m = 0; m < (nm); ++m) _Pragma("unroll") for (int bj = 0; bj < 2; ++bj) _Pragma("unroll") for (int n = 0; n < 2; ++n) \
            dst[m][bj][n] = *(const f32x4*)(bp + (size_t)((ai) * HALF + ((m0) + m) * 16) * D + bj * HALF + n * 16); } while (0)
#define EGR_STORE(src, ai, m0, nm) do { _Pragma("unroll") for (int m = 0; m < (nm); ++m) _Pragma("unroll") for (int bj = 0; bj < 2; ++bj) _Pragma("unroll") for (int n = 0; n < 2; ++n) \
            *(f32x4*)(op + (size_t)((ai) * HALF + ((m0) + m) * 16) * D + bj * HALF + n * 16) = src[m][bj][n] + gv[bj][n] * acc[ai][bj][(m0) + m][n]; } while (0)
        EGR_LOAD(b0, 0, 0, 2); asm volatile("" ::: "memory");
        EGR_LOAD(b1, 0, 2, 2); asm volatile("" ::: "memory");
        EGR_STORE(b0, 0, 0, 2); asm volatile("" ::: "memory");
        EGR_LOAD(b0, 1, 0, 2); asm volatile("" ::: "memory");
        EGR_STORE(b1, 0, 2, 2); asm volatile("" ::: "memory");
        EGR_LOAD(b1, 1, 2, 2); asm volatile("" ::: "memory");
        EGR_STORE(b0, 1, 0, 2); asm volatile("" ::: "memory");
        EGR_STORE(b1, 1, 2, 2);
#undef EGR_LOAD
#undef EGR_STORE
    }
};
struct EpiSigGate {
    static constexpr bool PERM = true, AFTER_DRAIN = false;
    const bf16_t* gsrc; bf16_t* O;
    __device__ __forceinline__ void operator()(const f32x4 (&acc)[2][2][4][2], const Unit& u, int wr, int wc, int fr, int fq) const {
        const int row0 = u.pm * BM + wr * 64 + fr, col0 = u.pn * BM + wc * 32 + 8 * fq;
#pragma unroll
        for (int ai = 0; ai < 2; ++ai)
#pragma unroll
            for (int m = 0; m < 4; ++m) { const size_t off = (size_t)(row0 + ai * HALF + m * 16) * DP + col0;
#pragma unroll
                for (int bj = 0; bj < 2; ++bj) { const f32x4 v0 = acc[ai][bj][m][0], v1 = acc[ai][bj][m][1];
                    const u32x4 g = *(const u32x4*)(gsrc + off + bj * HALF);
                    u32x4 w;
                    w.x = cvt_pk_bf16(bf_lo(g.x) * fast_sigmoid(v0[0]), bf_hi(g.x) * fast_sigmoid(v0[1]));
                    w.y = cvt_pk_bf16(bf_lo(g.y) * fast_sigmoid(v0[2]), bf_hi(g.y) * fast_sigmoid(v0[3]));
                    w.z = cvt_pk_bf16(bf_lo(g.z) * fast_sigmoid(v1[0]), bf_hi(g.z) * fast_sigmoid(v1[1]));
                    w.w = cvt_pk_bf16(bf_lo(g.w) * fast_sigmoid(v1[2]), bf_hi(g.w) * fast_sigmoid(v1[3]));
                    *(u32x4*)(O + off + bj * HALF) = w; }
                asm volatile("" ::: "memory"); }
    }
};
template <int CTRL> __device__ __forceinline__ float dpp_ror(float v) { return __int_as_float(__builtin_amdgcn_update_dpp(0, __float_as_int(v), CTRL, 0xf, 0xf, false)); }
struct EpiConvGate {
    static constexpr bool PERM = true, AFTER_DRAIN = false;
    bf16_t* O; float* raw; const float* cw; const float* cb; PG8_LAS unsigned char* xlds;
    __device__ __forceinline__ void operator()(const f32x4 (&acc)[2][2][4][2], const Unit& u, int wr, int wc, int fr, int fq) const {
        const int wid = wr * 4 + wc;
        PG8_LAS f32x4* ex = (PG8_LAS f32x4*)xlds;
        if (fr >= 14) {
#pragma unroll
            for (int ai = 0; ai < 2; ++ai)
#pragma unroll
                for (int bj = 0; bj < 2; ++bj)
#pragma unroll
                    for (int n = 0; n < 2; ++n) ex[((((wid * 2 + ai) * 2 + bj) * 2 + n) * 4 + fq) * 2 + (fr - 14)] = acc[ai][bj][3][n];
        }
        asm volatile("s_waitcnt lgkmcnt(0)" ::: "memory"); __builtin_amdgcn_s_barrier(); asm volatile("" ::: "memory");
        const int gcol0 = u.pn * HALF + wc * 32 + 8 * fq;
        const int row0 = u.pm * BM + wr * 64 + fr;
        if (wr == 0 && fr < 2) {
#pragma unroll
            for (int bj = 0; bj < 2; ++bj)
#pragma unroll
                for (int n = 0; n < 2; ++n) *(f32x4*)(raw + ((size_t)u.pm * 4 + fr) * FF2 + bj * FF + gcol0 + 4 * n) = acc[0][bj][0][n];
        }
        if (wr == 1 && fr >= 14) {
#pragma unroll
            for (int bj = 0; bj < 2; ++bj)
#pragma unroll
                for (int n = 0; n < 2; ++n) *(f32x4*)(raw + ((size_t)u.pm * 4 + 2 + (fr - 14)) * FF2 + bj * FF + gcol0 + 4 * n) = acc[1][bj][3][n];
        }
        unsigned outpk[2][4][2];
#pragma unroll
        for (int n = 0; n < 2; ++n) {
            const int gc = gcol0 + 4 * n;
            const f32x4 wg0 = *(const f32x4*)(cw + gc), wg1 = *(const f32x4*)(cw + FF2 + gc), wg2 = *(const f32x4*)(cw + 2 * FF2 + gc), bg = *(const f32x4*)(cb + gc);
            const f32x4 wu0 = *(const f32x4*)(cw + FF + gc), wu1 = *(const f32x4*)(cw + FF2 + FF + gc), wu2 = *(const f32x4*)(cw + 2 * FF2 + FF + gc), bu = *(const f32x4*)(cb + FF + gc);
#pragma unroll
            for (int ai = 0; ai < 2; ++ai) {
                f32x4 pg = (f32x4){0.f, 0.f, 0.f, 0.f}, pu = (f32x4){0.f, 0.f, 0.f, 0.f};
                if (!(ai == 0 && wr == 0) && fr >= 14) {
                    const int sw = (wr == 1) ? wc : 4 + wc, sai = (wr == 1) ? ai : 0;
                    pg = ex[((((sw * 2 + sai) * 2 + 0) * 2 + n) * 4 + fq) * 2 + (fr - 14)];
                    pu = ex[((((sw * 2 + sai) * 2 + 1) * 2 + n) * 4 + fq) * 2 + (fr - 14)];
                }
                f32x4 pg1, pg2, pu1, pu2;
#pragma unroll
                for (int e = 0; e < 4; ++e) { pg1[e] = dpp_ror<0x121>(pg[e]); pg2[e] = dpp_ror<0x122>(pg[e]); pu1[e] = dpp_ror<0x121>(pu[e]); pu2[e] = dpp_ror<0x122>(pu[e]); }
#pragma unroll
                for (int m = 0; m < 4; ++m) {
                    const f32x4 cg = acc[ai][0][m][n], cu = acc[ai][1][m][n];
                    float o[4];
                    f32x4 cg1, cg2, cu1, cu2;
#pragma unroll
                    for (int e = 0; e < 4; ++e) { cg1[e] = dpp_ror<0x121>(cg[e]); cg2[e] = dpp_ror<0x122>(cg[e]); cu1[e] = dpp_ror<0x121>(cu[e]); cu2[e] = dpp_ror<0x122>(cu[e]); }
#pragma unroll
                    for (int e = 0; e < 4; ++e) {
                        const float g1 = (fr == 0) ? pg1[e] : cg1[e], g2 = (fr < 2) ? pg2[e] : cg2[e], u1 = (fr == 0) ? pu1[e] : cu1[e], u2 = (fr < 2) ? pu2[e] : cu2[e];
#if MK_DEBUG_NOTAPS
                        const float gg = bg[e] + wg2[e] * cg[e] + 0.f * (g1 + g2);
                        const float uu = bu[e] + wu2[e] * cu[e] + 0.f * (u1 + u2);
#else
                        const float gg = bg[e] + wg2[e] * cg[e] + wg1[e] * g1 + wg0[e] * g2;
                        const float uu = bu[e] + wu2[e] * cu[e] + wu1[e] * u1 + wu0[e] * u2;
#endif
                        o[e] = gg * fast_sigmoid(gg) * uu;
                    }
                    pg1 = cg1; pg2 = cg2; pu1 = cu1; pu2 = cu2;
                    const unsigned p0 = cvt_pk_bf16(o[0], o[1]), p1 = cvt_pk_bf16(o[2], o[3]);
                    if (n == 0) { outpk[ai][m][0] = p0; outpk[ai][m][1] = p1; }
                    else { u32x4 w; w.x = outpk[ai][m][0]; w.y = outpk[ai][m][1]; w.z = p0; w.w = p1;
                        *(u32x4*)(O + (size_t)(row0 + ai * HALF + m * 16) * FFP + gcol0) = w; }
                }
            }
        }
    }
};

template <class Epi, class Sched, bool ALIGN_EPI = false, bool SP2 = false>
__device__ __forceinline__ void gemm_phase(PG8_LAS unsigned char* lds, const Gemm g, const Sched& S, const Epi& E) {
    const int tid = opaque_tid(), wid = __builtin_amdgcn_readfirstlane(tid >> 6), lane = tid & 63, wr = wid >> 2, wc = wid & 3, fr = lane & 15, fq = lane >> 4;
    const int K = g.K, nt = K / BK, ldk = g.ldk;
    unsigned voffA[2], voffB[2];
#pragma unroll
    for (int i = 0; i < 2; ++i) { int R, C; stage_rc(tid * 16 + i * 8192, R, C); const int Rb = Epi::PERM ? ((R & ~31) + perm32(R & 31)) : R;
        voffA[i] = (unsigned)(R * ldk + C) * 2u; voffB[i] = (unsigned)(Rb * ldk + C) * 2u; }
    const size_t kstep = (size_t)(BK * 2);
    const size_t hstep = (size_t)HALF * ldk * 2;
    const size_t tstep = 2 * hstep;
    const unsigned ldsw = (unsigned)wid * 1024u;
    const int aoff = lds_byte(wr * 64 + fr, fq * 8), boff = lds_byte(wc * 32 + fr, fq * 8);
#define PG8_SA(b, h) (((b) * 2 + (h)) * HTB)
#define PG8_SB(b, h) ((4 + (b) * 2 + (h)) * HTB)
#define PG8_STAGE(bufoff, gbase, voff) do { _Pragma("unroll") for (int _i = 0; _i < 2; ++_i) \
        __builtin_amdgcn_global_load_lds((const unsigned*)((const char*)(gbase) + (voff)[_i]), (PG8_LAS unsigned*)(lds + (bufoff) + ldsw + _i * 8192), 16, 0, 0); } while (0)
#define PG8_LDA(dst, b, h) do { _Pragma("unroll") for (int m = 0; m < 4; ++m) _Pragma("unroll") for (int k = 0; k < 2; ++k) dst[m][k] = *(const PG8_LAS bf16x8*)(lds + PG8_SA(b, h) + aoff + m * 2048 + k * 1024); } while (0)
#define PG8_LDB(dst, b, h) do { _Pragma("unroll") for (int n = 0; n < 2; ++n) _Pragma("unroll") for (int k = 0; k < 2; ++k) dst[n][k] = *(const PG8_LAS bf16x8*)(lds + PG8_SB(b, h) + boff + n * 2048 + k * 1024); } while (0)
#define PG8_MMA(ai, bj, At, Bt) do { __builtin_amdgcn_s_setprio(1); _Pragma("unroll") for (int m = 0; m < 4; ++m) _Pragma("unroll") for (int n = 0; n < 2; ++n) _Pragma("unroll") for (int k = 0; k < 2; ++k) \
        acc[ai][bj][m][n] = __builtin_amdgcn_mfma_f32_16x16x32_bf16(Bt[n][k], At[m][k], acc[ai][bj][m][n], 0, 0, 0); __builtin_amdgcn_s_setprio(0); } while (0)
#define PG8_WAIT_V(n) asm volatile("s_waitcnt vmcnt(" #n ")" ::: "memory")
#define PG8_WAIT_L(n) asm volatile("s_waitcnt lgkmcnt(" #n ")" ::: "memory")
#define PG8_BAR __builtin_amdgcn_s_barrier()
#define PG8_SCHED __builtin_amdgcn_sched_barrier(0)
    Unit cur, nxt; int ui = 0;
    if (!S.next(0, cur)) return;
    f32x4 acc[2][2][4][2];
#pragma unroll
    for (int a = 0; a < 2; ++a)
#pragma unroll
        for (int b = 0; b < 2; ++b)
#pragma unroll
            for (int m = 0; m < 4; ++m)
#pragma unroll
                for (int n = 0; n < 2; ++n) acc[a][b][m][n] = (f32x4){0.f, 0.f, 0.f, 0.f};
    bf16x8 At[4][2], B0[2][2], B1[2][2];
    const char* cA = (const char*)g.A + (size_t)cur.pm * tstep; const char* cB = (const char*)g.Bt + (size_t)cur.pn * tstep;
    S.a_ready(cur);
    if constexpr (SP2) {
        PG8_STAGE(PG8_SB(0, 0), cB, voffB); PG8_STAGE(PG8_SB(0, 1), cB + hstep, voffB); PG8_STAGE(PG8_SA(0, 0), cA, voffA); PG8_STAGE(PG8_SA(0, 1), cA + hstep, voffA);
        if (wr == 1) PG8_BAR;
        PG8_WAIT_V(2); PG8_BAR;
        PG8_STAGE(PG8_SB(1, 0), cB + kstep, voffB); PG8_STAGE(PG8_SA(1, 0), cA + kstep, voffA); PG8_STAGE(PG8_SB(1, 1), cB + hstep + kstep, voffB);
        PG8_WAIT_V(6); PG8_BAR;
    } else {
        PG8_STAGE(PG8_SB(0, 0), cB, voffB); PG8_STAGE(PG8_SA(0, 0), cA, voffA); PG8_STAGE(PG8_SB(0, 1), cB + hstep, voffB); PG8_STAGE(PG8_SA(0, 1), cA + hstep, voffA);
        if (wr == 1) PG8_BAR;
        PG8_WAIT_V(4); PG8_BAR;
        PG8_STAGE(PG8_SB(1, 0), cB + kstep, voffB); PG8_STAGE(PG8_SA(1, 0), cA + kstep, voffA); PG8_STAGE(PG8_SB(1, 1), cB + hstep + kstep, voffB);
        PG8_WAIT_V(6); PG8_BAR;
    }
    for (;;) {
        const bool has_next = S.next(ui + 1, nxt);
        const char* nA = has_next ? (const char*)g.A + (size_t)nxt.pm * tstep : cA; const char* nB = has_next ? (const char*)g.Bt + (size_t)nxt.pn * tstep : cB;
        for (int t = 0; t < nt; t += 2) {
            const bool last = (t == nt - 2);
            const char* a1 = cA + (size_t)(t + 1) * kstep;
            const char* a2 = last ? nA : cA + (size_t)(t + 2) * kstep; const char* b2 = last ? nB : cB + (size_t)(t + 2) * kstep;
            const char* a3 = a2 + kstep; const char* b3 = b2 + kstep;
            if (last && has_next) S.a_ready(nxt);
            if constexpr (SP2) {
            PG8_LDB(B0, 0, 0); PG8_LDB(B1, 0, 1); PG8_SCHED; PG8_LDA(At, 0, 0); PG8_STAGE(PG8_SA(1, 1), a1 + hstep, voffA);
            PG8_WAIT_V(8); PG8_WAIT_L(0); PG8_BAR; PG8_MMA(0, 0, At, B0); PG8_MMA(0, 1, At, B1); PG8_BAR; PG8_SCHED;
            PG8_LDA(At, 0, 1); PG8_STAGE(PG8_SB(0, 0), b2, voffB); PG8_STAGE(PG8_SB(0, 1), b2 + hstep, voffB); PG8_STAGE(PG8_SA(0, 0), a2, voffA);
            PG8_WAIT_V(8); PG8_WAIT_L(0); PG8_BAR; PG8_MMA(1, 0, At, B0); PG8_MMA(1, 1, At, B1); PG8_BAR; PG8_SCHED;
            PG8_LDB(B0, 1, 0); PG8_LDB(B1, 1, 1); PG8_SCHED; PG8_LDA(At, 1, 0); PG8_STAGE(PG8_SA(0, 1), a2 + hstep, voffA);
            PG8_WAIT_V(8); PG8_WAIT_L(0); PG8_BAR; PG8_MMA(0, 0, At, B0); PG8_MMA(0, 1, At, B1); PG8_BAR; PG8_SCHED;
            PG8_LDA(At, 1, 1); PG8_STAGE(PG8_SB(1, 0), b3, voffB); PG8_STAGE(PG8_SB(1, 1), b3 + hstep, voffB); PG8_STAGE(PG8_SA(1, 0), a3, voffA);
            PG8_WAIT_V(8); PG8_WAIT_L(0); PG8_BAR; PG8_MMA(1, 0, At, B0); PG8_MMA(1, 1, At, B1); PG8_BAR; PG8_SCHED;
            } else {
            PG8_LDB(B0, 0, 0); PG8_SCHED; PG8_LDA(At, 0, 0); PG8_STAGE(PG8_SA(1, 1), a1 + hstep, voffA);
            PG8_WAIT_L(8); PG8_BAR; PG8_WAIT_L(0); PG8_MMA(0, 0, At, B0); PG8_BAR; PG8_SCHED;
            PG8_LDB(B1, 0, 1); PG8_STAGE(PG8_SB(0, 0), b2, voffB);
            PG8_BAR; PG8_WAIT_L(0); PG8_MMA(0, 1, At, B1); PG8_BAR;
            PG8_LDA(At, 0, 1); PG8_STAGE(PG8_SA(0, 0), a2, voffA);
            PG8_BAR; PG8_WAIT_L(0); PG8_MMA(1, 0, At, B0); PG8_BAR; PG8_SCHED;
            PG8_STAGE(PG8_SB(0, 1), b2 + hstep, voffB);
            PG8_WAIT_V(6); PG8_BAR; PG8_MMA(1, 1, At, B1); PG8_BAR;
            PG8_LDB(B0, 1, 0); PG8_SCHED; PG8_LDA(At, 1, 0); PG8_STAGE(PG8_SA(0, 1), a2 + hstep, voffA);
            PG8_WAIT_L(8); PG8_BAR; PG8_WAIT_L(0); PG8_MMA(0, 0, At, B0); PG8_BAR; PG8_SCHED;
            PG8_LDB(B1, 1, 1); PG8_STAGE(PG8_SB(1, 0), b3, voffB);
            PG8_BAR; PG8_WAIT_L(0); PG8_MMA(0, 1, At, B1); PG8_BAR;
            PG8_LDA(At, 1, 1); PG8_STAGE(PG8_SA(1, 0), a3, voffA);
            PG8_BAR; PG8_WAIT_L(0); PG8_MMA(1, 0, At, B0); PG8_BAR; PG8_SCHED;
            PG8_STAGE(PG8_SB(1, 1), b3 + hstep, voffB);
            PG8_WAIT_V(6); PG8_BAR; PG8_MMA(1, 1, At, B1); PG8_BAR;
            }
        }
        if constexpr (ALIGN_EPI) { if (wr == 0) PG8_BAR; }
        if constexpr (!Epi::AFTER_DRAIN) { E(acc, cur, wr, wc, fr, fq); S.done(cur); }
        if (!has_next) break;
#pragma unroll
        for (int a = 0; a < 2; ++a)
#pragma unroll
            for (int b = 0; b < 2; ++b)
#pragma unroll
                for (int m = 0; m < 4; ++m)
#pragma unroll
                    for (int n = 0; n < 2; ++n) acc[a][b][m][n] = (f32x4){0.f, 0.f, 0.f, 0.f};
        cur = nxt; cA = nA; cB = nB; ++ui;
        if constexpr (ALIGN_EPI) { if (wr == 1) PG8_BAR; }
    }
    PG8_WAIT_V(0);
    if constexpr (!ALIGN_EPI) { if (wr == 0) PG8_BAR; }
    PG8_BAR;
    if constexpr (Epi::AFTER_DRAIN) { E.fused(acc, cur, wr, wc, fr, fq, lds, wid, lane); S.done(cur); }
#undef PG8_SA
#undef PG8_SB
#undef PG8_STAGE
#undef PG8_LDA
#undef PG8_LDB
#undef PG8_MMA
#undef PG8_WAIT_V
#undef PG8_WAIT_L
#undef PG8_BAR
#undef PG8_SCHED
}
}

constexpr size_t MiB = 1u << 20;
constexpr size_t WS_CTL = 0, CTL_ZERO_BYTES = 1 * MiB;
constexpr size_t WS_MOD = 1 * MiB;
constexpr size_t WS_S5T = 4 * MiB;
constexpr size_t WS_LSE = 8 * MiB;
constexpr size_t WS_RAW = 12 * MiB;
constexpr size_t W_AIN_B = (size_t)AIN * DP * 2, W_DD_B = (size_t)D * DP * 2, W_UP_B = (size_t)FF2 * DP * 2, W_DN_B = (size_t)D * FFP * 2;
constexpr size_t WS_WAIN = 40 * MiB, WS_WAOUT = WS_WAIN + 2 * W_AIN_B, WS_WSIN = WS_WAOUT + 2 * W_DD_B, WS_WSGATE = WS_WSIN + 2 * W_DD_B, WS_WSOUT = WS_WSGATE + 2 * W_DD_B, WS_WUP = WS_WSOUT + 2 * W_DD_B, WS_WDOWN = WS_WUP + 4 * W_UP_B;
constexpr size_t WS_H = 492 * MiB;
constexpr size_t WS_BIG = 624 * MiB;
constexpr size_t WS_END = 1520 * MiB;
static_assert(WS_WDOWN + 4 * W_DN_B <= WS_H && WS_H + (size_t)M * DP * 2 <= WS_BIG && WS_BIG + (size_t)M * AIN * 2 <= WS_END && (size_t)M * FFP * 2 <= 512 * MiB && WS_RAW + (size_t)(M / 256) * 4 * FF2 * 4 <= WS_WAIN, "d_ws map");
constexpr int S5T_WORDS = 2304;
constexpr int CW_BAR = 4096;
constexpr int RING_OFF = 0, RING_BYTES = 131072;
constexpr int LDSCTL_OFF = RING_BYTES, MISC_OFF = LDSCTL_OFF + 320;
constexpr int EXCH_OFF = RING_BYTES + 1024;
constexpr int LDS_BYTES = 147456;
static_assert(EXCH_OFF + 8192 <= LDS_BYTES && MISC_OFF + 128 <= EXCH_OFF, "LDS map");
constexpr int NWAVES = 8;

#define LAS __attribute__((address_space(3)))
typedef unsigned short bf16;
typedef float f32x4 __attribute__((ext_vector_type(4)));
typedef float f32x2 __attribute__((ext_vector_type(2)));
typedef short bf16x8 __attribute__((ext_vector_type(8)));
typedef short s16x4 __attribute__((ext_vector_type(4)));
typedef unsigned u32x4 __attribute__((ext_vector_type(4)));
typedef unsigned u32x2 __attribute__((ext_vector_type(2)));
#define LDS_WAIT() asm volatile("s_waitcnt lgkmcnt(0)" ::: "memory")
#define VM_WAIT() asm volatile("s_waitcnt vmcnt(0)" ::: "memory")
__device__ __forceinline__ unsigned f2bf(float f) { unsigned u = __builtin_bit_cast(unsigned, f); return (u + 0x7fffu + ((u >> 16) & 1u)) >> 16; }
__device__ __forceinline__ unsigned pk2(float lo, float hi) { return f2bf(lo) | (f2bf(hi) << 16); }
using pg8::cvt_pk_bf16; using pg8::bf_lo; using pg8::bf_hi;

#define XB_TMO      128
#define XB_XCNT(j)  (256  + 64 * (j))
#define XB_XSUB(j)  (1280 + 64 * (j))
#define XB_XGEN(j)  (2304 + 64 * (j))
#define XB_TOP      3328
#define XB_TOPGEN   3392
#define XCD_BAR_WORDS 3456
#define XB_SPIN_CAP (1u << 18)

__device__ __forceinline__ unsigned xb_ld(unsigned* p)              { return __hip_atomic_load(p, __ATOMIC_RELAXED, __HIP_MEMORY_SCOPE_AGENT); }
__device__ __forceinline__ unsigned xb_add(unsigned* p, unsigned v) { return __hip_atomic_fetch_add(p, v, __ATOMIC_RELAXED, __HIP_MEMORY_SCOPE_AGENT); }
__device__ __forceinline__ unsigned xb_xcc_id() { return (unsigned)__builtin_amdgcn_s_getreg((3 << 11) | 20) & 0xFu; }
#define XB_SPIN(cond, bar) do { unsigned _sp = 0; while (cond) { __builtin_amdgcn_s_sleep(1); \
    if ((++_sp & 255u) == 0u) { if (xb_ld(&(bar)[XB_TMO])) break; if (_sp > XB_SPIN_CAP) { atomicAdd(&(bar)[XB_TMO], 1u); break; } } } } while (0)

struct XcdBarrier {
    unsigned* bar; unsigned x;
    volatile LAS unsigned* st;
};

__device__ __forceinline__ XcdBarrier xcd_barrier_post(unsigned* bar, volatile LAS unsigned* st) {
    XcdBarrier b; b.bar = bar; b.x = xb_xcc_id(); b.st = st;
    if (threadIdx.x == 0) (void)xb_add(&bar[XB_XCNT(b.x)], 1u);
    return b;
}
__device__ __forceinline__ void xcd_barrier_complete(unsigned* bar, unsigned x, unsigned& nloc, unsigned& nx) {
    const unsigned G = gridDim.x * gridDim.y * gridDim.z;
    unsigned sum, cnt, mine, sp = 0u;
    for (;;) {
        sum = 0u; cnt = 0u; mine = 0u;
#pragma unroll
        for (unsigned j = 0; j < 16; ++j) { const unsigned c = xb_ld(&bar[XB_XCNT(j)]); sum += c; cnt += (c > 0u) ? 1u : 0u; mine = (j == x) ? c : mine; }
        if (sum == G) break;
        __builtin_amdgcn_s_sleep(1);
        if ((++sp & 255u) == 0u) { if (xb_ld(&bar[XB_TMO])) break; if (sp > XB_SPIN_CAP) { atomicAdd(&bar[XB_TMO], 1u); break; } }
    }
    nloc = mine > 0u ? mine : 1u; nx = cnt > 0u ? cnt : 1u;
}

__device__ __forceinline__ void xcd_barrier(const XcdBarrier& b) {
    asm volatile("s_waitcnt vmcnt(0)" ::: "memory");
    __syncthreads();
    if (threadIdx.x == 0) {
        unsigned* bar = b.bar;
        __builtin_amdgcn_s_waitcnt(0);
        unsigned nloc = b.st[0], nx = b.st[1];
        if (nloc == 0u) { xcd_barrier_complete(bar, b.x, nloc, nx); b.st[0] = nloc; b.st[1] = nx; }
        const unsigned old = xb_add(&bar[XB_XSUB(b.x)], 1u);
        const unsigned gen = old / nloc;
        if (old + 1u == (gen + 1u) * nloc) {
            __builtin_amdgcn_fence(__ATOMIC_RELEASE, "agent");
            asm volatile("s_waitcnt vmcnt(0)" ::: "memory");
            const unsigned og = xb_add(&bar[XB_TOP], 1u);
            const unsigned tg = og / nx;
            if (og + 1u == (tg + 1u) * nx) xb_add(&bar[XB_TOPGEN], 1u);
            else XB_SPIN(xb_ld(&bar[XB_TOPGEN]) == tg, bar);
            __builtin_amdgcn_fence(__ATOMIC_ACQUIRE, "agent");
            xb_add(&bar[XB_XGEN(b.x)], 1u);
            asm volatile("s_waitcnt vmcnt(0)" ::: "memory");
        } else {
            XB_SPIN(xb_ld(&bar[XB_XGEN(b.x)]) == gen, bar);
            __builtin_amdgcn_fence(__ATOMIC_ACQUIRE, "agent");
            asm volatile("s_waitcnt vmcnt(0)" ::: "memory");
        }
    }
    __syncthreads();
}

struct Frame {
    LAS unsigned char* lds;
    volatile LAS unsigned* MISC;
    unsigned* ctl;
    int tid, lane, wave;
    int vcu, G;
    unsigned char* ws; float* out;
};
__device__ __forceinline__ void frame_refresh(Frame& F, unsigned char* ws, float* out) {
    asm volatile("" : "+s"(ws)); asm volatile("" : "+s"(out)); F.ws = ws; F.out = out; F.ctl = (unsigned*)(ws + WS_CTL);
    F.tid = pg8::opaque_tid(); F.lane = F.tid & 63; F.wave = __builtin_amdgcn_readfirstlane(F.tid >> 6);
    const int bx = pg8::opaque_bid(); F.vcu = (F.G % 8 == 0) ? (bx % 8) * (F.G / 8) + bx / 8 : bx;
}
template <int CTRL> __device__ __forceinline__ float dpp_mov(float v) { return __int_as_float(__builtin_amdgcn_update_dpp(0, __float_as_int(v), CTRL, 0xf, 0xf, false)); }
__device__ __forceinline__ float wave_sum(float v) {
    v += dpp_mov<0xB1>(v);
    v += dpp_mov<0x4E>(v);
    v += dpp_mov<0x141>(v);
    v += dpp_mov<0x140>(v);
    const float s0 = __int_as_float(__builtin_amdgcn_readlane(__float_as_int(v), 0)), s1 = __int_as_float(__builtin_amdgcn_readlane(__float_as_int(v), 16));
    const float s2 = __int_as_float(__builtin_amdgcn_readlane(__float_as_int(v), 32)), s3 = __int_as_float(__builtin_amdgcn_readlane(__float_as_int(v), 48));
    return (s0 + s1) + (s2 + s3);
}
__device__ __forceinline__ float xrow_max(float v) {
    { const auto r = __builtin_amdgcn_permlane16_swap(__float_as_uint(v), __float_as_uint(v), false, false); v = fmaxf(__uint_as_float(r[0]), __uint_as_float(r[1])); }
    { const auto r = __builtin_amdgcn_permlane32_swap(__float_as_uint(v), __float_as_uint(v), false, false); v = fmaxf(__uint_as_float(r[0]), __uint_as_float(r[1])); }
    return v;
}
__device__ __forceinline__ float xrow_sum(float v) {
    { const auto r = __builtin_amdgcn_permlane16_swap(__float_as_uint(v), __float_as_uint(v), false, false); v = __uint_as_float(r[0]) + __uint_as_float(r[1]); }
    { const auto r = __builtin_amdgcn_permlane32_swap(__float_as_uint(v), __float_as_uint(v), false, false); v = __uint_as_float(r[0]) + __uint_as_float(r[1]); }
    return v;
}

__device__ __forceinline__ void p0_transpose_item(const float* W, int K, int N, bf16* WT, int k0, int n0, int dst_row0, LAS float* scr, int lane) {
#pragma unroll 8
    for (int i = 0; i < 32; ++i) { const int kk = 2 * i + (lane >> 5); scr[kk * 33 + (lane & 31)] = W[(size_t)(k0 + kk) * N + n0 + (lane & 31)]; }
    LDS_WAIT(); asm volatile("" ::: "memory");
    const int c = lane & 7;
#pragma unroll
    for (int j = 0; j < 4; ++j) { const int n = (lane >> 3) + 8 * j; const LAS float* s = scr + (8 * c) * 33 + n;
        u32x4 o; o.x = pk2(s[0 * 33], s[1 * 33]); o.y = pk2(s[2 * 33], s[3 * 33]); o.z = pk2(s[4 * 33], s[5 * 33]); o.w = pk2(s[6 * 33], s[7 * 33]);
        *(u32x4*)(WT + (size_t)(dst_row0 + n) * (K + KPAD) + k0 + 8 * c) = o; }
    LDS_WAIT(); asm volatile("" ::: "memory");
}
struct P0In { const float *c, *ada_w, *ada_b, *attn_w_in, *attn_w_out, *ssm_w_in, *log_step, *a_re, *a_im, *b_re, *b_im, *c_re, *c_im, *ssm_w_gate, *ssm_w_out, *ffn_w_up, *ffn_w_down; };

__device__ __forceinline__ void p0_ada_unit(Frame& F, const P0In& in, int unit) {
    LAS float* csl = (LAS float*)(F.lds + RING_OFF);
    for (int idx = F.tid; idx < BATCH * D; idx += NWAVES * 64) { const int b = idx / D, k = idx % D; const float v = in.c[idx]; csl[k * 16 + b] = v / (1.0f + __expf(-v)); }
    __syncthreads();
    const int li = unit >> 6, c0 = (unit & 63) * 192 + F.lane;
    const float* W = in.ada_w + (size_t)li * D * MODW + c0;
    float acc[3][16];
#pragma unroll
    for (int c = 0; c < 3; ++c)
#pragma unroll
        for (int b = 0; b < 16; ++b) acc[c][b] = 0.f;
    const int kbeg = F.wave * 256;
#pragma unroll 4
    for (int k = kbeg; k < kbeg + 256; ++k) {
        const float w0 = W[(size_t)k * MODW], w1 = W[(size_t)k * MODW + 64], w2 = W[(size_t)k * MODW + 128];
        const LAS f32x4* cp = (const LAS f32x4*)(csl + k * 16);
        const f32x4 s0 = cp[0], s1 = cp[1], s2 = cp[2], s3 = cp[3];
        const float cs[16] = {s0[0], s0[1], s0[2], s0[3], s1[0], s1[1], s1[2], s1[3], s2[0], s2[1], s2[2], s2[3], s3[0], s3[1], s3[2], s3[3]};
#pragma unroll
        for (int b = 0; b < 16; ++b) { acc[0][b] += w0 * cs[b]; acc[1][b] += w1 * cs[b]; acc[2][b] += w2 * cs[b]; }
    }
    __syncthreads();
    LAS float* part = (LAS float*)(F.lds + RING_OFF);
#pragma unroll
    for (int c = 0; c < 3; ++c)
#pragma unroll
        for (int b = 0; b < 16; ++b) part[(F.wave * 16 + b) * 192 + c * 64 + F.lane] = acc[c][b];
    __syncthreads();
    float* mod = (float*)(F.ws + WS_MOD);
    for (int o = F.tid; o < 16 * 192; o += NWAVES * 64) { const int b = o / 192, cc = o % 192; float s = 0.f;
#pragma unroll
        for (int w = 0; w < 8; ++w) s += part[(w * 16 + b) * 192 + cc];
        const int n = (unit & 63) * 192 + cc; mod[((size_t)li * BATCH + b) * MODW + n] = s + in.ada_b[(size_t)li * MODW + n]; }
    __syncthreads();
}
__device__ __forceinline__ void s5_coef(const P0In& in, int jg, int p, float& lbr, float& lbi, float& cfr, float& cfi) {
    const float step = __expf(in.log_step[jg]);
    const float lr = in.a_re[(size_t)jg * SP + p], li = in.a_im[(size_t)jg * SP + p];
    const float mag = expf(lr * step), ang = li * step;
    lbr = mag * cosf(ang); lbi = mag * sinf(ang);
    const float nr = lbr - 1.0f, ni = lbi, den = lr * lr + li * li;
    cfr = (nr * lr + ni * li) / den; cfi = (ni * lr - nr * li) / den;
}
__device__ __forceinline__ void p0_s5_tables(Frame& F, const P0In& in, int jg) {
    unsigned* tab = (unsigned*)(F.ws + WS_S5T) + (size_t)jg * S5T_WORDS;
    const int t = F.tid;
    if (t < 64) {
        float lbr, lbi, cfr, cfi; s5_coef(in, jg, t, lbr, lbi, cfr, cfi);
        float ar = lbr, ai = lbi;
#pragma unroll
        for (int s = 0; s < 7; ++s) { const float nr = ar * ar - ai * ai, ni = 2.0f * ar * ai; ar = nr; ai = ni; }
        tab[t] = __float_as_uint(lbr); tab[64 + t] = __float_as_uint(lbi); tab[128 + t] = __float_as_uint(ar); tab[192 + t] = __float_as_uint(ai);
    }
    {
        const int tau = t >> 6, lane = t & 63, q = tau >> 1, part = tau & 1, p = 16 * q + (lane & 15), c0 = 4 * (lane >> 4);
        float lbr, lbi, cfr, cfi; s5_coef(in, jg, p, lbr, lbi, cfr, cfi);
        const float* br = in.b_re + ((size_t)jg * SP + p) * SG + c0; const float* bi = in.b_im + ((size_t)jg * SP + p) * SG + c0;
        float v[4];
#pragma unroll
        for (int j = 0; j < 4; ++j) v[j] = part ? (cfr * bi[j] + cfi * br[j]) : (cfr * br[j] - cfi * bi[j]);
        tab[256 + (tau * 64 + lane) * 2 + 0] = pk2(v[0], v[1]); tab[256 + (tau * 64 + lane) * 2 + 1] = pk2(v[2], v[3]);
    }
    if (t < 256) {
        const int q = t >> 6, lane = t & 63, c = lane & 15, g4 = lane >> 4;
        const float* cr = in.c_re + ((size_t)jg * SG + c) * SP + 16 * q + 4 * g4; const float* ci = in.c_im + ((size_t)jg * SG + c) * SP + 16 * q + 4 * g4;
        unsigned* o = tab + 1280 + (q * 64 + lane) * 4;
        o[0] = pk2(cr[0], cr[1]); o[1] = pk2(cr[2], cr[3]); o[2] = pk2(-ci[0], -ci[1]); o[3] = pk2(-ci[2], -ci[3]);
    }
}
__device__ __forceinline__ void p0_prologue(Frame& F, const P0In& in) {
    for (int u = F.vcu; u < 256; u += F.G) p0_ada_unit(F, in, u);
    for (int u = F.vcu; u < 2 * NG; u += F.G) p0_s5_tables(F, in, u);
    LAS float* scr = (LAS float*)(F.lds + RING_OFF + F.wave * 16384);
    const int gw = F.vcu * NWAVES + F.wave, NGW = F.G * NWAVES;
    constexpr int I_AIN = (D / 64) * (AIN / 32), I_DD = (D / 64) * (D / 32), I_UP = (D / 64) * (FF2 / 32), I_DN = (FF / 64) * (D / 32);
    constexpr int C0 = 2 * I_AIN, C1 = C0 + 2 * I_DD, C2 = C1 + 2 * I_DD, C3 = C2 + 2 * I_DD, C4 = C3 + 2 * I_DD, C5 = C4 + 4 * I_UP, C6 = C5 + 4 * I_DN;
    for (int it = gw; it < C6; it += NGW) {
        const float* W; bf16* WT; int K, N, r; bool up = false;
        if (it < C0)      { r = it;      const int j = r / I_AIN; r -= j * I_AIN; K = D; N = AIN; W = in.attn_w_in + (size_t)j * D * AIN;  WT = (bf16*)(F.ws + WS_WAIN + j * W_AIN_B); }
        else if (it < C1) { r = it - C0; const int j = r / I_DD;  r -= j * I_DD;  K = D; N = D;   W = in.attn_w_out + (size_t)j * D * D;   WT = (bf16*)(F.ws + WS_WAOUT + j * W_DD_B); }
        else if (it < C2) { r = it - C1; const int j = r / I_DD;  r -= j * I_DD;  K = D; N = D;   W = in.ssm_w_in + (size_t)j * D * D;     WT = (bf16*)(F.ws + WS_WSIN + j * W_DD_B); }
        else if (it < C3) { r = it - C2; const int j = r / I_DD;  r -= j * I_DD;  K = D; N = D;   W = in.ssm_w_gate + (size_t)j * D * D;   WT = (bf16*)(F.ws + WS_WSGATE + j * W_DD_B); }
        else if (it < C4) { r = it - C3; const int j = r / I_DD;  r -= j * I_DD;  K = D; N = D;   W = in.ssm_w_out + (size_t)j * D * D;    WT = (bf16*)(F.ws + WS_WSOUT + j * W_DD_B); }
        else if (it < C5) { r = it - C4; const int j = r / I_UP;  r -= j * I_UP;  K = D; N = FF2; W = in.ffn_w_up + (size_t)j * D * FF2;   WT = (bf16*)(F.ws + WS_WUP + j * W_UP_B); up = true; }
        else              { r = it - C5; const int j = r / I_DN;  r -= j * I_DN;  K = FF; N = D;  W = in.ffn_w_down + (size_t)j * FF * D;  WT = (bf16*)(F.ws + WS_WDOWN + j * W_DN_B); }
        const int nblk = N / 32, kb = r / nblk, nb = r % nblk, n0 = 32 * nb;
        int drow = n0;
        if (up) { const int half = n0 >= FF ? 1 : 0, nn = n0 - half * FF; drow = 256 * (nn >> 7) + 128 * half + (nn & 127); }
        p0_transpose_item(W, K, N, WT, 64 * kb, n0, drow, scr, F.lane);
    }
}

__device__ __forceinline__ void norm_mod_phase(Frame& F, const float* xin, bf16* hout, const float* gain, const float* modl, int sh_off, int sc_off) {
    const int gw = F.vcu * NWAVES + F.wave, NGW = F.G * NWAVES;
    for (int blk = gw; blk < M / 16; blk += NGW) {
        const int row0 = blk * 16, b = row0 / T;
        f32x4 A[8], Bv[8];
#pragma unroll
        for (int j = 0; j < 8; ++j) { const int col = 4 * F.lane + 256 * j;
            const f32x4 g = *(const f32x4*)(gain + col), sc = *(const f32x4*)(modl + (size_t)b * MODW + sc_off + col);
            A[j] = g * (sc + 1.0f); Bv[j] = *(const f32x4*)(modl + (size_t)b * MODW + sh_off + col); }
        f32x4 cur[8], nxt[8];
#pragma unroll
        for (int j = 0; j < 8; ++j) cur[j] = *(const f32x4*)(xin + (size_t)row0 * D + 4 * F.lane + 256 * j);
        for (int r = 0; r < 16; ++r) {
            const int rn = (r + 1 < 16) ? r + 1 : r;
#pragma unroll
            for (int j = 0; j < 8; ++j) nxt[j] = *(const f32x4*)(xin + (size_t)(row0 + rn) * D + 4 * F.lane + 256 * j);
            float ss = 0.f;
#pragma unroll
            for (int j = 0; j < 8; ++j) ss += (cur[j][0] * cur[j][0] + cur[j][1] * cur[j][1]) + (cur[j][2] * cur[j][2] + cur[j][3] * cur[j][3]);
            const float rstd = __builtin_amdgcn_rsqf(wave_sum(ss) * (1.0f / D) + EPS);
            unsigned long long* o8 = (unsigned long long*)(hout + (size_t)(row0 + r) * DP) + F.lane;
#pragma unroll
            for (int j = 0; j < 8; ++j) { const f32x4 v = cur[j] * rstd * A[j] + Bv[j];
                o8[64 * j] = (unsigned long long)cvt_pk_bf16(v[0], v[1]) | ((unsigned long long)cvt_pk_bf16(v[2], v[3]) << 32); }
#pragma unroll
            for (int j = 0; j < 8; ++j) cur[j] = nxt[j];
        }
    }
}
__device__ __forceinline__ void final_norm_phase(Frame& F, const float* xin, float* out, const float* gain) {
    const int gw = F.vcu * NWAVES + F.wave, NGW = F.G * NWAVES;
    f32x4 A[8];
#pragma unroll
    for (int j = 0; j < 8; ++j) A[j] = *(const f32x4*)(gain + 4 * F.lane + 256 * j);
    for (int blk = gw; blk < M / 16; blk += NGW) {
        const int row0 = blk * 16;
        for (int r = 0; r < 16; ++r) {
            f32x4 cur[8];
#pragma unroll
            for (int j = 0; j < 8; ++j) cur[j] = *(const f32x4*)(xin + (size_t)(row0 + r) * D + 4 * F.lane + 256 * j);
            float ss = 0.f;
#pragma unroll
            for (int j = 0; j < 8; ++j) ss += (cur[j][0] * cur[j][0] + cur[j][1] * cur[j][1]) + (cur[j][2] * cur[j][2] + cur[j][3] * cur[j][3]);
            const float rstd = __builtin_amdgcn_rsqf(wave_sum(ss) * (1.0f / D) + EPS);
#pragma unroll
            for (int j = 0; j < 8; ++j) *(f32x4*)(out + (size_t)(row0 + r) * D + 4 * F.lane + 256 * j) = cur[j] * rstd * A[j];
        }
    }
}

__device__ __forceinline__ void conv_fix_phase(Frame& F, const float* raw, bf16* aout, const float* cw, const float* cb) {
    const int gt = (F.vcu * NWAVES + F.wave) * 64 + F.lane, NT = F.G * NWAVES * 64;
    constexpr int C4 = FF / 4, NITEM = 112 * 2 * C4;
    for (int it = gt; it < NITEM; it += NT) {
        const int c4 = it % C4, rr = (it / C4) & 1, bi = it / (2 * C4), pm = (bi / 7) * 8 + 1 + (bi % 7), gc = 4 * c4;
        const float* r_m2 = raw + ((size_t)(pm - 1) * 4 + 2) * FF2; const float* r_m1 = raw + ((size_t)(pm - 1) * 4 + 3) * FF2;
        const float* r_0 = raw + ((size_t)pm * 4 + 0) * FF2;       const float* r_1 = raw + ((size_t)pm * 4 + 1) * FF2;
        const float* pc = rr ? r_1 : r_0; const float* p1 = rr ? r_0 : r_m1; const float* p2 = rr ? r_m1 : r_m2;
        float o[4];
        const f32x4 cg = *(const f32x4*)(pc + gc), g1 = *(const f32x4*)(p1 + gc), g2 = *(const f32x4*)(p2 + gc);
        const f32x4 cu = *(const f32x4*)(pc + FF + gc), u1 = *(const f32x4*)(p1 + FF + gc), u2 = *(const f32x4*)(p2 + FF + gc);
        const f32x4 wg0 = *(const f32x4*)(cw + gc), wg1 = *(const f32x4*)(cw + FF2 + gc), wg2 = *(const f32x4*)(cw + 2 * FF2 + gc), bg = *(const f32x4*)(cb + gc);
        const f32x4 wu0 = *(const f32x4*)(cw + FF + gc), wu1 = *(const f32x4*)(cw + FF2 + FF + gc), wu2 = *(const f32x4*)(cw + 2 * FF2 + FF + gc), bu = *(const f32x4*)(cb + FF + gc);
#pragma unroll
        for (int e = 0; e < 4; ++e) { const float gg = bg[e] + wg2[e] * cg[e] + wg1[e] * g1[e] + wg0[e] * g2[e], uu = bu[e] + wu2[e] * cu[e] + wu1[e] * u1[e] + wu0[e] * u2[e];
            o[e] = gg * pg8::fast_sigmoid(gg) * uu; }
        u32x2 w; w.x = cvt_pk_bf16(o[0], o[1]); w.y = cvt_pk_bf16(o[2], o[3]);
        *(u32x2*)(aout + (size_t)(pm * 256 + rr) * FFP + gc) = w;
    }
}

namespace att {
constexpr int SLOT = 32768, K_OFF = 0, V_OFF = 65536;
__device__ __forceinline__ int kswz(int row, int colB) { return row * 256 + (colB ^ ((row & 15) << 4)); }
__device__ __forceinline__ int vperm(int k) { return (k & ~0xC) | ((k & 4) << 1) | ((k & 8) >> 1); }
__device__ __forceinline__ int voff(int row, int ch) { return 256 * row + 16 * (ch ^ (((row & 3) << 2) | ((row >> 2) & 3))); }
__device__ __forceinline__ s16x4 tr_read(int addr) { s16x4 r; asm volatile("ds_read_b64_tr_b16 %0, %1" : "=&v"(r) : "v"(addr) : "memory"); return r; }
struct Stg { u32x4 k[4], v[4]; };
}
__device__ __forceinline__ void attn_phase(Frame& F, bf16* proj, bf16* obuf, float* lse) {
    using namespace att;
    const int w = F.wave;
    for (int unit = F.vcu; unit < BATCH * NH; unit += F.G) {
        const int b = unit >> 4, h = unit & 15;
        bf16* qbase = proj + (size_t)unit * 3 * T * HD; const bf16* kbase = proj + pg8::QK_PART + (size_t)unit * 3 * T * HD; const bf16* vbase = proj + 2 * pg8::QK_PART + (size_t)unit * T * HD;
        const float c1 = 0.08838834764831845f * 1.4426950408889634f;
        const float slope2 = exp2f(-0.5f * (float)(h + 1)) * 1.4426950408889634f;
        Stg st;
        int tid = F.tid;
#define ATT_LANE() asm volatile("" : "+v"(tid)); const int lane = tid & 63, q16 = lane & 15, g4 = lane >> 4, skey = tid >> 4, sch = tid & 15
#define ATT_DECODE(bu, grp, dil, cls, n) const int grp = 2 - ((bu) >> 4), dil = 1 << (2 * grp), nbk = 16 >> (2 * grp), cls = ((bu) & 15) / nbk, n = ((bu) & 15) % nbk
#define ATT_LOAD(bu) do { ATT_DECODE(bu, grp_, dil_, cls_, n_); const bf16* kb_ = kbase + (size_t)grp_ * T * HD + (size_t)(cls_ * (T >> (2 * grp_)) + 128 * n_) * HD + sch * 8; \
            _Pragma("unroll") for (int i = 0; i < 4; ++i) { const int key_ = skey + 32 * i; \
            st.k[i] = *(const u32x4*)(kb_ + (size_t)key_ * HD); st.v[i] = *(const u32x4*)(vbase + (size_t)((128 * n_ + key_) * dil_ + cls_) * HD + sch * 8); } } while (0)
#define ATT_WRITE(slot) do { _Pragma("unroll") for (int i = 0; i < 4; ++i) { const int key_ = skey + 32 * i; \
            *(LAS u32x4*)(F.lds + K_OFF + (slot) * SLOT + kswz(key_, sch * 16)) = st.k[i]; *(LAS u32x4*)(F.lds + V_OFF + (slot) * SLOT + voff(vperm(key_), sch)) = st.v[i]; } } while (0)
        { ATT_LANE(); (void)q16; (void)g4; (void)lane;
        ATT_LOAD(0);
        { unsigned z0 = 0u; asm volatile("" : "+v"(z0));
          for (int i = tid; i < SLOT / 16; i += NWAVES * 64) *(LAS u32x4*)(F.lds + V_OFF + SLOT + i * 16) = (u32x4){z0, z0, z0, z0}; }
        ATT_WRITE(0); }
        __syncthreads();
        for (int bu = 0; bu < 48; ++bu) {
            ATT_LANE();
            ATT_DECODE(bu, grp, dil, cls, n);
            const int cur = bu & 1, prev = cur ^ 1;
            const int cpq = 128 * n + 16 * w + q16;
            const size_t rowq = (size_t)b * T + (size_t)cpq * dil + cls;
            bf16* qp = qbase + ((size_t)grp * T + cls * (T >> (2 * grp)) + cpq) * HD;
            bf16x8 qf[4];
#pragma unroll
            for (int ks = 0; ks < 4; ++ks) qf[ks] = *(const bf16x8*)(qp + 32 * ks + 8 * g4);
            if (bu + 1 < 48) ATT_LOAD(bu + 1);
            f32x4 s[9];
            int kx[4];
#pragma unroll
            for (int ks = 0; ks < 4; ++ks) kx[ks] = q16 * 256 + ((64 * ks + 16 * g4) ^ (q16 << 4));
            const int ring0 = prev * SLOT;
#pragma unroll
            for (int t = 0; t < 9; ++t) { const int base = K_OFF + (((w + t) * 4096 + ring0) & 0xFFFF);
                s[t] = (f32x4){0.f, 0.f, 0.f, 0.f};
#pragma unroll
                for (int ks = 0; ks < 4; ++ks) { const bf16x8 kf = *(const LAS bf16x8*)(F.lds + base + kx[ks]); s[t] = __builtin_amdgcn_mfma_f32_16x16x32_bf16(kf, qf[ks], s[t], 0, 0, 0); }
                if (t & 1) __builtin_amdgcn_sched_barrier(0); }
            const float c2 = slope2 * (float)dil;
            float mx = -__builtin_inff();
#pragma unroll
            for (int t = 0; t < 9; ++t) { const bool tv = (n > 0) || (t >= 8 - w);
#pragma unroll
                for (int i = 0; i < 4; ++i) { const int kk = 4 * g4 + i; const float dist = (float)(128 - 16 * t + q16 - kk);
                    bool valid = tv; if (t == 0) valid = valid && (kk >= q16); if (t == 8) valid = valid && (kk <= q16);
                    const float z = valid ? (s[t][i] * c1 - c2 * dist) : -__builtin_inff(); s[t][i] = z; mx = fmaxf(mx, z); } }
            mx = xrow_max(mx);
            float l = 0.f;
            u32x2 pp[10];
#pragma unroll
            for (int t = 0; t < 9; ++t) { float p[4];
#pragma unroll
                for (int i = 0; i < 4; ++i) { p[i] = __builtin_amdgcn_exp2f(s[t][i] - mx); l += p[i]; }
                pp[t].x = cvt_pk_bf16(p[0], p[1]); pp[t].y = cvt_pk_bf16(p[2], p[3]); }
            pp[9].x = 0u; pp[9].y = 0u;
            l = xrow_sum(l);
            f32x4 o[8];
#pragma unroll
            for (int dt = 0; dt < 8; ++dt) o[dt] = (f32x4){0.f, 0.f, 0.f, 0.f};
            const int lq = (lane >> 2) & 3, lp = lane & 3;
            const int vmask = (lq << 2) | (2 * (g4 & 1) + (g4 >> 1));
            const int vlane = 256 * (8 * (g4 & 1) + 4 * (g4 >> 1) + lq) + 8 * (lp & 1), vpart = ((lp >> 1) ^ vmask) << 4;
            struct VB { s16x4 va[4], vb[4]; } vb0, vb1;
#define PV_READ(B, g) do { const int pr_ = (g) >> 1, dh_ = (g) & 1, ta_ = 2 * pr_, tb_ = (pr_ < 4) ? 2 * pr_ + 1 : 2 * pr_; \
                const int ba_ = V_OFF + (((w + ta_) * 4096 + ring0) & 0xFFFF) + vlane, bb_ = V_OFF + (((w + tb_) * 4096 + ring0) & 0xFFFF) + vlane; \
                _Pragma("unroll") for (int d = 0; d < 4; ++d) { const int dt_ = 4 * dh_ + d; B.va[d] = tr_read(ba_ + (vpart ^ (dt_ << 5))); B.vb[d] = tr_read(bb_ + (vpart ^ (dt_ << 5))); } } while (0)
#define PV_MMA(B, g) do { const int pr_ = (g) >> 1, dh_ = (g) & 1; u32x4 pw_; pw_.x = pp[2 * pr_].x; pw_.y = pp[2 * pr_].y; pw_.z = pp[2 * pr_ + 1].x; pw_.w = pp[2 * pr_ + 1].y; \
                const bf16x8 pa_ = __builtin_bit_cast(bf16x8, pw_); \
                _Pragma("unroll") for (int d = 0; d < 4; ++d) { const int dt_ = 4 * dh_ + d; const bf16x8 vf_ = (bf16x8){B.va[d][0], B.va[d][1], B.va[d][2], B.va[d][3], B.vb[d][0], B.vb[d][1], B.vb[d][2], B.vb[d][3]}; \
                    o[dt_] = __builtin_amdgcn_mfma_f32_16x16x32_bf16(vf_, pa_, o[dt_], 0, 0, 0); } } while (0)
#define PV_STEP(BC, BN, g) do { PV_READ(BN, (g) + 1); asm volatile("s_waitcnt lgkmcnt(8)" ::: "memory"); __builtin_amdgcn_sched_barrier(0); PV_MMA(BC, g); __builtin_amdgcn_sched_barrier(0); } while (0)
            asm volatile("s_waitcnt lgkmcnt(0)" ::: "memory"); __builtin_amdgcn_sched_barrier(0);
            PV_READ(vb0, 0);
            PV_STEP(vb0, vb1, 0); PV_STEP(vb1, vb0, 1); PV_STEP(vb0, vb1, 2); PV_STEP(vb1, vb0, 3); PV_STEP(vb0, vb1, 4); PV_STEP(vb1, vb0, 5); PV_STEP(vb0, vb1, 6); PV_STEP(vb1, vb0, 7); PV_STEP(vb0, vb1, 8);
            asm volatile("s_waitcnt lgkmcnt(0)" ::: "memory"); __builtin_amdgcn_sched_barrier(0); PV_MMA(vb1, 9); __builtin_amdgcn_sched_barrier(0);
#undef PV_READ
#undef PV_MMA
#undef PV_STEP
            const float inv = 1.0f / l, lse2 = mx + __builtin_amdgcn_logf(l);
            if (grp > 0) {
#pragma unroll
                for (int dt = 0; dt < 8; ++dt) { u32x2 wv; wv.x = cvt_pk_bf16(o[dt][0] * inv, o[dt][1] * inv); wv.y = cvt_pk_bf16(o[dt][2] * inv, o[dt][3] * inv);
                    *(u32x2*)(qp + 16 * dt + 4 * g4) = wv; }
                if (g4 == 0) lse[((size_t)(grp - 1) * M + rowq) * NH + h] = lse2;
            } else {
                const float l1 = lse[((size_t)0 * M + rowq) * NH + h], l2 = lse[((size_t)1 * M + rowq) * NH + h];
                const float mm = fmaxf(lse2, fmaxf(l1, l2));
                float w0 = __builtin_amdgcn_exp2f(lse2 - mm), w1 = __builtin_amdgcn_exp2f(l1 - mm), w2 = __builtin_amdgcn_exp2f(l2 - mm);
                const float wi = 1.0f / (w0 + w1 + w2); w0 *= wi * inv; w1 *= wi; w2 *= wi;
                const int tq = cpq;
                const bf16* o1p = qbase + ((size_t)1 * T + (tq & 3) * (T >> 2) + (tq >> 2)) * HD; const bf16* o2p = qbase + ((size_t)2 * T + (tq & 15) * (T >> 4) + (tq >> 4)) * HD;
                bf16* op = obuf + rowq * DP + h * HD;
#pragma unroll
                for (int dt = 0; dt < 8; ++dt) { const u32x2 a1 = *(const u32x2*)(o1p + 16 * dt + 4 * g4), a2 = *(const u32x2*)(o2p + 16 * dt + 4 * g4);
                    const float r0 = w0 * o[dt][0] + w1 * bf_lo(a1.x) + w2 * bf_lo(a2.x), r1 = w0 * o[dt][1] + w1 * bf_hi(a1.x) + w2 * bf_hi(a2.x);
                    const float r2 = w0 * o[dt][2] + w1 * bf_lo(a1.y) + w2 * bf_lo(a2.y), r3 = w0 * o[dt][3] + w1 * bf_hi(a1.y) + w2 * bf_hi(a2.y);
                    u32x2 wv; wv.x = cvt_pk_bf16(r0, r1); wv.y = cvt_pk_bf16(r2, r3); *(u32x2*)(op + 16 * dt + 4 * g4) = wv;
                    if ((dt & 3) == 3) __builtin_amdgcn_sched_barrier(0); }
            }
            if (bu == 31) VM_WAIT();
            __syncthreads();
            if (bu == 31) { __builtin_amdgcn_fence(__ATOMIC_ACQUIRE, "agent"); }
            if (bu + 1 < 48) ATT_WRITE(prev);
            __syncthreads();
        }
#undef ATT_DECODE
#undef ATT_LANE
#undef ATT_LOAD
#undef ATT_WRITE
    }
}

template <int CTRL> __device__ __forceinline__ float dpp_shr0(float v) { return __int_as_float(__builtin_amdgcn_update_dpp(0, __float_as_int(v), CTRL, 0xf, 0xf, true)); }
__device__ __forceinline__ float gelu_tanh(float v) {
    const float inner = 0.7978845608028654f * (v + 0.044715f * v * v * v);
    return v * __builtin_amdgcn_rcpf(1.0f + __builtin_amdgcn_exp2f(-2.8853900817779268f * inner));
}
__device__ __forceinline__ void s5_phase(Frame& F, const bf16* U, bf16* Gout, const unsigned* tabl, const float* dskip) {
    typedef __attribute__((address_space(1))) const bf16 gcbf; typedef __attribute__((address_space(1))) bf16 gbf;
    int tid = F.tid;
#define S5_LANE() asm volatile("" : "+v"(tid)); const int lane = tid & 63, vs = lane & 15, g4 = lane >> 4; (void)vs
    for (int unit = F.vcu; unit < BATCH * (NG / 8); unit += F.G) {
        const int b = unit >> 4, g = (unit & 15) * 8 + F.wave;
        const unsigned* tab = tabl + (size_t)g * S5T_WORDS;
        float lr[4][4], li[4][4], xr[4][4], xi[4][4];
        s16x4 bbf[8];
        { S5_LANE();
#pragma unroll
        for (int q = 0; q < 4; ++q)
#pragma unroll
            for (int i = 0; i < 4; ++i) { const int p = 16 * q + 4 * g4 + i; lr[q][i] = __uint_as_float(tab[p]); li[q][i] = __uint_as_float(tab[64 + p]); xr[q][i] = 0.f; xi[q][i] = 0.f; }
#pragma unroll
        for (int tau = 0; tau < 8; ++tau) bbf[tau] = *(const s16x4*)(tab + 256 + (tau * 64 + lane) * 2); }
        const f32x4 zero4 = (f32x4){0.f, 0.f, 0.f, 0.f};
        { S5_LANE();
        gcbf* upt = (gcbf*)(U + ((size_t)b * T + 128 * vs) * D + g * SG + 4 * g4);
#pragma unroll 2
        for (int tt = 0; tt < 128; ++tt, upt += D) {
            const s16x4 ub = *(const __attribute__((address_space(1))) s16x4*)upt;
#pragma unroll
            for (int q = 0; q < 4; ++q) {
                const f32x4 br = __builtin_amdgcn_mfma_f32_16x16x16bf16_1k(bbf[2 * q], ub, zero4, 0, 0, 0), bi = __builtin_amdgcn_mfma_f32_16x16x16bf16_1k(bbf[2 * q + 1], ub, zero4, 0, 0, 0);
#pragma unroll
                for (int i = 0; i < 4; ++i) { const float nr = lr[q][i] * xr[q][i] - li[q][i] * xi[q][i] + br[i], ni = lr[q][i] * xi[q][i] + li[q][i] * xr[q][i] + bi[i]; xr[q][i] = nr; xi[q][i] = ni; }
            }
        } }
        {
            S5_LANE();
            float ar[4][4], ai[4][4];
#pragma unroll
            for (int q = 0; q < 4; ++q)
#pragma unroll
                for (int i = 0; i < 4; ++i) { const int p = 16 * q + 4 * g4 + i; ar[q][i] = __uint_as_float(tab[128 + p]); ai[q][i] = __uint_as_float(tab[192 + p]); }
#define S5_STEP(CTRL) do { _Pragma("unroll") for (int q = 0; q < 4; ++q) _Pragma("unroll") for (int i = 0; i < 4; ++i) { \
                const float nbr = dpp_shr0<CTRL>(xr[q][i]), nbi = dpp_shr0<CTRL>(xi[q][i]); \
                xr[q][i] += ar[q][i] * nbr - ai[q][i] * nbi; xi[q][i] += ar[q][i] * nbi + ai[q][i] * nbr; \
                const float sr = ar[q][i] * ar[q][i] - ai[q][i] * ai[q][i], si = 2.0f * ar[q][i] * ai[q][i]; ar[q][i] = sr; ai[q][i] = si; } } while (0)
            S5_STEP(0x111); S5_STEP(0x112); S5_STEP(0x114); S5_STEP(0x118);
#undef S5_STEP
#pragma unroll
            for (int q = 0; q < 4; ++q)
#pragma unroll
                for (int i = 0; i < 4; ++i) { xr[q][i] = dpp_shr0<0x111>(xr[q][i]); xi[q][i] = dpp_shr0<0x111>(xi[q][i]); }
        }
        { S5_LANE();
        bf16x8 cmf[4];
#pragma unroll
        for (int q = 0; q < 4; ++q) cmf[q] = *(const bf16x8*)(tab + 1280 + (q * 64 + lane) * 4);
        const f32x4 dsk = *(const f32x4*)(dskip + g * SG + 4 * g4);
        gcbf* upt = (gcbf*)(U + ((size_t)b * T + 128 * vs) * D + g * SG + 4 * g4);
        gbf* gp = (gbf*)(Gout + ((size_t)b * T + 128 * vs) * DP + g * SG + 4 * g4);
#pragma unroll 1
        for (int tt = 0; tt < 128; ++tt, upt += D, gp += DP) {
            const u32x2 uw = *(const __attribute__((address_space(1))) u32x2*)upt;
            const s16x4 ub = __builtin_bit_cast(s16x4, uw);
            f32x4 y = zero4;
#pragma unroll
            for (int q = 0; q < 4; ++q) {
                const f32x4 br = __builtin_amdgcn_mfma_f32_16x16x16bf16_1k(bbf[2 * q], ub, zero4, 0, 0, 0), bi = __builtin_amdgcn_mfma_f32_16x16x16bf16_1k(bbf[2 * q + 1], ub, zero4, 0, 0, 0);
#pragma unroll
                for (int i = 0; i < 4; ++i) { const float nr = lr[q][i] * xr[q][i] - li[q][i] * xi[q][i] + br[i], ni = lr[q][i] * xi[q][i] + li[q][i] * xr[q][i] + bi[i]; xr[q][i] = nr; xi[q][i] = ni; }
                u32x4 xw; xw.x = cvt_pk_bf16(xr[q][0], xr[q][1]); xw.y = cvt_pk_bf16(xr[q][2], xr[q][3]); xw.z = cvt_pk_bf16(xi[q][0], xi[q][1]); xw.w = cvt_pk_bf16(xi[q][2], xi[q][3]);
                y = __builtin_amdgcn_mfma_f32_16x16x32_bf16(cmf[q], __builtin_bit_cast(bf16x8, xw), y, 0, 0, 0);
            }
            const float v0 = y[0] + dsk[0] * bf_lo(uw.x), v1 = y[1] + dsk[1] * bf_hi(uw.x), v2 = y[2] + dsk[2] * bf_lo(uw.y), v3 = y[3] + dsk[3] * bf_hi(uw.y);
            u32x2 ow; ow.x = cvt_pk_bf16(gelu_tanh(v0), gelu_tanh(v1)); ow.y = cvt_pk_bf16(gelu_tanh(v2), gelu_tanh(v3));
            *(__attribute__((address_space(1))) u32x2*)gp = ow;
        } }
    }
#undef S5_LANE
}

constexpr int NPH_PAIR = 17, NPHASE = 2 + 2 * NPH_PAIR;
struct Args { const float* in[24]; float* out; unsigned char* ws; int ph_lo, ph_hi, dry, pad; };
__device__ __forceinline__ const float* argp(const Args& a, int i) { asm volatile("" : "+s"(i)); return a.in[i]; }
__global__ void __launch_bounds__(NWAVES * 64, 2) fwd_kernel(Args args) {
    extern __shared__ __attribute__((aligned(16))) unsigned char lds[];
    Frame F;
    F.lds = (LAS unsigned char*)lds;
    F.MISC = (volatile LAS unsigned*)(F.lds + MISC_OFF);
    F.tid = threadIdx.x; F.lane = F.tid & 63; F.wave = __builtin_amdgcn_readfirstlane(F.tid >> 6);
    F.G = gridDim.x; { const int bx = blockIdx.x; F.vcu = (F.G % 8 == 0) ? (bx % 8) * (F.G / 8) + bx / 8 : bx; }
    F.ws = args.ws; F.ctl = (unsigned*)(F.ws + WS_CTL);
    for (int u = F.tid; u < (EXCH_OFF - LDSCTL_OFF) / 4; u += NWAVES * 64) ((LAS unsigned*)(F.lds + LDSCTL_OFF))[u] = 0u;
    __syncthreads();
#if MK_ONE_LAUNCH
    XcdBarrier bar = xcd_barrier_post(F.ctl + CW_BAR, F.MISC + 8);
#if MK_DOUBLE_BAR
#define GRID_BAR() do { xcd_barrier(bar); xcd_barrier(bar); } while (0)
#else
#define GRID_BAR() xcd_barrier(bar)
#endif
#else
#define GRID_BAR() do { } while (0)
#endif
    const int lo = args.ph_lo, hi = args.ph_hi;
#define IN(k) (lo <= (k) && (k) < hi && (frame_refresh(F, args.ws, args.out), true))
#define SEAM(k) do { if (lo <= (k) && (k) + 1 < hi) GRID_BAR(); } while (0)
#define xres (F.out)
#if MK_DRY_MASK
#define xout (args.dry ? (float*)(F.ws + WS_BIG + 512 * MiB) : F.out)
#else
#define xout (F.out)
#endif
#define Hb ((bf16*)(F.ws + WS_H))
#define BIG ((bf16*)(F.ws + WS_BIG))
#define ring (F.lds + RING_OFF)
#define moda ((const float*)(F.ws + WS_MOD) + (size_t)la * BATCH * MODW)
#define mods ((const float*)(F.ws + WS_MOD) + (size_t)ls * BATCH * MODW)
#define xa ((pr == 0) ? argp(args, 0) : (const float*)F.out)

    if (IN(0)) {
        P0In pin{argp(args, 1), argp(args, 2), argp(args, 3), argp(args, 6), argp(args, 7), argp(args, 8), argp(args, 9), argp(args, 10), argp(args, 11), argp(args, 12), argp(args, 13), argp(args, 14), argp(args, 15),
                 argp(args, 17), argp(args, 18), argp(args, 19), argp(args, 22)};
        p0_prologue(F, pin);
    }
    SEAM(0);
    for (int pr = 0; pr < 2; ++pr) {
        const int pb = 1 + NPH_PAIR * pr, la = 2 * pr, ls = 2 * pr + 1;
        if (IN(pb + 0)) norm_mod_phase(F, xa, Hb, argp(args, 4) + (size_t)la * D, moda, 0, D);
        SEAM(pb + 0);
        if (IN(pb + 1)) { pg8::Gemm g{Hb, (const bf16*)(F.ws + WS_WAIN + pr * W_AIN_B), M, AIN, D, DP}; pg8::StaticOrder S; S.init(M, AIN, F.G, pg8::opaque_bid());
#if MK_DRY_MASK
            if (args.dry) { pg8::EpiNull E0; pg8::SameTileOrder S1; S1.init(M, AIN, F.G, pg8::opaque_bid()); pg8::gemm_phase<pg8::EpiNull, pg8::SameTileOrder, true, true>(ring, g, S1, E0); } else
#endif
            { pg8::EpiQKV E{BIG}; pg8::gemm_phase<pg8::EpiQKV, pg8::StaticOrder, true, true>(ring, g, S, E); } }
        SEAM(pb + 1);
#if MK_DRY_MASK
        if (IN(pb + 2)) { if (args.dry) attn_phase(F, BIG, (bf16*)F.out, (float*)(F.ws + WS_RAW)); else attn_phase(F, BIG, Hb, (float*)(F.ws + WS_LSE)); }
#else
        if (IN(pb + 2)) attn_phase(F, BIG, Hb, (float*)(F.ws + WS_LSE));
#endif
        SEAM(pb + 2);
        if (IN(pb + 3)) { pg8::Gemm g{Hb, (const bf16*)(F.ws + WS_WAOUT + pr * W_DD_B), M, D, D, DP}; pg8::StaticOrder S; S.init(M, D, F.G, pg8::opaque_bid());
            pg8::EpiGateRes E{xa, xout, moda + 2 * D}; pg8::gemm_phase<pg8::EpiGateRes, pg8::StaticOrder, true, true>(ring, g, S, E); }
        SEAM(pb + 3);
        if (IN(pb + 4)) norm_mod_phase(F, xres, Hb, argp(args, 5) + (size_t)la * D, moda, 3 * D, 4 * D);
        SEAM(pb + 4);
        if (IN(pb + 5)) { pg8::Gemm g{Hb, (const bf16*)(F.ws + WS_WUP + la * W_UP_B), M, FF2, D, DP}; pg8::StaticOrder S; S.init(M, FF2, F.G, pg8::opaque_bid());
            pg8::EpiConvGate E{BIG, (float*)(F.ws + WS_RAW), argp(args, 20) + (size_t)la * 3 * FF2, argp(args, 21) + (size_t)la * FF2, F.lds + EXCH_OFF};
            pg8::gemm_phase<pg8::EpiConvGate, pg8::StaticOrder, true, true>(ring, g, S, E); }
        SEAM(pb + 5);
        if (IN(pb + 6)) conv_fix_phase(F, (const float*)(F.ws + WS_RAW), BIG, argp(args, 20) + (size_t)la * 3 * FF2, argp(args, 21) + (size_t)la * FF2);
        SEAM(pb + 6);
        if (IN(pb + 7)) { pg8::Gemm g{BIG, (const bf16*)(F.ws + WS_WDOWN + la * W_DN_B), M, D, FF, FFP}; pg8::StaticOrder S; S.init(M, D, F.G, pg8::opaque_bid());
            pg8::EpiGateRes E{xres, xout, moda + 5 * D}; pg8::gemm_phase<pg8::EpiGateRes, pg8::StaticOrder, true, true>(ring, g, S, E); }
        SEAM(pb + 7);
        if (IN(pb + 8)) norm_mod_phase(F, xres, Hb, argp(args, 4) + (size_t)ls * D, mods, 0, D);
        SEAM(pb + 8);
        if (IN(pb + 9)) { pg8::Gemm g{Hb, (const bf16*)(F.ws + WS_WSIN + pr * W_DD_B), M, D, D, DP}; pg8::StaticOrder S; S.init(M, D, F.G, pg8::opaque_bid());
            pg8::EpiBf16 E{BIG, D}; pg8::gemm_phase<pg8::EpiBf16, pg8::StaticOrder, true, true>(ring, g, S, E); }
        SEAM(pb + 9);
        if (IN(pb + 10)) s5_phase(F, BIG, Hb, (const unsigned*)(F.ws + WS_S5T) + (size_t)pr * NG * S5T_WORDS, argp(args, 16) + (size_t)pr * D);
        SEAM(pb + 10);
        if (IN(pb + 11)) { pg8::Gemm g{Hb, (const bf16*)(F.ws + WS_WSGATE + pr * W_DD_B), M, D, D, DP}; pg8::StaticOrder S; S.init(M, D, F.G, pg8::opaque_bid());
            pg8::EpiSigGate E{Hb, (bf16*)(F.ws + WS_BIG + 128 * MiB)}; pg8::gemm_phase<pg8::EpiSigGate, pg8::StaticOrder, true, true>(ring, g, S, E); }
        SEAM(pb + 11);
        if (IN(pb + 12)) { pg8::Gemm g{(const bf16*)(F.ws + WS_BIG + 128 * MiB), (const bf16*)(F.ws + WS_WSOUT + pr * W_DD_B), M, D, D, DP}; pg8::StaticOrder S; S.init(M, D, F.G, pg8::opaque_bid());
            pg8::EpiGateRes E{xres, xout, mods + 2 * D}; pg8::gemm_phase<pg8::EpiGateRes, pg8::StaticOrder, true, true>(ring, g, S, E); }
        SEAM(pb + 12);
        if (IN(pb + 13)) norm_mod_phase(F, xres, Hb, argp(args, 5) + (size_t)ls * D, mods, 3 * D, 4 * D);
        SEAM(pb + 13);
        if (IN(pb + 14)) { pg8::Gemm g{Hb, (const bf16*)(F.ws + WS_WUP + ls * W_UP_B), M, FF2, D, DP}; pg8::StaticOrder S; S.init(M, FF2, F.G, pg8::opaque_bid());
            pg8::EpiConvGate E{BIG, (float*)(F.ws + WS_RAW), argp(args, 20) + (size_t)ls * 3 * FF2, argp(args, 21) + (size_t)ls * FF2, F.lds + EXCH_OFF};
            pg8::gemm_phase<pg8::EpiConvGate, pg8::StaticOrder, true, true>(ring, g, S, E); }
        SEAM(pb + 14);
        if (IN(pb + 15)) conv_fix_phase(F, (const float*)(F.ws + WS_RAW), BIG, argp(args, 20) + (size_t)ls * 3 * FF2, argp(args, 21) + (size_t)ls * FF2);
        SEAM(pb + 15);
        if (IN(pb + 16)) { pg8::Gemm g{BIG, (const bf16*)(F.ws + WS_WDOWN + ls * W_DN_B), M, D, FF, FFP}; pg8::StaticOrder S; S.init(M, D, F.G, pg8::opaque_bid());
            pg8::EpiGateRes E{xres, xout, mods + 5 * D}; pg8::gemm_phase<pg8::EpiGateRes, pg8::StaticOrder, true, true>(ring, g, S, E); }
        SEAM(pb + 16);
    }
    if (IN(NPHASE - 1)) final_norm_phase(F, xres, xout, argp(args, 23));
#undef IN
#undef xres
#undef xout
#undef Hb
#undef BIG
#undef ring
#undef moda
#undef mods
#undef xa
#undef SEAM
#undef GRID_BAR
}

extern "C" void kernel_launch(void* const* d_in, const int* in_sizes, int n_in, void* d_out, int out_size, void* d_ws, size_t ws_size, hipStream_t stream) {
    static int grid = 0;
    if (grid == 0) {
        if (n_in != 24 || in_sizes[0] != M * D || out_size != M * D || ws_size < WS_END) { fprintf(stderr, "kernel_launch: shape mismatch: n_in %d in0 %d out %d ws %zu (need %zu)\n", n_in, n_in > 0 ? in_sizes[0] : -1, out_size, ws_size, (size_t)WS_END); grid = -1; return; }
        int dev = 0, cus = 0, per_cu = 0;
        if (hipGetDevice(&dev) != hipSuccess || hipDeviceGetAttribute(&cus, hipDeviceAttributeMultiprocessorCount, dev) != hipSuccess) { grid = -1; return; }
        if (hipFuncSetAttribute((const void*)fwd_kernel, hipFuncAttributeMaxDynamicSharedMemorySize, LDS_BYTES) != hipSuccess) { fprintf(stderr, "kernel_launch: hipFuncSetAttribute failed\n"); grid = -1; return; }
        if (hipOccupancyMaxActiveBlocksPerMultiprocessor(&per_cu, (const void*)fwd_kernel, NWAVES * 64, LDS_BYTES) != hipSuccess || per_cu < 1) { fprintf(stderr, "kernel_launch: occupancy query says %d\n", per_cu); }
        (void)hipGetLastError();
        grid = cus;
    }
    if (grid < 0) return;
    if (hipMemsetAsync((char*)d_ws + WS_CTL, 0, CTL_ZERO_BYTES, stream) != hipSuccess) return;
    Args a{};
    for (int i = 0; i < 24; ++i) a.in[i] = (const float*)d_in[i];
    a.out = (float*)d_out; a.ws = (unsigned char*)d_ws;
#if MK_ONE_LAUNCH
    a.ph_lo = 0; a.ph_hi = NPHASE;
    hipLaunchKernelGGL(fwd_kernel, dim3(grid), dim3(NWAVES * 64), LDS_BYTES, stream, a);
#else
    for (int p = 0; p < NPHASE; ++p) { a.ph_lo = p; a.ph_hi = p + 1;
#if MK_DEBUG_CHECKS
        debug_checks(p, true, d_in, (float*)d_out, (unsigned char*)d_ws, stream);
#endif
        { const int kbit = (p == 0) ? 17 : (p == NPHASE - 1 ? 18 : (p - 1) % NPH_PAIR); const int nrep = ((MK_REPEAT_MASK >> kbit) & 1) ? 2 : 1;
          for (int r = 0; r < nrep; ++r) hipLaunchKernelGGL(fwd_kernel, dim3(grid), dim3(NWAVES * 64), LDS_BYTES, stream, a);
          if (((MK_DRY_MASK >> kbit) & 1) && !(kbit == 2 && p > NPH_PAIR)) { a.dry = 1; hipLaunchKernelGGL(fwd_kernel, dim3(grid), dim3(NWAVES * 64), LDS_BYTES, stream, a); a.dry = 0; } }
#if MK_DEBUG_CHECKS
        debug_checks(p, false, d_in, (float*)d_out, (unsigned char*)d_ws, stream);
#endif
    }
#endif
    const hipError_t le = hipPeekAtLastError();
    if (le != hipSuccess) fprintf(stderr, "kernel_launch: launch failed: %s\n", hipGetErrorName(le));
}
```

```cpp
#include <hip/hip_runtime.h>
#include <cstdio>
#include <cstdint>

#ifndef MK_ONE_LAUNCH
#define MK_ONE_LAUNCH 1
#endif
#ifndef MK_DEBUG_CHECKS
#define MK_DEBUG_CHECKS 0
#endif
#ifndef MK_REPEAT_MASK
#define MK_REPEAT_MASK 0
#endif
#ifndef MK_DRY_MASK
#define MK_DRY_MASK 0
#endif
#ifndef MK_ATTN_SAME
#define MK_ATTN_SAME 0
#endif
#ifndef MK_DOUBLE_BAR
#define MK_DOUBLE_BAR 0
#endif
#ifndef MK_DEBUG_NOTAPS
#define MK_DEBUG_NOTAPS 0
#endif

constexpr int BATCH = 16, T = 2048, D = 2048, M = BATCH * T, DEPTH = 4;
constexpr int NH = 16, HD = 128, QK_COLS = 3 * NH * HD, V_COLS = NH * HD, AIN = 2 * QK_COLS + V_COLS;
constexpr int SG = 16, NG = D / SG, SP = 64;
constexpr int FF = 5632, FF2 = 2 * FF;
constexpr int MODW = 6 * D;
constexpr float EPS = 1e-6f;
constexpr int KPAD = 64, DP = D + KPAD, FFP = FF + KPAD;

namespace pg8 {
#define PG8_LAS __attribute__((address_space(3)))
typedef unsigned short bf16_t;
typedef short bf16x8 __attribute__((ext_vector_type(8)));
typedef float f32x4 __attribute__((ext_vector_type(4)));
typedef unsigned u32x4 __attribute__((ext_vector_type(4)));
typedef unsigned u32x2 __attribute__((ext_vector_type(2)));
constexpr int BM = 256, BK = 64, HALF = 128, HTB = HALF * BK * 2  , STAGE_BYTES = 8 * HTB, NXCD = 8, WGM = 4;

__host__ __device__ __forceinline__ int lds_byte(int r, int c) { const int st = (r >> 4) * 2 + (c >> 5), rr = r & 15, cc = c & 31, ob = rr * 64 + cc * 2; return st * 1024 + (ob ^ (((ob >> 9) & 1) << 5)); }
__host__ __device__ __forceinline__ void stage_rc(int b, int& R, int& C) { const int st = b / 1024, sb = b % 1024, swz = sb ^ (((sb >> 9) & 1) << 5); R = (st >> 1) * 16 + swz / 64; C = (st & 1) * 32 + (swz % 64) / 2; }
__host__ __device__ __forceinline__ int perm32(int rho) { const int n = rho >> 4, i = rho & 15; return 8 * (i >> 2) + 4 * n + (i & 3); }

__device__ __forceinline__ int opaque_tid() { int t = (int)threadIdx.x; asm volatile("" : "+v"(t)); return t; }
__device__ __forceinline__ int opaque_bid() { int t = (int)blockIdx.x; asm volatile("" : "+s"(t)); return t; }
struct Unit { int pm, pn; };
struct Gemm { const bf16_t* A; const bf16_t* Bt; int M, N, K, ldk; };

struct StaticOrder {
    int nM, nN, nwg, G, c;
    __host__ __device__ void init(int M_, int N_, int G_, int c_) { nM = M_ / BM; nN = N_ / BM; nwg = nM * nN; G = G_; c = c_; }
    __host__ __device__ bool next(int i, Unit& u) const {
        const long L = (long)i * G + c; if (L >= nwg) return false;
        int wgid = (int)L; { const int q = nwg / NXCD, r = nwg % NXCD, xcd = wgid % NXCD, off = wgid / NXCD; wgid = (xcd < r ? xcd * (q + 1) : r * (q + 1) + (xcd - r) * q) + off; }
        const int nig = WGM * nN, gid = wgid / nig, fm = gid * WGM, gsz = (nM - fm) < WGM ? (nM - fm) : WGM;
        u.pm = fm + ((wgid % nig) % gsz); u.pn = (wgid % nig) / gsz; return true;
    }
    __device__ __forceinline__ void a_ready(const Unit&) const {}
    __device__ __forceinline__ void done(const Unit&) const {}
};
#if MK_DRY_MASK
struct SameTileOrder : StaticOrder {
    __host__ __device__ bool next(int i, Unit& u) const { const bool ok = StaticOrder::next(i, u); u.pm = 0; u.pn = 0; return ok; }
};
#endif

__device__ __forceinline__ unsigned cvt_pk_bf16(float lo, float hi) { unsigned r; asm volatile("v_cvt_pk_bf16_f32 %0, %1, %2" : "=v"(r) : "v"(lo), "v"(hi)); return r; }
__device__ __forceinline__ float bf_lo(unsigned w) { return __uint_as_float(w << 16); }
__device__ __forceinline__ float bf_hi(unsigned w) { return __uint_as_float(w & 0xffff0000u); }
__device__ __forceinline__ float fast_sigmoid(float v) { return __builtin_amdgcn_rcpf(1.0f + __builtin_amdgcn_exp2f(-1.4426950408889634f * v)); }

struct EpiBf16 {
    static constexpr bool PERM = true, AFTER_DRAIN = false;
    bf16_t* O; int ldc;
    __device__ __forceinline__ void operator()(const f32x4 (&acc)[2][2][4][2], const Unit& u, int wr, int wc, int fr, int fq) const {
        const int row0 = u.pm * BM + wr * 64 + fr, col0 = u.pn * BM + wc * 32 + 8 * fq;
#pragma unroll
        for (int ai = 0; ai < 2; ++ai)
#pragma unroll
            for (int m = 0; m < 4; ++m) { bf16_t* rowp = O + (size_t)(row0 + ai * HALF + m * 16) * ldc + col0;
#pragma unroll
                for (int bj = 0; bj < 2; ++bj) { const f32x4 v0 = acc[ai][bj][m][0], v1 = acc[ai][bj][m][1];
                    u32x4 w; w.x = cvt_pk_bf16(v0[0], v0[1]); w.y = cvt_pk_bf16(v0[2], v0[3]); w.z = cvt_pk_bf16(v1[0], v1[1]); w.w = cvt_pk_bf16(v1[2], v1[3]);
                    *(u32x4*)(rowp + bj * HALF) = w; } }
    }
};
#if MK_DRY_MASK
struct EpiNull {
    static constexpr bool PERM = true, AFTER_DRAIN = false;
    __device__ __forceinline__ void operator()(const f32x4 (&acc)[2][2][4][2], const Unit& u, int wr, int wc, int fr, int fq) const {
#pragma unroll
        for (int ai = 0; ai < 2; ++ai)
#pragma unroll
            for (int bj = 0; bj < 2; ++bj)
#pragma unroll
                for (int m = 0; m < 4; ++m)
#pragma unroll
                    for (int n = 0; n < 2; ++n) asm volatile("" :: "v"(acc[ai][bj][m][n]));
    }
};
#endif
constexpr size_t QK_PART = (size_t)BATCH * NH * 3 * T * HD;
struct EpiQKV {
    static constexpr bool PERM = true, AFTER_DRAIN = false;
    bf16_t* O;
    __device__ __forceinline__ void operator()(const f32x4 (&acc)[2][2][4][2], const Unit& u, int wr, int wc, int fr, int fq) const {
        const int part = u.pn >> 3, b = u.pm >> 3, t0 = (u.pm & 7) * BM + wr * 64 + fr, d0 = wc * 32 + 8 * fq;
        const int grp = part < 3 ? part : (part < 6 ? part - 3 : 0), sh = 2 * grp;
#pragma unroll
        for (int bj = 0; bj < 2; ++bj) { const int h = 2 * (u.pn & 7) + bj;
            bf16_t* hb = (part < 6) ? O + (part >= 3 ? QK_PART : 0) + ((size_t)((b * NH + h) * 3 + grp) * T) * HD + d0 : O + 2 * QK_PART + ((size_t)(b * NH + h) * T) * HD + d0;
#pragma unroll
            for (int ai = 0; ai < 2; ++ai)
#pragma unroll
                for (int m = 0; m < 4; ++m) { const int t = t0 + ai * HALF + m * 16;
                    const int pos = (part < 6) ? ((t & ((1 << sh) - 1)) * (T >> sh) + (t >> sh)) : t;
                    const f32x4 v0 = acc[ai][bj][m][0], v1 = acc[ai][bj][m][1];
                    u32x4 w; w.x = cvt_pk_bf16(v0[0], v0[1]); w.y = cvt_pk_bf16(v0[2], v0[3]); w.z = cvt_pk_bf16(v1[0], v1[1]); w.w = cvt_pk_bf16(v1[2], v1[3]);
                    *(u32x4*)(hb + (size_t)pos * HD) = w; } }
    }
};
struct EpiGateRes {
    static constexpr bool PERM = false, AFTER_DRAIN = false;
    const float* base; float* out; const float* gate;
    __device__ __forceinline__ void operator()(const f32x4 (&acc)[2][2][4][2], const Unit& u, int wr, int wc, int fr, int fq) const {
        const int row0 = u.pm * BM + wr * 64 + fr, col0 = u.pn * BM + wc * 32 + 4 * fq;
        const float* gp = gate + (size_t)(u.pm >> 3) * MODW + col0;
        f32x4 gv[2][2];
#pragma unroll
        for (int bj = 0; bj < 2; ++bj)
#pragma unroll
            for (int n = 0; n < 2; ++n) gv[bj][n] = *(const f32x4*)(gp + bj * HALF + n * 16);
        const float* bp = base + (size_t)row0 * D + col0; float* op = out + (size_t)row0 * D + col0;
        f32x4 b0[2][2][2], b1[2][2][2];
#define EGR_LOAD(dst, ai, m0, nm) do { _Pragma("unroll") for (int m = 0; m < (nm); ++m) _Pragma("unroll") for (int bj = 0; bj < 2; ++bj) _Pragma("unroll") for (int n = 0; n < 2; ++n) \
            dst[m][bj][n] = *(const f32x4*)(bp + (size_t)((ai) * HALF + ((m0) + m) * 16) * D + bj * HALF + n * 16); } while (0)
#define EGR_STORE(src, ai, m0, nm) do { _Pragma("unroll") for (int m = 0; m < (nm); ++m) _Pragma("unroll") for (int bj = 0; bj < 2; ++bj) _Pragma("unroll") for (int n = 0; n < 2; ++n) \
            *(f32x4*)(op + (size_t)((ai) * HALF + ((m0) + m) * 16) * D + bj * HALF + n * 16) = src[m][bj][n] + gv[bj][n] * acc[ai][bj][(m0) + m][n]; } while (0)
        EGR_LOAD(b0, 0, 0, 2); asm volatile("" ::: "memory");
        EGR_LOAD(b1, 0, 2, 2); asm volatile("" ::: "memory");
        EGR_STORE(b0, 0, 0, 2); asm volatile("" ::: "memory");
        EGR_LOAD(b0, 1, 0, 2); asm volatile("" ::: "memory");
        EGR_STORE(b1, 0, 2, 2); asm volatile("" ::: "memory");
        EGR_LOAD(b1, 1, 2, 2); asm volatile("" ::: "memory");
        EGR_STORE(b0, 1, 0, 2); asm volatile("" ::: "memory");
        EGR_STORE(b1, 1, 2, 2);
#undef EGR_LOAD
#undef EGR_STORE
    }
};
struct EpiSigGate {
    static constexpr bool PERM = true, AFTER_DRAIN = false;
    const bf16_t* gsrc; bf16_t* O;
    __device__ __forceinline__ void operator()(const f32x4 (&acc)[2][2][4][2], const Unit& u, int wr, int wc, int fr, int fq) const {
        const int row0 = u.pm * BM + wr * 64 + fr, col0 = u.pn * BM + wc * 32 + 8 * fq;
#pragma unroll
        for (int ai = 0; ai < 2; ++ai)
#pragma unroll
            for (int m = 0; m < 4; ++m) { const size_t off = (size_t)(row0 + ai * HALF + m * 16) * DP + col0;
#pragma unroll
                for (int bj = 0; bj < 2; ++bj) { const f32x4 v0 = acc[ai][bj][m][0], v1 = acc[ai][bj][m][1];
                    const u32x4 g = *(const u32x4*)(gsrc + off + bj * HALF);
                    u32x4 w;
                    w.x = cvt_pk_bf16(bf_lo(g.x) * fast_sigmoid(v0[0]), bf_hi(g.x) * fast_sigmoid(v0[1]));
                    w.y = cvt_pk_bf16(bf_lo(g.y) * fast_sigmoid(v0[2]), bf_hi(g.y) * fast_sigmoid(v0[3]));
                    w.z = cvt_pk_bf16(bf_lo(g.z) * fast_sigmoid(v1[0]), bf_hi(g.z) * fast_sigmoid(v1[1]));
                    w.w = cvt_pk_bf16(bf_lo(g.w) * fast_sigmoid(v1[2]), bf_hi(g.w) * fast_sigmoid(v1[3]));
                    *(u32x4*)(O + off + bj * HALF) = w; }
                asm volatile("" ::: "memory"); }
    }
};
template <int CTRL> __device__ __forceinline__ float dpp_ror(float v) { return __int_as_float(__builtin_amdgcn_update_dpp(0, __float_as_int(v), CTRL, 0xf, 0xf, false)); }
struct EpiConvGate {
    static constexpr bool PERM = true, AFTER_DRAIN = false;
    bf16_t* O; float* raw; const float* cw; const float* cb; PG8_LAS unsigned char* xlds;
    __device__ __forceinline__ void operator()(const f32x4 (&acc)[2][2][4][2], const Unit& u, int wr, int wc, int fr, int fq) const {
        const int wid = wr * 4 + wc;
        PG8_LAS f32x4* ex = (PG8_LAS f32x4*)xlds;
        if (fr >= 14) {
#pragma unroll
            for (int ai = 0; ai < 2; ++ai)
#pragma unroll
                for (int bj = 0; bj < 2; ++bj)
#pragma unroll
                    for (int n = 0; n < 2; ++n) ex[((((wid * 2 + ai) * 2 + bj) * 2 + n) * 4 + fq) * 2 + (fr - 14)] = acc[ai][bj][3][n];
        }
        asm volatile("s_waitcnt lgkmcnt(0)" ::: "memory"); __builtin_amdgcn_s_barrier(); asm volatile("" ::: "memory");
        const int gcol0 = u.pn * HALF + wc * 32 + 8 * fq;
        const int row0 = u.pm * BM + wr * 64 + fr;
        if (wr == 0 && fr < 2) {
#pragma unroll
            for (int bj = 0; bj < 2; ++bj)
#pragma unroll
                for (int n = 0; n < 2; ++n) *(f32x4*)(raw + ((size_t)u.pm * 4 + fr) * FF2 + bj * FF + gcol0 + 4 * n) = acc[0][bj][0][n];
        }
        if (wr == 1 && fr >= 14) {
#pragma unroll
            for (int bj = 0; bj < 2; ++bj)
#pragma unroll
                for (int n = 0; n < 2; ++n) *(f32x4*)(raw + ((size_t)u.pm * 4 + 2 + (fr - 14)) * FF2 + bj * FF + gcol0 + 4 * n) = acc[1][bj][3][n];
        }
        unsigned outpk[2][4][2];
#pragma unroll
        for (int n = 0; n < 2; ++n) {
            const int gc = gcol0 + 4 * n;
            const f32x4 wg0 = *(const f32x4*)(cw + gc), wg1 = *(const f32x4*)(cw + FF2 + gc), wg2 = *(const f32x4*)(cw + 2 * FF2 + gc), bg = *(const f32x4*)(cb + gc);
            const f32x4 wu0 = *(const f32x4*)(cw + FF + gc), wu1 = *(const f32x4*)(cw + FF2 + FF + gc), wu2 = *(const f32x4*)(cw + 2 * FF2 + FF + gc), bu = *(const f32x4*)(cb + FF + gc);
#pragma unroll
            for (int ai = 0; ai < 2; ++ai) {
                f32x4 pg = (f32x4){0.f, 0.f, 0.f, 0.f}, pu = (f32x4){0.f, 0.f, 0.f, 0.f};
                if (!(ai == 0 && wr == 0) && fr >= 14) {
                    const int sw = (wr == 1) ? wc : 4 + wc, sai = (wr == 1) ? ai : 0;
                    pg = ex[((((sw * 2 + sai) * 2 + 0) * 2 + n) * 4 + fq) * 2 + (fr - 14)];
                    pu = ex[((((sw * 2 + sai) * 2 + 1) * 2 + n) * 4 + fq) * 2 + (fr - 14)];
                }
                f32x4 pg1, pg2, pu1, pu2;
#pragma unroll
                for (int e = 0; e < 4; ++e) { pg1[e] = dpp_ror<0x121>(pg[e]); pg2[e] = dpp_ror<0x122>(pg[e]); pu1[e] = dpp_ror<0x121>(pu[e]); pu2[e] = dpp_ror<0x122>(pu[e]); }
#pragma unroll
                for (int m = 0; m < 4; ++m) {
                    const f32x4 cg = acc[ai][0][m][n], cu = acc[ai][1][m][n];
                    float o[4];
                    f32x4 cg1, cg2, cu1, cu2;
#pragma unroll
                    for (int e = 0; e < 4; ++e) { cg1[e] = dpp_ror<0x121>(cg[e]); cg2[e] = dpp_ror<0x122>(cg[e]); cu1[e] = dpp_ror<0x121>(cu[e]); cu2[e] = dpp_ror<0x122>(cu[e]); }
#pragma unroll
                    for (int e = 0; e < 4; ++e) {
                        const float g1 = (fr == 0) ? pg1[e] : cg1[e], g2 = (fr < 2) ? pg2[e] : cg2[e], u1 = (fr == 0) ? pu1[e] : cu1[e], u2 = (fr < 2) ? pu2[e] : cu2[e];
#if MK_DEBUG_NOTAPS
                        const float gg = bg[e] + wg2[e] * cg[e] + 0.f * (g1 + g2);
                        const float uu = bu[e] + wu2[e] * cu[e] + 0.f * (u1 + u2);
#else
                        const float gg = bg[e] + wg2[e] * cg[e] + wg1[e] * g1 + wg0[e] * g2;
                        const float uu = bu[e] + wu2[e] * cu[e] + wu1[e] * u1 + wu0[e] * u2;
#endif
                        o[e] = gg * fast_sigmoid(gg) * uu;
                    }
                    pg1 = cg1; pg2 = cg2; pu1 = cu1; pu2 = cu2;
                    const unsigned p0 = cvt_pk_bf16(o[0], o[1]), p1 = cvt_pk_bf16(o[2], o[3]);
                    if (n == 0) { outpk[ai][m][0] = p0; outpk[ai][m][1] = p1; }
                    else { u32x4 w; w.x = outpk[ai][m][0]; w.y = outpk[ai][m][1]; w.z = p0; w.w = p1;
                        *(u32x4*)(O + (size_t)(row0 + ai * HALF + m * 16) * FFP + gcol0) = w; }
                }
            }
        }
    }
};

template <class Epi, class Sched, bool ALIGN_EPI = false, bool SP2 = false>
__device__ __forceinline__ void gemm_phase(PG8_LAS unsigned char* lds, const Gemm g, const Sched& S, const Epi& E) {
    const int tid = opaque_tid(), wid = __builtin_amdgcn_readfirstlane(tid >> 6), lane = tid & 63, wr = wid >> 2, wc = wid & 3, fr = lane & 15, fq = lane >> 4;
    const int K = g.K, nt = K / BK, ldk = g.ldk;
    unsigned voffA[2], voffB[2];
#pragma unroll
    for (int i = 0; i < 2; ++i) { int R, C; stage_rc(tid * 16 + i * 8192, R, C); const int Rb = Epi::PERM ? ((R & ~31) + perm32(R & 31)) : R;
        voffA[i] = (unsigned)(R * ldk + C) * 2u; voffB[i] = (unsigned)(Rb * ldk + C) * 2u; }
    const size_t kstep = (size_t)(BK * 2);
    const size_t hstep = (size_t)HALF * ldk * 2;
    const size_t tstep = 2 * hstep;
    const unsigned ldsw = (unsigned)wid * 1024u;
    const int aoff = lds_byte(wr * 64 + fr, fq * 8), boff = lds_byte(wc * 32 + fr, fq * 8);
#define PG8_SA(b, h) (((b) * 2 + (h)) * HTB)
#define PG8_SB(b, h) ((4 + (b) * 2 + (h)) * HTB)
#define PG8_STAGE(bufoff, gbase, voff) do { _Pragma("unroll") for (int _i = 0; _i < 2; ++_i) \
        __builtin_amdgcn_global_load_lds((const unsigned*)((const char*)(gbase) + (voff)[_i]), (PG8_LAS unsigned*)(lds + (bufoff) + ldsw + _i * 8192), 16, 0, 0); } while (0)
#define PG8_LDA(dst, b, h) do { _Pragma("unroll") for (int m = 0; m < 4; ++m) _Pragma("unroll") for (int k = 0; k < 2; ++k) dst[m][k] = *(const PG8_LAS bf16x8*)(lds + PG8_SA(b, h) + aoff + m * 2048 + k * 1024); } while (0)
#define PG8_LDB(dst, b, h) do { _Pragma("unroll") for (int n = 0; n < 2; ++n) _Pragma("unroll") for (int k = 0; k < 2; ++k) dst[n][k] = *(const PG8_LAS bf16x8*)(lds + PG8_SB(b, h) + boff + n * 2048 + k * 1024); } while (0)
#define PG8_MMA(ai, bj, At, Bt) do { __builtin_amdgcn_s_setprio(1); _Pragma("unroll") for (int m = 0; m < 4; ++m) _Pragma("unroll") for (int n = 0; n < 2; ++n) _Pragma("unroll") for (int k = 0; k < 2; ++k) \
        acc[ai][bj][m][n] = __builtin_amdgcn_mfma_f32_16x16x32_bf16(Bt[n][k], At[m][k], acc[ai][bj][m][n], 0, 0, 0); __builtin_amdgcn_s_setprio(0); } while (0)
#define PG8_WAIT_V(n) asm volatile("s_waitcnt vmcnt(" #n ")" ::: "memory")
#define PG8_WAIT_L(n) asm volatile("s_waitcnt lgkmcnt(" #n ")" ::: "memory")
#define PG8_BAR __builtin_amdgcn_s_barrier()
#define PG8_SCHED __builtin_amdgcn_sched_barrier(0)
    Unit cur, nxt; int ui = 0;
    if (!S.next(0, cur)) return;
    f32x4 acc[2][2][4][2];
#pragma unroll
    for (int a = 0; a < 2; ++a)
#pragma unroll
        for (int b = 0; b < 2; ++b)
#pragma unroll
            for (int m = 0; m < 4; ++m)
#pragma unroll
                for (int n = 0; n < 2; ++n) acc[a][b][m][n] = (f32x4){0.f, 0.f, 0.f, 0.f};
    bf16x8 At[4][2], B0[2][2], B1[2][2];
    const char* cA = (const char*)g.A + (size_t)cur.pm * tstep; const char* cB = (const char*)g.Bt + (size_t)cur.pn * tstep;
    S.a_ready(cur);
    if constexpr (SP2) {
        PG8_STAGE(PG8_SB(0, 0), cB, voffB); PG8_STAGE(PG8_SB(0, 1), cB + hstep, voffB); PG8_STAGE(PG8_SA(0, 0), cA, voffA); PG8_STAGE(PG8_SA(0, 1), cA + hstep, voffA);
        if (wr == 1) PG8_BAR;
        PG8_WAIT_V(2); PG8_BAR;
        PG8_STAGE(PG8_SB(1, 0), cB + kstep, voffB); PG8_STAGE(PG8_SA(1, 0), cA + kstep, voffA); PG8_STAGE(PG8_SB(1, 1), cB + hstep + kstep, voffB);
        PG8_WAIT_V(6); PG8_BAR;
    } else {
        PG8_STAGE(PG8_SB(0, 0), cB, voffB); PG8_STAGE(PG8_SA(0, 0), cA, voffA); PG8_STAGE(PG8_SB(0, 1), cB + hstep, voffB); PG8_STAGE(PG8_SA(0, 1), cA + hstep, voffA);
        if (wr == 1) PG8_BAR;
        PG8_WAIT_V(4); PG8_BAR;
        PG8_STAGE(PG8_SB(1, 0), cB + kstep, voffB); PG8_STAGE(PG8_SA(1, 0), cA + kstep, voffA); PG8_STAGE(PG8_SB(1, 1), cB + hstep + kstep, voffB);
        PG8_WAIT_V(6); PG8_BAR;
    }
    for (;;) {
        const bool has_next = S.next(ui + 1, nxt);
        const char* nA = has_next ? (const char*)g.A + (size_t)nxt.pm * tstep : cA; const char* nB = has_next ? (const char*)g.Bt + (size_t)nxt.pn * tstep : cB;
        for (int t = 0; t < nt; t += 2) {
            const bool last = (t == nt - 2);
            const char* a1 = cA + (size_t)(t + 1) * kstep;
            const char* a2 = last ? nA : cA + (size_t)(t + 2) * kstep; const char* b2 = last ? nB : cB + (size_t)(t + 2) * kstep;
            const char* a3 = a2 + kstep; const char* b3 = b2 + kstep;
            if (last && has_next) S.a_ready(nxt);
            if constexpr (SP2) {
            PG8_LDB(B0, 0, 0); PG8_LDB(B1, 0, 1); PG8_SCHED; PG8_LDA(At, 0, 0); PG8_STAGE(PG8_SA(1, 1), a1 + hstep, voffA);
            PG8_WAIT_V(8); PG8_WAIT_L(0); PG8_BAR; PG8_MMA(0, 0, At, B0); PG8_MMA(0, 1, At, B1); PG8_BAR; PG8_SCHED;
            PG8_LDA(At, 0, 1); PG8_STAGE(PG8_SB(0, 0), b2, voffB); PG8_STAGE(PG8_SB(0, 1), b2 + hstep, voffB); PG8_STAGE(PG8_SA(0, 0), a2, voffA);
            PG8_WAIT_V(8); PG8_WAIT_L(0); PG8_BAR; PG8_MMA(1, 0, At, B0); PG8_MMA(1, 1, At, B1); PG8_BAR; PG8_SCHED;
            PG8_LDB(B0, 1, 0); PG8_LDB(B1, 1, 1); PG8_SCHED; PG8_LDA(At, 1, 0); PG8_STAGE(PG8_SA(0, 1), a2 + hstep, voffA);
            PG8_WAIT_V(8); PG8_WAIT_L(0); PG8_BAR; PG8_MMA(0, 0, At, B0); PG8_MMA(0, 1, At, B1); PG8_BAR; PG8_SCHED;
            PG8_LDA(At, 1, 1); PG8_STAGE(PG8_SB(1, 0), b3, voffB); PG8_STAGE(PG8_SB(1, 1), b3 + hstep, voffB); PG8_STAGE(PG8_SA(1, 0), a3, voffA);
            PG8_WAIT_V(8); PG8_WAIT_L(0); PG8_BAR; PG8_MMA(1, 0, At, B0); PG8_MMA(1, 1, At, B1); PG8_BAR; PG8_SCHED;
            } else {
            PG8_LDB(B0, 0, 0); PG8_SCHED; PG8_LDA(At, 0, 0); PG8_STAGE(PG8_SA(1, 1), a1 + hstep, voffA);
            PG8_WAIT_L(8); PG8_BAR; PG8_WAIT_L(0); PG8_MMA(0, 0, At, B0); PG8_BAR; PG8_SCHED;
            PG8_LDB(B1, 0, 1); PG8_STAGE(PG8_SB(0, 0), b2, voffB);
            PG8_BAR; PG8_WAIT_L(0); PG8_MMA(0, 1, At, B1); PG8_BAR;
            PG8_LDA(At, 0, 1); PG8_STAGE(PG8_SA(0, 0), a2, voffA);
            PG8_BAR; PG8_WAIT_L(0); PG8_MMA(1, 0, At, B0); PG8_BAR; PG8_SCHED;
            PG8_STAGE(PG8_SB(0, 1), b2 + hstep, voffB);
            PG8_WAIT_V(6); PG8_BAR; PG8_MMA(1, 1, At, B1); PG8_BAR;
            PG8_LDB(B0, 1, 0); PG8_SCHED; PG8_LDA(At, 1, 0); PG8_STAGE(PG8_SA(0, 1), a2 + hstep, voffA);
            PG8_WAIT_L(8); PG8_BAR; PG8_WAIT_L(0); PG8_MMA(0, 0, At, B0); PG8_BAR; PG8_SCHED;
            PG8_LDB(B1, 1, 1); PG8_STAGE(PG8_SB(1, 0), b3, voffB);
            PG8_BAR; PG8_WAIT_L(0); PG8_MMA(0, 1, At, B1); PG8_BAR;
            PG8_LDA(At, 1, 1); PG8_STAGE(PG8_SA(1, 0), a3, voffA);
            PG8_BAR; PG8_WAIT_L(0); PG8_MMA(1, 0, At, B0); PG8_BAR; PG8_SCHED;
            PG8_STAGE(PG8_SB(1, 1), b3 + hstep, voffB);
            PG8_WAIT_V(6); PG8_BAR; PG8_MMA(1, 1, At, B1); PG8_BAR;
            }
        }
        if constexpr (ALIGN_EPI) { if (wr == 0) PG8_BAR; }
        if constexpr (!Epi::AFTER_DRAIN) { E(acc, cur, wr, wc, fr, fq); S.done(cur); }
        if (!has_next) break;
#pragma unroll
        for (int a = 0; a < 2; ++a)
#pragma unroll
            for (int b = 0; b < 2; ++b)
#pragma unroll
                for (int m = 0; m < 4; ++m)
#pragma unroll
                    for (int n = 0; n < 2; ++n) acc[a][b][m][n] = (f32x4){0.f, 0.f, 0.f, 0.f};
        cur = nxt; cA = nA; cB = nB; ++ui;
        if constexpr (ALIGN_EPI) { if (wr == 1) PG8_BAR; }
    }
    PG8_WAIT_V(0);
    if constexpr (!ALIGN_EPI) { if (wr == 0) PG8_BAR; }
    PG8_BAR;
    if constexpr (Epi::AFTER_DRAIN) { E.fused(acc, cur, wr, wc, fr, fq, lds, wid, lane); S.done(cur); }
#undef PG8_SA
#undef PG8_SB
#undef PG8_STAGE
#undef PG8_LDA
#undef PG8_LDB
#undef PG8_MMA
#undef PG8_WAIT_V
#undef PG8_WAIT_L
#undef PG8_BAR
#undef PG8_SCHED
}
}

constexpr size_t MiB = 1u << 20;
constexpr size_t WS_CTL = 0, CTL_ZERO_BYTES = 1 * MiB;
constexpr size_t WS_MOD = 1 * MiB;
constexpr size_t WS_S5T = 4 * MiB;
constexpr size_t WS_LSE = 8 * MiB;
constexpr size_t WS_RAW = 12 * MiB;
constexpr size_t W_AIN_B = (size_t)AIN * DP * 2, W_DD_B = (size_t)D * DP * 2, W_UP_B = (size_t)FF2 * DP * 2, W_DN_B = (size_t)D * FFP * 2;
constexpr size_t WS_WAIN = 40 * MiB, WS_WAOUT = WS_WAIN + 2 * W_AIN_B, WS_WSIN = WS_WAOUT + 2 * W_DD_B, WS_WSGATE = WS_WSIN + 2 * W_DD_B, WS_WSOUT = WS_WSGATE + 2 * W_DD_B, WS_WUP = WS_WSOUT + 2 * W_DD_B, WS_WDOWN = WS_WUP + 4 * W_UP_B;
constexpr size_t WS_H = 492 * MiB;
constexpr size_t WS_BIG = 624 * MiB;
constexpr size_t WS_END = 1520 * MiB;
static_assert(WS_WDOWN + 4 * W_DN_B <= WS_H && WS_H + (size_t)M * DP * 2 <= WS_BIG && WS_BIG + (size_t)M * AIN * 2 <= WS_END && (size_t)M * FFP * 2 <= 512 * MiB && WS_RAW + (size_t)(M / 256) * 4 * FF2 * 4 <= WS_WAIN, "d_ws map");
constexpr int S5T_WORDS = 2304;
constexpr int CW_BAR = 4096;
constexpr int RING_OFF = 0, RING_BYTES = 131072;
constexpr int LDSCTL_OFF = RING_BYTES, MISC_OFF = LDSCTL_OFF + 320;
constexpr int EXCH_OFF = RING_BYTES + 1024;
constexpr int LDS_BYTES = 147456;
static_assert(EXCH_OFF + 8192 <= LDS_BYTES && MISC_OFF + 128 <= EXCH_OFF, "LDS map");
constexpr int NWAVES = 8;

#define LAS __attribute__((address_space(3)))
typedef unsigned short bf16;
typedef float f32x4 __attribute__((ext_vector_type(4)));
typedef float f32x2 __attribute__((ext_vector_type(2)));
typedef short bf16x8 __attribute__((ext_vector_type(8)));
typedef short s16x4 __attribute__((ext_vector_type(4)));
typedef unsigned u32x4 __attribute__((ext_vector_type(4)));
typedef unsigned u32x2 __attribute__((ext_vector_type(2)));
#define LDS_WAIT() asm volatile("s_waitcnt lgkmcnt(0)" ::: "memory")
#define VM_WAIT() asm volatile("s_waitcnt vmcnt(0)" ::: "memory")
__device__ __forceinline__ unsigned f2bf(float f) { unsigned u = __builtin_bit_cast(unsigned, f); return (u + 0x7fffu + ((u >> 16) & 1u)) >> 16; }
__device__ __forceinline__ unsigned pk2(float lo, float hi) { return f2bf(lo) | (f2bf(hi) << 16); }
using pg8::cvt_pk_bf16; using pg8::bf_lo; using pg8::bf_hi;

#define XB_TMO      128
#define XB_XCNT(j)  (256  + 64 * (j))
#define XB_XSUB(j)  (1280 + 64 * (j))
#define XB_XGEN(j)  (2304 + 64 * (j))
#define XB_TOP      3328
#define XB_TOPGEN   3392
#define XCD_BAR_WORDS 3456
#define XB_SPIN_CAP (1u << 18)

__device__ __forceinline__ unsigned xb_ld(unsigned* p)              { return __hip_atomic_load(p, __ATOMIC_RELAXED, __HIP_MEMORY_SCOPE_AGENT); }
__device__ __forceinline__ unsigned xb_add(unsigned* p, unsigned v) { return __hip_atomic_fetch_add(p, v, __ATOMIC_RELAXED, __HIP_MEMORY_SCOPE_AGENT); }
__device__ __forceinline__ unsigned xb_xcc_id() { return (unsigned)__builtin_amdgcn_s_getreg((3 << 11) | 20) & 0xFu; }
#define XB_SPIN(cond, bar) do { unsigned _sp = 0; while (cond) { __builtin_amdgcn_s_sleep(1); \
    if ((++_sp & 255u) == 0u) { if (xb_ld(&(bar)[XB_TMO])) break; if (_sp > XB_SPIN_CAP) { atomicAdd(&(bar)[XB_TMO], 1u); break; } } } } while (0)

struct XcdBarrier {
    unsigned* bar; unsigned x;
    volatile LAS unsigned* st;
};

__device__ __forceinline__ XcdBarrier xcd_barrier_post(unsigned* bar, volatile LAS unsigned* st) {
    XcdBarrier b; b.bar = bar; b.x = xb_xcc_id(); b.st = st;
    if (threadIdx.x == 0) (void)xb_add(&bar[XB_XCNT(b.x)], 1u);
    return b;
}
__device__ __forceinline__ void xcd_barrier_complete(unsigned* bar, unsigned x, unsigned& nloc, unsigned& nx) {
    const unsigned G = gridDim.x * gridDim.y * gridDim.z;
    unsigned sum, cnt, mine, sp = 0u;
    for (;;) {
        sum = 0u; cnt = 0u; mine = 0u;
#pragma unroll
        for (unsigned j = 0; j < 16; ++j) { const unsigned c = xb_ld(&bar[XB_XCNT(j)]); sum += c; cnt += (c > 0u) ? 1u : 0u; mine = (j == x) ? c : mine; }
        if (sum == G) break;
        __builtin_amdgcn_s_sleep(1);
        if ((++sp & 255u) == 0u) { if (xb_ld(&bar[XB_TMO])) break; if (sp > XB_SPIN_CAP) { atomicAdd(&bar[XB_TMO], 1u); break; } }
    }
    nloc = mine > 0u ? mine : 1u; nx = cnt > 0u ? cnt : 1u;
}

__device__ __forceinline__ void xcd_barrier(const XcdBarrier& b) {
    asm volatile("s_waitcnt vmcnt(0)" ::: "memory");
    __syncthreads();
    if (threadIdx.x == 0) {
        unsigned* bar = b.bar;
        __builtin_amdgcn_s_waitcnt(0);
        unsigned nloc = b.st[0], nx = b.st[1];
        if (nloc == 0u) { xcd_barrier_complete(bar, b.x, nloc, nx); b.st[0] = nloc; b.st[1] = nx; }
        const unsigned old = xb_add(&bar[XB_XSUB(b.x)], 1u);
        const unsigned gen = old / nloc;
        if (old + 1u == (gen + 1u) * nloc) {
            __builtin_amdgcn_fence(__ATOMIC_RELEASE, "agent");
            asm volatile("s_waitcnt vmcnt(0)" ::: "memory");
            const unsigned og = xb_add(&bar[XB_TOP], 1u);
            const unsigned tg = og / nx;
            if (og + 1u == (tg + 1u) * nx) xb_add(&bar[XB_TOPGEN], 1u);
            else XB_SPIN(xb_ld(&bar[XB_TOPGEN]) == tg, bar);
            __builtin_amdgcn_fence(__ATOMIC_ACQUIRE, "agent");
            xb_add(&bar[XB_XGEN(b.x)], 1u);
            asm volatile("s_waitcnt vmcnt(0)" ::: "memory");
        } else {
            XB_SPIN(xb_ld(&bar[XB_XGEN(b.x)]) == gen, bar);
            __builtin_amdgcn_fence(__ATOMIC_ACQUIRE, "agent");
            asm volatile("s_waitcnt vmcnt(0)" ::: "memory");
        }
    }
    __syncthreads();
}

struct Frame {
    LAS unsigned char* lds;
    volatile LAS unsigned* MISC;
    unsigned* ctl;
    int tid, lane, wave;
    int vcu, G;
    unsigned char* ws; float* out;
};
__device__ __forceinline__ void frame_refresh(Frame& F, unsigned char* ws, float* out) {
    asm volatile("" : "+s"(ws)); asm volatile("" : "+s"(out)); F.ws = ws; F.out = out; F.ctl = (unsigned*)(ws + WS_CTL);
    F.tid = pg8::opaque_tid(); F.lane = F.tid & 63; F.wave = __builtin_amdgcn_readfirstlane(F.tid >> 6);
    const int bx = pg8::opaque_bid(); F.vcu = (F.G % 8 == 0) ? (bx % 8) * (F.G / 8) + bx / 8 : bx;
}
template <int CTRL> __device__ __forceinline__ float dpp_mov(float v) { return __int_as_float(__builtin_amdgcn_update_dpp(0, __float_as_int(v), CTRL, 0xf, 0xf, false)); }
__device__ __forceinline__ float wave_sum(float v) {
    v += dpp_mov<0xB1>(v);
    v += dpp_mov<0x4E>(v);
    v += dpp_mov<0x141>(v);
    v += dpp_mov<0x140>(v);
    const float s0 = __int_as_float(__builtin_amdgcn_readlane(__float_as_int(v), 0)), s1 = __int_as_float(__builtin_amdgcn_readlane(__float_as_int(v), 16));
    const float s2 = __int_as_float(__builtin_amdgcn_readlane(__float_as_int(v), 32)), s3 = __int_as_float(__builtin_amdgcn_readlane(__float_as_int(v), 48));
    return (s0 + s1) + (s2 + s3);
}
__device__ __forceinline__ float xrow_max(float v) {
    { const auto r = __builtin_amdgcn_permlane16_swap(__float_as_uint(v), __float_as_uint(v), false, false); v = fmaxf(__uint_as_float(r[0]), __uint_as_float(r[1])); }
    { const auto r = __builtin_amdgcn_permlane32_swap(__float_as_uint(v), __float_as_uint(v), false, false); v = fmaxf(__uint_as_float(r[0]), __uint_as_float(r[1])); }
    return v;
}
__device__ __forceinline__ float xrow_sum(float v) {
    { const auto r = __builtin_amdgcn_permlane16_swap(__float_as_uint(v), __float_as_uint(v), false, false); v = __uint_as_float(r[0]) + __uint_as_float(r[1]); }
    { const auto r = __builtin_amdgcn_permlane32_swap(__float_as_uint(v), __float_as_uint(v), false, false); v = __uint_as_float(r[0]) + __uint_as_float(r[1]); }
    return v;
}

__device__ __forceinline__ void p0_transpose_item(const float* W, int K, int N, bf16* WT, int k0, int n0, int dst_row0, LAS float* scr, int lane) {
#pragma unroll 8
    for (int i = 0; i < 32; ++i) { const int kk = 2 * i + (lane >> 5); scr[kk * 33 + (lane & 31)] = W[(size_t)(k0 + kk) * N + n0 + (lane & 31)]; }
    LDS_WAIT(); asm volatile("" ::: "memory");
    const int c = lane & 7;
#pragma unroll
    for (int j = 0; j < 4; ++j) { const int n = (lane >> 3) + 8 * j; const LAS float* s = scr + (8 * c) * 33 + n;
        u32x4 o; o.x = pk2(s[0 * 33], s[1 * 33]); o.y = pk2(s[2 * 33], s[3 * 33]); o.z = pk2(s[4 * 33], s[5 * 33]); o.w = pk2(s[6 * 33], s[7 * 33]);
        *(u32x4*)(WT + (size_t)(dst_row0 + n) * (K + KPAD) + k0 + 8 * c) = o; }
    LDS_WAIT(); asm volatile("" ::: "memory");
}
struct P0In { const float *c, *ada_w, *ada_b, *attn_w_in, *attn_w_out, *ssm_w_in, *log_step, *a_re, *a_im, *b_re, *b_im, *c_re, *c_im, *ssm_w_gate, *ssm_w_out, *ffn_w_up, *ffn_w_down; };

__device__ __forceinline__ void p0_ada_unit(Frame& F, const P0In& in, int unit) {
    LAS float* csl = (LAS float*)(F.lds + RING_OFF);
    for (int idx = F.tid; idx < BATCH * D; idx += NWAVES * 64) { const int b = idx / D, k = idx % D; const float v = in.c[idx]; csl[k * 16 + b] = v / (1.0f + __expf(-v)); }
    __syncthreads();
    const int li = unit >> 6, c0 = (unit & 63) * 192 + F.lane;
    const float* W = in.ada_w + (size_t)li * D * MODW + c0;
    float acc[3][16];
#pragma unroll
    for (int c = 0; c < 3; ++c)
#pragma unroll
        for (int b = 0; b < 16; ++b) acc[c][b] = 0.f;
    const int kbeg = F.wave * 256;
#pragma unroll 4
    for (int k = kbeg; k < kbeg + 256; ++k) {
        const float w0 = W[(size_t)k * MODW], w1 = W[(size_t)k * MODW + 64], w2 = W[(size_t)k * MODW + 128];
        const LAS f32x4* cp = (const LAS f32x4*)(csl + k * 16);
        const f32x4 s0 = cp[0], s1 = cp[1], s2 = cp[2], s3 = cp[3];
        const float cs[16] = {s0[0], s0[1], s0[2], s0[3], s1[0], s1[1], s1[2], s1[3], s2[0], s2[1], s2[2], s2[3], s3[0], s3[1], s3[2], s3[3]};
#pragma unroll
        for (int b = 0; b < 16; ++b) { acc[0][b] += w0 * cs[b]; acc[1][b] += w1 * cs[b]; acc[2][b] += w2 * cs[b]; }
    }
    __syncthreads();
    LAS float* part = (LAS float*)(F.lds + RING_OFF);
#pragma unroll
    for (int c = 0; c < 3; ++c)
#pragma unroll
        for (int b = 0; b < 16; ++b) part[(F.wave * 16 + b) * 192 + c * 64 + F.lane] = acc[c][b];
    __syncthreads();
    float* mod = (float*)(F.ws + WS_MOD);
    for (int o = F.tid; o < 16 * 192; o += NWAVES * 64) { const int b = o / 192, cc = o % 192; float s = 0.f;
#pragma unroll
        for (int w = 0; w < 8; ++w) s += part[(w * 16 + b) * 192 + cc];
        const int n = (unit & 63) * 192 + cc; mod[((size_t)li * BATCH + b) * MODW + n] = s + in.ada_b[(size_t)li * MODW + n]; }
    __syncthreads();
}
__device__ __forceinline__ void s5_coef(const P0In& in, int jg, int p, float& lbr, float& lbi, float& cfr, float& cfi) {
    const float step = __expf(in.log_step[jg]);
    const float lr = in.a_re[(size_t)jg * SP + p], li = in.a_im[(size_t)jg * SP + p];
    const float mag = expf(lr * step), ang = li * step;
    lbr = mag * cosf(ang); lbi = mag * sinf(ang);
    const float nr = lbr - 1.0f, ni = lbi, den = lr * lr + li * li;
    cfr = (nr * lr + ni * li) / den; cfi = (ni * lr - nr * li) / den;
}
__device__ __forceinline__ void p0_s5_tables(Frame& F, const P0In& in, int jg) {
    unsigned* tab = (unsigned*)(F.ws + WS_S5T) + (size_t)jg * S5T_WORDS;
    const int t = F.tid;
    if (t < 64) {
        float lbr, lbi, cfr, cfi; s5_coef(in, jg, t, lbr, lbi, cfr, cfi);
        float ar = lbr, ai = lbi;
#pragma unroll
        for (int s = 0; s < 7; ++s) { const float nr = ar * ar - ai * ai, ni = 2.0f * ar * ai; ar = nr; ai = ni; }
        tab[t] = __float_as_uint(lbr); tab[64 + t] = __float_as_uint(lbi); tab[128 + t] = __float_as_uint(ar); tab[192 + t] = __float_as_uint(ai);
    }
    {
        const int tau = t >> 6, lane = t & 63, q = tau >> 1, part = tau & 1, p = 16 * q + (lane & 15), c0 = 4 * (lane >> 4);
        float lbr, lbi, cfr, cfi; s5_coef(in, jg, p, lbr, lbi, cfr, cfi);
        const float* br = in.b_re + ((size_t)jg * SP + p) * SG + c0; const float* bi = in.b_im + ((size_t)jg * SP + p) * SG + c0;
        float v[4];
#pragma unroll
        for (int j = 0; j < 4; ++j) v[j] = part ? (cfr * bi[j] + cfi * br[j]) : (cfr * br[j] - cfi * bi[j]);
        tab[256 + (tau * 64 + lane) * 2 + 0] = pk2(v[0], v[1]); tab[256 + (tau * 64 + lane) * 2 + 1] = pk2(v[2], v[3]);
    }
    if (t < 256) {
        const int q = t >> 6, lane = t & 63, c = lane & 15, g4 = lane >> 4;
        const float* cr = in.c_re + ((size_t)jg * SG + c) * SP + 16 * q + 4 * g4; const float* ci = in.c_im + ((size_t)jg * SG + c) * SP + 16 * q + 4 * g4;
        unsigned* o = tab + 1280 + (q * 64 + lane) * 4;
        o[0] = pk2(cr[0], cr[1]); o[1] = pk2(cr[2], cr[3]); o[2] = pk2(-ci[0], -ci[1]); o[3] = pk2(-ci[2], -ci[3]);
    }
}
__device__ __forceinline__ void p0_prologue(Frame& F, const P0In& in) {
    for (int u = F.vcu; u < 256; u += F.G) p0_ada_unit(F, in, u);
    for (int u = F.vcu; u < 2 * NG; u += F.G) p0_s5_tables(F, in, u);
    LAS float* scr = (LAS float*)(F.lds + RING_OFF + F.wave * 16384);
    const int gw = F.vcu * NWAVES + F.wave, NGW = F.G * NWAVES;
    constexpr int I_AIN = (D / 64) * (AIN / 32), I_DD = (D / 64) * (D / 32), I_UP = (D / 64) * (FF2 / 32), I_DN = (FF / 64) * (D / 32);
    constexpr int C0 = 2 * I_AIN, C1 = C0 + 2 * I_DD, C2 = C1 + 2 * I_DD, C3 = C2 + 2 * I_DD, C4 = C3 + 2 * I_DD, C5 = C4 + 4 * I_UP, C6 = C5 + 4 * I_DN;
    for (int it = gw; it < C6; it += NGW) {
        const float* W; bf16* WT; int K, N, r; bool up = false;
        if (it < C0)      { r = it;      const int j = r / I_AIN; r -= j * I_AIN; K = D; N = AIN; W = in.attn_w_in + (size_t)j * D * AIN;  WT = (bf16*)(F.ws + WS_WAIN + j * W_AIN_B); }
        else if (it < C1) { r = it - C0; const int j = r / I_DD;  r -= j * I_DD;  K = D; N = D;   W = in.attn_w_out + (size_t)j * D * D;   WT = (bf16*)(F.ws + WS_WAOUT + j * W_DD_B); }
        else if (it < C2) { r = it - C1; const int j = r / I_DD;  r -= j * I_DD;  K = D; N = D;   W = in.ssm_w_in + (size_t)j * D * D;     WT = (bf16*)(F.ws + WS_WSIN + j * W_DD_B); }
        else if (it < C3) { r = it - C2; const int j = r / I_DD;  r -= j * I_DD;  K = D; N = D;   W = in.ssm_w_gate + (size_t)j * D * D;   WT = (bf16*)(F.ws + WS_WSGATE + j * W_DD_B); }
        else if (it < C4) { r = it - C3; const int j = r / I_DD;  r -= j * I_DD;  K = D; N = D;   W = in.ssm_w_out + (size_t)j * D * D;    WT = (bf16*)(F.ws + WS_WSOUT + j * W_DD_B); }
        else if (it < C5) { r = it - C4; const int j = r / I_UP;  r -= j * I_UP;  K = D; N = FF2; W = in.ffn_w_up + (size_t)j * D * FF2;   WT = (bf16*)(F.ws + WS_WUP + j * W_UP_B); up = true; }
        else              { r = it - C5; const int j = r / I_DN;  r -= j * I_DN;  K = FF; N = D;  W = in.ffn_w_down + (size_t)j * FF * D;  WT = (bf16*)(F.ws + WS_WDOWN + j * W_DN_B); }
        const int nblk = N / 32, kb = r / nblk, nb = r % nblk, n0 = 32 * nb;
        int drow = n0;
        if (up) { const int half = n0 >= FF ? 1 : 0, nn = n0 - half * FF; drow = 256 * (nn >> 7) + 128 * half + (nn & 127); }
        p0_transpose_item(W, K, N, WT, 64 * kb, n0, drow, scr, F.lane);
    }
}

__device__ __forceinline__ void norm_mod_phase(Frame& F, const float* xin, bf16* hout, const float* gain, const float* modl, int sh_off, int sc_off) {
    const int gw = F.vcu * NWAVES + F.wave, NGW = F.G * NWAVES;
    for (int blk = gw; blk < M / 16; blk += NGW) {
        const int row0 = blk * 16, b = row0 / T;
        f32x4 A[8], Bv[8];
#pragma unroll
        for (int j = 0; j < 8; ++j) { const int col = 4 * F.lane + 256 * j;
            const f32x4 g = *(const f32x4*)(gain + col), sc = *(const f32x4*)(modl + (size_t)b * MODW + sc_off + col);
            A[j] = g * (sc + 1.0f); Bv[j] = *(const f32x4*)(modl + (size_t)b * MODW + sh_off + col); }
        f32x4 cur[8], nxt[8];
#pragma unroll
        for (int j = 0; j < 8; ++j) cur[j] = *(const f32x4*)(xin + (size_t)row0 * D + 4 * F.lane + 256 * j);
        for (int r = 0; r < 16; ++r) {
            const int rn = (r + 1 < 16) ? r + 1 : r;
#pragma unroll
            for (int j = 0; j < 8; ++j) nxt[j] = *(const f32x4*)(xin + (size_t)(row0 + rn) * D + 4 * F.lane + 256 * j);
            float ss = 0.f;
#pragma unroll
            for (int j = 0; j < 8; ++j) ss += (cur[j][0] * cur[j][0] + cur[j][1] * cur[j][1]) + (cur[j][2] * cur[j][2] + cur[j][3] * cur[j][3]);
            const float rstd = __builtin_amdgcn_rsqf(wave_sum(ss) * (1.0f / D) + EPS);
            unsigned long long* o8 = (unsigned long long*)(hout + (size_t)(row0 + r) * DP) + F.lane;
#pragma unroll
            for (int j = 0; j < 8; ++j) { const f32x4 v = cur[j] * rstd * A[j] + Bv[j];
                o8[64 * j] = (unsigned long long)cvt_pk_bf16(v[0], v[1]) | ((unsigned long long)cvt_pk_bf16(v[2], v[3]) << 32); }
#pragma unroll
            for (int j = 0; j < 8; ++j) cur[j] = nxt[j];
        }
    }
}
__device__ __forceinline__ void final_norm_phase(Frame& F, const float* xin, float* out, const float* gain) {
    const int gw = F.vcu * NWAVES + F.wave, NGW = F.G * NWAVES;
    f32x4 A[8];
#pragma unroll
    for (int j = 0; j < 8; ++j) A[j] = *(const f32x4*)(gain + 4 * F.lane + 256 * j);
    for (int blk = gw; blk < M / 16; blk += NGW) {
        const int row0 = blk * 16;
        for (int r = 0; r < 16; ++r) {
            f32x4 cur[8];
#pragma unroll
            for (int j = 0; j < 8; ++j) cur[j] = *(const f32x4*)(xin + (size_t)(row0 + r) * D + 4 * F.lane + 256 * j);
            float ss = 0.f;
#pragma unroll
            for (int j = 0; j < 8; ++j) ss += (cur[j][0] * cur[j][0] + cur[j][1] * cur[j][1]) + (cur[j][2] * cur[j][2] + cur[j][3] * cur[j][3]);
            const float rstd = __builtin_amdgcn_rsqf(wave_sum(ss) * (1.0f / D) + EPS);
#pragma unroll
            for (int j = 0; j < 8; ++j) *(f32x4*)(out + (size_t)(row0 + r) * D + 4 * F.lane + 256 * j) = cur[j] * rstd * A[j];
        }
    }
}

__device__ __forceinline__ void conv_fix_phase(Frame& F, const float* raw, bf16* aout, const float* cw, const float* cb) {
    const int gt = (F.vcu * NWAVES + F.wave) * 64 + F.lane, NT = F.G * NWAVES * 64;
    constexpr int C4 = FF / 4, NITEM = 112 * 2 * C4;
    for (int it = gt; it < NITEM; it += NT) {
        const int c4 = it % C4, rr = (it / C4) & 1, bi = it / (2 * C4), pm = (bi / 7) * 8 + 1 + (bi % 7), gc = 4 * c4;
        const float* r_m2 = raw + ((size_t)(pm - 1) * 4 + 2) * FF2; const float* r_m1 = raw + ((size_t)(pm - 1) * 4 + 3) * FF2;
        const float* r_0 = raw + ((size_t)pm * 4 + 0) * FF2;       const float* r_1 = raw + ((size_t)pm * 4 + 1) * FF2;
        const float* pc = rr ? r_1 : r_0; const float* p1 = rr ? r_0 : r_m1; const float* p2 = rr ? r_m1 : r_m2;
        float o[4];
        const f32x4 cg = *(const f32x4*)(pc + gc), g1 = *(const f32x4*)(p1 + gc), g2 = *(const f32x4*)(p2 + gc);
        const f32x4 cu = *(const f32x4*)(pc + FF + gc), u1 = *(const f32x4*)(p1 + FF + gc), u2 = *(const f32x4*)(p2 + FF + gc);
        const f32x4 wg0 = *(const f32x4*)(cw + gc), wg1 = *(const f32x4*)(cw + FF2 + gc), wg2 = *(const f32x4*)(cw + 2 * FF2 + gc), bg = *(const f32x4*)(cb + gc);
        const f32x4 wu0 = *(const f32x4*)(cw + FF + gc), wu1 = *(const f32x4*)(cw + FF2 + FF + gc), wu2 = *(const f32x4*)(cw + 2 * FF2 + FF + gc), bu = *(const f32x4*)(cb + FF + gc);
#pragma unroll
        for (int e = 0; e < 4; ++e) { const float gg = bg[e] + wg2[e] * cg[e] + wg1[e] * g1[e] + wg0[e] * g2[e], uu = bu[e] + wu2[e] * cu[e] + wu1[e] * u1[e] + wu0[e] * u2[e];
            o[e] = gg * pg8::fast_sigmoid(gg) * uu; }
        u32x2 w; w.x = cvt_pk_bf16(o[0], o[1]); w.y = cvt_pk_bf16(o[2], o[3]);
        *(u32x2*)(aout + (size_t)(pm * 256 + rr) * FFP + gc) = w;
    }
}

namespace att {
constexpr int SLOT = 32768, K_OFF = 0, V_OFF = 65536;
__device__ __forceinline__ int kswz(int row, int colB) { return row * 256 + (colB ^ ((row & 15) << 4)); }
__device__ __forceinline__ int vperm(int k) { return (k & ~0xC) | ((k & 4) << 1) | ((k & 8) >> 1); }
__device__ __forceinline__ int voff(int row, int ch) { return 256 * row + 16 * (ch ^ (((row & 3) << 2) | ((row >> 2) & 3))); }
__device__ __forceinline__ s16x4 tr_read(int addr) { s16x4 r; asm volatile("ds_read_b64_tr_b16 %0, %1" : "=&v"(r) : "v"(addr) : "memory"); return r; }
struct Stg { u32x4 k[4], v[4]; };
}
template <bool SAME>
__device__ __forceinline__ void attn_phase(Frame& F, bf16* proj, bf16* obuf, float* lse) {
    using namespace att;
    const int w = F.wave;
    for (int unit = F.vcu; unit < BATCH * NH; unit += F.G) {
        const int b = SAME ? 0 : unit >> 4, h = SAME ? 0 : unit & 15;
        bf16* qbase = proj + (size_t)(SAME ? 0 : unit) * 3 * T * HD; const bf16* kbase = proj + pg8::QK_PART + (size_t)(SAME ? 0 : unit) * 3 * T * HD; const bf16* vbase = proj + 2 * pg8::QK_PART + (size_t)(SAME ? 0 : unit) * T * HD;
        const float c1 = 0.08838834764831845f * 1.4426950408889634f;
        const float slope2 = exp2f(-0.5f * (float)(h + 1)) * 1.4426950408889634f;
        Stg st;
        bf16x8 qn[4];
        int tid = F.tid;
#define ATT_LANE() asm volatile("" : "+v"(tid)); const int lane = tid & 63, q16 = lane & 15, g4 = lane >> 4, skey = tid >> 4, sch = tid & 15
#define ATT_DECODE(bu_, grp, dil, cls, n) const int bux_ = SAME ? 33 : (bu_); const int grp = 2 - ((bux_) >> 4), dil = 1 << (2 * grp), nbk = 16 >> (2 * grp), cls = ((bux_) & 15) / nbk, n = ((bux_) & 15) % nbk
#define ATT_LOAD(bu) do { ATT_DECODE(bu, grp_, dil_, cls_, n_); const bf16* kb_ = kbase + (size_t)grp_ * T * HD + (size_t)(cls_ * (T >> (2 * grp_)) + 128 * n_) * HD + sch * 8; \
            _Pragma("unroll") for (int i = 0; i < 4; ++i) { const int key_ = skey + 32 * i; \
            st.k[i] = *(const u32x4*)(kb_ + (size_t)key_ * HD); st.v[i] = *(const u32x4*)(vbase + (size_t)((128 * n_ + key_) * dil_ + cls_) * HD + sch * 8); } } while (0)
#define ATT_QLOAD(bu) do { ATT_DECODE(bu, grp_, dil_, cls_, n_); (void)dil_; const bf16* qq_ = qbase + ((size_t)grp_ * T + cls_ * (T >> (2 * grp_)) + 128 * n_ + 16 * w + q16) * HD + 8 * g4; \
            _Pragma("unroll") for (int ks = 0; ks < 4; ++ks) qn[ks] = *(const bf16x8*)(qq_ + 32 * ks); } while (0)
#define ATT_WRITE(slot) do { _Pragma("unroll") for (int i = 0; i < 4; ++i) { const int key_ = skey + 32 * i; \
            *(LAS u32x4*)(F.lds + K_OFF + (slot) * SLOT + kswz(key_, sch * 16)) = st.k[i]; *(LAS u32x4*)(F.lds + V_OFF + (slot) * SLOT + voff(vperm(key_), sch)) = st.v[i]; } } while (0)
        { ATT_LANE(); (void)q16; (void)g4; (void)lane;
        ATT_LOAD(0); ATT_QLOAD(0);
        { unsigned z0 = 0u; asm volatile("" : "+v"(z0));
          for (int i = tid; i < SLOT / 16; i += NWAVES * 64) *(LAS u32x4*)(F.lds + V_OFF + SLOT + i * 16) = (u32x4){z0, z0, z0, z0}; }
        ATT_WRITE(0); }
        __syncthreads();
        for (int bu = 0; bu < 48; ++bu) {
            ATT_LANE();
            ATT_DECODE(bu, grp, dil, cls, n);
            const int cur = bu & 1, prev = cur ^ 1;
            const int cpq = 128 * n + 16 * w + q16;
            const size_t rowq = (size_t)b * T + (size_t)cpq * dil + cls;
            bf16* qp = qbase + ((size_t)grp * T + cls * (T >> (2 * grp)) + cpq) * HD;
            bf16x8 qf[4];
#pragma unroll
            for (int ks = 0; ks < 4; ++ks) qf[ks] = qn[ks];
            if (bu + 1 < 48) { ATT_LOAD(bu + 1); ATT_QLOAD(bu + 1); }
            u32x2 a1[8], a2[8]; float l1 = 0.f, l2 = 0.f;
            if (grp == 0) {
                const int tq = cpq;
                const bf16* o1p = qbase + ((size_t)1 * T + (tq & 3) * (T >> 2) + (tq >> 2)) * HD + 4 * g4; const bf16* o2p = qbase + ((size_t)2 * T + (tq & 15) * (T >> 4) + (tq >> 4)) * HD + 4 * g4;
#pragma unroll
                for (int dt = 0; dt < 8; ++dt) { a1[dt] = *(const u32x2*)(o1p + 16 * dt); a2[dt] = *(const u32x2*)(o2p + 16 * dt); }
                l1 = lse[((size_t)0 * M + rowq) * NH + h]; l2 = lse[((size_t)1 * M + rowq) * NH + h];
            }
            f32x4 s[9];
            int kx[4];
#pragma unroll
            for (int ks = 0; ks < 4; ++ks) kx[ks] = q16 * 256 + ((64 * ks + 16 * g4) ^ (q16 << 4));
            const int ring0 = prev * SLOT;
#pragma unroll
            for (int t = 0; t < 9; ++t) { const int base = K_OFF + (((w + t) * 4096 + ring0) & 0xFFFF);
                s[t] = (f32x4){0.f, 0.f, 0.f, 0.f};
#pragma unroll
                for (int ks = 0; ks < 4; ++ks) { const bf16x8 kf = *(const LAS bf16x8*)(F.lds + base + kx[ks]); s[t] = __builtin_amdgcn_mfma_f32_16x16x32_bf16(kf, qf[ks], s[t], 0, 0, 0); }
                if (t & 1) __builtin_amdgcn_sched_barrier(0); }
            const float c2 = slope2 * (float)dil;
            float mx = -__builtin_inff();
#pragma unroll
            for (int t = 0; t < 9; ++t) { const bool tv = (n > 0) || (t >= 8 - w);
#pragma unroll
                for (int i = 0; i < 4; ++i) { const int kk = 4 * g4 + i; const float dist = (float)(128 - 16 * t + q16 - kk);
                    bool valid = tv; if (t == 0) valid = valid && (kk >= q16); if (t == 8) valid = valid && (kk <= q16);
                    const float z = valid ? (s[t][i] * c1 - c2 * dist) : -__builtin_inff(); s[t][i] = z; mx = fmaxf(mx, z); } }
            mx = xrow_max(mx);
            float l = 0.f;
            u32x2 pp[10];
#pragma unroll
            for (int t = 0; t < 9; ++t) { float p[4];
#pragma unroll
                for (int i = 0; i < 4; ++i) { p[i] = __builtin_amdgcn_exp2f(s[t][i] - mx); l += p[i]; }
                pp[t].x = cvt_pk_bf16(p[0], p[1]); pp[t].y = cvt_pk_bf16(p[2], p[3]); }
            pp[9].x = 0u; pp[9].y = 0u;
            l = xrow_sum(l);
            f32x4 o[8];
#pragma unroll
            for (int dt = 0; dt < 8; ++dt) o[dt] = (f32x4){0.f, 0.f, 0.f, 0.f};
            const int lq = (lane >> 2) & 3, lp = lane & 3;
            const int vmask = (lq << 2) | (2 * (g4 & 1) + (g4 >> 1));
            const int vlane = 256 * (8 * (g4 & 1) + 4 * (g4 >> 1) + lq) + 8 * (lp & 1), vpart = ((lp >> 1) ^ vmask) << 4;
            struct VB { s16x4 va[4], vb[4]; } vb0, vb1;
#define PV_READ(B, g) do { const int pr_ = (g) >> 1, dh_ = (g) & 1, ta_ = 2 * pr_, tb_ = (pr_ < 4) ? 2 * pr_ + 1 : 2 * pr_; \
                const int ba_ = V_OFF + (((w + ta_) * 4096 + ring0) & 0xFFFF) + vlane, bb_ = V_OFF + (((w + tb_) * 4096 + ring0) & 0xFFFF) + vlane; \
                _Pragma("unroll") for (int d = 0; d < 4; ++d) { const int dt_ = 4 * dh_ + d; B.va[d] = tr_read(ba_ + (vpart ^ (dt_ << 5))); B.vb[d] = tr_read(bb_ + (vpart ^ (dt_ << 5))); } } while (0)
#define PV_MMA(B, g) do { const int pr_ = (g) >> 1, dh_ = (g) & 1; u32x4 pw_; pw_.x = pp[2 * pr_].x; pw_.y = pp[2 * pr_].y; pw_.z = pp[2 * pr_ + 1].x; pw_.w = pp[2 * pr_ + 1].y; \
                const bf16x8 pa_ = __builtin_bit_cast(bf16x8, pw_); \
                _Pragma("unroll") for (int d = 0; d < 4; ++d) { const int dt_ = 4 * dh_ + d; const bf16x8 vf_ = (bf16x8){B.va[d][0], B.va[d][1], B.va[d][2], B.va[d][3], B.vb[d][0], B.vb[d][1], B.vb[d][2], B.vb[d][3]}; \
                    o[dt_] = __builtin_amdgcn_mfma_f32_16x16x32_bf16(vf_, pa_, o[dt_], 0, 0, 0); } } while (0)
#define PV_STEP(BC, BN, g) do { PV_READ(BN, (g) + 1); asm volatile("s_waitcnt lgkmcnt(8)" ::: "memory"); __builtin_amdgcn_sched_barrier(0); PV_MMA(BC, g); __builtin_amdgcn_sched_barrier(0); } while (0)
            asm volatile("s_waitcnt lgkmcnt(0)" ::: "memory"); __builtin_amdgcn_sched_barrier(0);
            PV_READ(vb0, 0);
            PV_STEP(vb0, vb1, 0); PV_STEP(vb1, vb0, 1); PV_STEP(vb0, vb1, 2); PV_STEP(vb1, vb0, 3); PV_STEP(vb0, vb1, 4); PV_STEP(vb1, vb0, 5); PV_STEP(vb0, vb1, 6); PV_STEP(vb1, vb0, 7); PV_STEP(vb0, vb1, 8);
            asm volatile("s_waitcnt lgkmcnt(0)" ::: "memory"); __builtin_amdgcn_sched_barrier(0); PV_MMA(vb1, 9); __builtin_amdgcn_sched_barrier(0);
#undef PV_READ
#undef PV_MMA
#undef PV_STEP
            const float inv = 1.0f / l, lse2 = mx + __builtin_amdgcn_logf(l);
            if (grp > 0) {
#pragma unroll
                for (int dt = 0; dt < 8; ++dt) { u32x2 wv; wv.x = cvt_pk_bf16(o[dt][0] * inv, o[dt][1] * inv); wv.y = cvt_pk_bf16(o[dt][2] * inv, o[dt][3] * inv);
                    *(u32x2*)(qp + 16 * dt + 4 * g4) = wv; }
                if (g4 == 0) lse[((size_t)(grp - 1) * M + rowq) * NH + h] = lse2;
            } else {
                const float mm = fmaxf(lse2, fmaxf(l1, l2));
                float w0 = __builtin_amdgcn_exp2f(lse2 - mm), w1 = __builtin_amdgcn_exp2f(l1 - mm), w2 = __builtin_amdgcn_exp2f(l2 - mm);
                const float wi = 1.0f / (w0 + w1 + w2); w0 *= wi * inv; w1 *= wi; w2 *= wi;
                bf16* op = obuf + rowq * DP + h * HD;
#pragma unroll
                for (int dt = 0; dt < 8; ++dt) {
                    const float r0 = w0 * o[dt][0] + w1 * bf_lo(a1[dt].x) + w2 * bf_lo(a2[dt].x), r1 = w0 * o[dt][1] + w1 * bf_hi(a1[dt].x) + w2 * bf_hi(a2[dt].x);
                    const float r2 = w0 * o[dt][2] + w1 * bf_lo(a1[dt].y) + w2 * bf_lo(a2[dt].y), r3 = w0 * o[dt][3] + w1 * bf_hi(a1[dt].y) + w2 * bf_hi(a2[dt].y);
                    u32x2 wv; wv.x = cvt_pk_bf16(r0, r1); wv.y = cvt_pk_bf16(r2, r3); *(u32x2*)(op + 16 * dt + 4 * g4) = wv;
                    if ((dt & 3) == 3) __builtin_amdgcn_sched_barrier(0); }
            }
            if (bu == 31) VM_WAIT();
            __syncthreads();
            if (bu == 31) { __builtin_amdgcn_fence(__ATOMIC_ACQUIRE, "agent"); }
            if (bu + 1 < 48) ATT_WRITE(prev);
            __syncthreads();
        }
#undef ATT_DECODE
#undef ATT_LANE
#undef ATT_LOAD
#undef ATT_QLOAD
#undef ATT_WRITE
    }
}

template <int CTRL> __device__ __forceinline__ float dpp_shr0(float v) { return __int_as_float(__builtin_amdgcn_update_dpp(0, __float_as_int(v), CTRL, 0xf, 0xf, true)); }
__device__ __forceinline__ float gelu_tanh(float v) {
    const float inner = 0.7978845608028654f * (v + 0.044715f * v * v * v);
    return v * __builtin_amdgcn_rcpf(1.0f + __builtin_amdgcn_exp2f(-2.8853900817779268f * inner));
}
__device__ __forceinline__ void s5_phase(Frame& F, const bf16* U, bf16* Gout, const unsigned* tabl, const float* dskip) {
    typedef __attribute__((address_space(1))) const bf16 gcbf; typedef __attribute__((address_space(1))) bf16 gbf;
    int tid = F.tid;
#define S5_LANE() asm volatile("" : "+v"(tid)); const int lane = tid & 63, vs = lane & 15, g4 = lane >> 4; (void)vs
    for (int unit = F.vcu; unit < BATCH * (NG / 8); unit += F.G) {
        const int b = unit >> 4, g = (unit & 15) * 8 + F.wave;
        const unsigned* tab = tabl + (size_t)g * S5T_WORDS;
        float lr[4][4], li[4][4], xr[4][4], xi[4][4];
        s16x4 bbf[8];
        { S5_LANE();
#pragma unroll
        for (int q = 0; q < 4; ++q)
#pragma unroll
            for (int i = 0; i < 4; ++i) { const int p = 16 * q + 4 * g4 + i; lr[q][i] = __uint_as_float(tab[p]); li[q][i] = __uint_as_float(tab[64 + p]); xr[q][i] = 0.f; xi[q][i] = 0.f; }
#pragma unroll
        for (int tau = 0; tau < 8; ++tau) bbf[tau] = *(const s16x4*)(tab + 256 + (tau * 64 + lane) * 2); }
        const f32x4 zero4 = (f32x4){0.f, 0.f, 0.f, 0.f};
        { S5_LANE();
        gcbf* upt = (gcbf*)(U + ((size_t)b * T + 128 * vs) * D + g * SG + 4 * g4);
#pragma unroll 2
        for (int tt = 0; tt < 128; ++tt, upt += D) {
            const s16x4 ub = *(const __attribute__((address_space(1))) s16x4*)upt;
#pragma unroll
            for (int q = 0; q < 4; ++q) {
                const f32x4 br = __builtin_amdgcn_mfma_f32_16x16x16bf16_1k(bbf[2 * q], ub, zero4, 0, 0, 0), bi = __builtin_amdgcn_mfma_f32_16x16x16bf16_1k(bbf[2 * q + 1], ub, zero4, 0, 0, 0);
#pragma unroll
                for (int i = 0; i < 4; ++i) { const float nr = lr[q][i] * xr[q][i] - li[q][i] * xi[q][i] + br[i], ni = lr[q][i] * xi[q][i] + li[q][i] * xr[q][i] + bi[i]; xr[q][i] = nr; xi[q][i] = ni; }
            }
        } }
        {
            S5_LANE();
            float ar[4][4], ai[4][4];
#pragma unroll
            for (int q = 0; q < 4; ++q)
#pragma unroll
                for (int i = 0; i < 4; ++i) { const int p = 16 * q + 4 * g4 + i; ar[q][i] = __uint_as_float(tab[128 + p]); ai[q][i] = __uint_as_float(tab[192 + p]); }
#define S5_STEP(CTRL) do { _Pragma("unroll") for (int q = 0; q < 4; ++q) _Pragma("unroll") for (int i = 0; i < 4; ++i) { \
                const float nbr = dpp_shr0<CTRL>(xr[q][i]), nbi = dpp_shr0<CTRL>(xi[q][i]); \
                xr[q][i] += ar[q][i] * nbr - ai[q][i] * nbi; xi[q][i] += ar[q][i] * nbi + ai[q][i] * nbr; \
                const float sr = ar[q][i] * ar[q][i] - ai[q][i] * ai[q][i], si = 2.0f * ar[q][i] * ai[q][i]; ar[q][i] = sr; ai[q][i] = si; } } while (0)
            S5_STEP(0x111); S5_STEP(0x112); S5_STEP(0x114); S5_STEP(0x118);
#undef S5_STEP
#pragma unroll
            for (int q = 0; q < 4; ++q)
#pragma unroll
                for (int i = 0; i < 4; ++i) { xr[q][i] = dpp_shr0<0x111>(xr[q][i]); xi[q][i] = dpp_shr0<0x111>(xi[q][i]); }
        }
        { S5_LANE();
        bf16x8 cmf[4];
#pragma unroll
        for (int q = 0; q < 4; ++q) cmf[q] = *(const bf16x8*)(tab + 1280 + (q * 64 + lane) * 4);
        const f32x4 dsk = *(const f32x4*)(dskip + g * SG + 4 * g4);
        gcbf* upt = (gcbf*)(U + ((size_t)b * T + 128 * vs) * D + g * SG + 4 * g4);
        gbf* gp = (gbf*)(Gout + ((size_t)b * T + 128 * vs) * DP + g * SG + 4 * g4);
#pragma unroll 1
        for (int tt = 0; tt < 128; ++tt, upt += D, gp += DP) {
            const u32x2 uw = *(const __attribute__((address_space(1))) u32x2*)upt;
            const s16x4 ub = __builtin_bit_cast(s16x4, uw);
            f32x4 y = zero4;
#pragma unroll
            for (int q = 0; q < 4; ++q) {
                const f32x4 br = __builtin_amdgcn_mfma_f32_16x16x16bf16_1k(bbf[2 * q], ub, zero4, 0, 0, 0), bi = __builtin_amdgcn_mfma_f32_16x16x16bf16_1k(bbf[2 * q + 1], ub, zero4, 0, 0, 0);
#pragma unroll
                for (int i = 0; i < 4; ++i) { const float nr = lr[q][i] * xr[q][i] - li[q][i] * xi[q][i] + br[i], ni = lr[q][i] * xi[q][i] + li[q][i] * xr[q][i] + bi[i]; xr[q][i] = nr; xi[q][i] = ni; }
                u32x4 xw; xw.x = cvt_pk_bf16(xr[q][0], xr[q][1]); xw.y = cvt_pk_bf16(xr[q][2], xr[q][3]); xw.z = cvt_pk_bf16(xi[q][0], xi[q][1]); xw.w = cvt_pk_bf16(xi[q][2], xi[q][3]);
                y = __builtin_amdgcn_mfma_f32_16x16x32_bf16(cmf[q], __builtin_bit_cast(bf16x8, xw), y, 0, 0, 0);
            }
            const float v0 = y[0] + dsk[0] * bf_lo(uw.x), v1 = y[1] + dsk[1] * bf_hi(uw.x), v2 = y[2] + dsk[2] * bf_lo(uw.y), v3 = y[3] + dsk[3] * bf_hi(uw.y);
            u32x2 ow; ow.x = cvt_pk_bf16(gelu_tanh(v0), gelu_tanh(v1)); ow.y = cvt_pk_bf16(gelu_tanh(v2), gelu_tanh(v3));
            *(__attribute__((address_space(1))) u32x2*)gp = ow;
        } }
    }
#undef S5_LANE
}

constexpr int NPH_PAIR = 17, NPHASE = 2 + 2 * NPH_PAIR;
struct Args { const float* in[24]; float* out; unsigned char* ws; int ph_lo, ph_hi, dry, pad; };
__device__ __forceinline__ const float* argp(const Args& a, int i) { asm volatile("" : "+s"(i)); return a.in[i]; }
__global__ void __launch_bounds__(NWAVES * 64, 2) fwd_kernel(Args args) {
    extern __shared__ __attribute__((aligned(16))) unsigned char lds[];
    Frame F;
    F.lds = (LAS unsigned char*)lds;
    F.MISC = (volatile LAS unsigned*)(F.lds + MISC_OFF);
    F.tid = threadIdx.x; F.lane = F.tid & 63; F.wave = __builtin_amdgcn_readfirstlane(F.tid >> 6);
    F.G = gridDim.x; { const int bx = blockIdx.x; F.vcu = (F.G % 8 == 0) ? (bx % 8) * (F.G / 8) + bx / 8 : bx; }
    F.ws = args.ws; F.ctl = (unsigned*)(F.ws + WS_CTL);
    for (int u = F.tid; u < (EXCH_OFF - LDSCTL_OFF) / 4; u += NWAVES * 64) ((LAS unsigned*)(F.lds + LDSCTL_OFF))[u] = 0u;
    __syncthreads();
#if MK_ONE_LAUNCH
    XcdBarrier bar = xcd_barrier_post(F.ctl + CW_BAR, F.MISC + 8);
#if MK_DOUBLE_BAR
#define GRID_BAR() do { xcd_barrier(bar); xcd_barrier(bar); } while (0)
#else
#define GRID_BAR() xcd_barrier(bar)
#endif
#else
#define GRID_BAR() do { } while (0)
#endif
    const int lo = args.ph_lo, hi = args.ph_hi;
#define IN(k) (lo <= (k) && (k) < hi && (frame_refresh(F, args.ws, args.out), true))
#define SEAM(k) do { if (lo <= (k) && (k) + 1 < hi) GRID_BAR(); } while (0)
#define xres (F.out)
#if MK_DRY_MASK
#define xout (args.dry ? (float*)(F.ws + WS_BIG + 512 * MiB) : F.out)
#else
#define xout (F.out)
#endif
#define Hb ((bf16*)(F.ws + WS_H))
#define BIG ((bf16*)(F.ws + WS_BIG))
#define ring (F.lds + RING_OFF)
#define moda ((const float*)(F.ws + WS_MOD) + (size_t)la * BATCH * MODW)
#define mods ((const float*)(F.ws + WS_MOD) + (size_t)ls * BATCH * MODW)
#define xa ((pr == 0) ? argp(args, 0) : (const float*)F.out)

    if (IN(0)) {
        P0In pin{argp(args, 1), argp(args, 2), argp(args, 3), argp(args, 6), argp(args, 7), argp(args, 8), argp(args, 9), argp(args, 10), argp(args, 11), argp(args, 12), argp(args, 13), argp(args, 14), argp(args, 15),
                 argp(args, 17), argp(args, 18), argp(args, 19), argp(args, 22)};
        p0_prologue(F, pin);
    }
    SEAM(0);
    for (int pr = 0; pr < 2; ++pr) {
        const int pb = 1 + NPH_PAIR * pr, la = 2 * pr, ls = 2 * pr + 1;
        if (IN(pb + 0)) norm_mod_phase(F, xa, Hb, argp(args, 4) + (size_t)la * D, moda, 0, D);
        SEAM(pb + 0);
        if (IN(pb + 1)) { pg8::Gemm g{Hb, (const bf16*)(F.ws + WS_WAIN + pr * W_AIN_B), M, AIN, D, DP}; pg8::StaticOrder S; S.init(M, AIN, F.G, pg8::opaque_bid());
#if MK_DRY_MASK
            if (args.dry) { pg8::EpiNull E0; pg8::SameTileOrder S1; S1.init(M, AIN, F.G, pg8::opaque_bid()); pg8::gemm_phase<pg8::EpiNull, pg8::SameTileOrder, true, true>(ring, g, S1, E0); } else
#endif
            { pg8::EpiQKV E{BIG}; pg8::gemm_phase<pg8::EpiQKV, pg8::StaticOrder, true, true>(ring, g, S, E); } }
        SEAM(pb + 1);
#if MK_DRY_MASK
        if (IN(pb + 2)) { if (args.dry) attn_phase<MK_ATTN_SAME != 0>(F, BIG, (bf16*)F.out, (float*)(F.ws + WS_RAW)); else attn_phase<false>(F, BIG, Hb, (float*)(F.ws + WS_LSE)); }
#else
        if (IN(pb + 2)) attn_phase<false>(F, BIG, Hb, (float*)(F.ws + WS_LSE));
#endif
        SEAM(pb + 2);
        if (IN(pb + 3)) { pg8::Gemm g{Hb, (const bf16*)(F.ws + WS_WAOUT + pr * W_DD_B), M, D, D, DP}; pg8::StaticOrder S; S.init(M, D, F.G, pg8::opaque_bid());
            pg8::EpiGateRes E{xa, xout, moda + 2 * D}; pg8::gemm_phase<pg8::EpiGateRes, pg8::StaticOrder, true, true>(ring, g, S, E); }
        SEAM(pb + 3);
        if (IN(pb + 4)) norm_mod_phase(F, xres, Hb, argp(args, 5) + (size_t)la * D, moda, 3 * D, 4 * D);
        SEAM(pb + 4);
        if (IN(pb + 5)) { pg8::Gemm g{Hb, (const bf16*)(F.ws + WS_WUP + la * W_UP_B), M, FF2, D, DP}; pg8::StaticOrder S; S.init(M, FF2, F.G, pg8::opaque_bid());
            pg8::EpiConvGate E{BIG, (float*)(F.ws + WS_RAW), argp(args, 20) + (size_t)la * 3 * FF2, argp(args, 21) + (size_t)la * FF2, F.lds + EXCH_OFF};
            pg8::gemm_phase<pg8::EpiConvGate, pg8::StaticOrder, true, true>(ring, g, S, E); }
        SEAM(pb + 5);
        if (IN(pb + 6)) conv_fix_phase(F, (const float*)(F.ws + WS_RAW), BIG, argp(args, 20) + (size_t)la * 3 * FF2, argp(args, 21) + (size_t)la * FF2);
        SEAM(pb + 6);
        if (IN(pb + 7)) { pg8::Gemm g{BIG, (const bf16*)(F.ws + WS_WDOWN + la * W_DN_B), M, D, FF, FFP}; pg8::StaticOrder S; S.init(M, D, F.G, pg8::opaque_bid());
            pg8::EpiGateRes E{xres, xout, moda + 5 * D}; pg8::gemm_phase<pg8::EpiGateRes, pg8::StaticOrder, true, true>(ring, g, S, E); }
        SEAM(pb + 7);
        if (IN(pb + 8)) norm_mod_phase(F, xres, Hb, argp(args, 4) + (size_t)ls * D, mods, 0, D);
        SEAM(pb + 8);
        if (IN(pb + 9)) { pg8::Gemm g{Hb, (const bf16*)(F.ws + WS_WSIN + pr * W_DD_B), M, D, D, DP}; pg8::StaticOrder S; S.init(M, D, F.G, pg8::opaque_bid());
            pg8::EpiBf16 E{BIG, D}; pg8::gemm_phase<pg8::EpiBf16, pg8::StaticOrder, true, true>(ring, g, S, E); }
        SEAM(pb + 9);
        if (IN(pb + 10)) s5_phase(F, BIG, Hb, (const unsigned*)(F.ws + WS_S5T) + (size_t)pr * NG * S5T_WORDS, argp(args, 16) + (size_t)pr * D);
        SEAM(pb + 10);
        if (IN(pb + 11)) { pg8::Gemm g{Hb, (const bf16*)(F.ws + WS_WSGATE + pr * W_DD_B), M, D, D, DP}; pg8::StaticOrder S; S.init(M, D, F.G, pg8::opaque_bid());
            pg8::EpiSigGate E{Hb, (bf16*)(F.ws + WS_BIG + 128 * MiB)}; pg8::gemm_phase<pg8::EpiSigGate, pg8::StaticOrder, true, true>(ring, g, S, E); }
        SEAM(pb + 11);
        if (IN(pb + 12)) { pg8::Gemm g{(const bf16*)(F.ws + WS_BIG + 128 * MiB), (const bf16*)(F.ws + WS_WSOUT + pr * W_DD_B), M, D, D, DP}; pg8::StaticOrder S; S.init(M, D, F.G, pg8::opaque_bid());
            pg8::EpiGateRes E{xres, xout, mods + 2 * D}; pg8::gemm_phase<pg8::EpiGateRes, pg8::StaticOrder, true, true>(ring, g, S, E); }
        SEAM(pb + 12);
        if (IN(pb + 13)) norm_mod_phase(F, xres, Hb, argp(args, 5) + (size_t)ls * D, mods, 3 * D, 4 * D);
        SEAM(pb + 13);
        if (IN(pb + 14)) { pg8::Gemm g{Hb, (const bf16*)(F.ws + WS_WUP + ls * W_UP_B), M, FF2, D, DP}; pg8::StaticOrder S; S.init(M, FF2, F.G, pg8::opaque_bid());
            pg8::EpiConvGate E{BIG, (float*)(F.ws + WS_RAW), argp(args, 20) + (size_t)ls * 3 * FF2, argp(args, 21) + (size_t)ls * FF2, F.lds + EXCH_OFF};
            pg8::gemm_phase<pg8::EpiConvGate, pg8::StaticOrder, true, true>(ring, g, S, E); }
        SEAM(pb + 14);
        if (IN(pb + 15)) conv_fix_phase(F, (const float*)(F.ws + WS_RAW), BIG, argp(args, 20) + (size_t)ls * 3 * FF2, argp(args, 21) + (size_t)ls * FF2);
        SEAM(pb + 15);
        if (IN(pb + 16)) { pg8::Gemm g{BIG, (const bf16*)(F.ws + WS_WDOWN + ls * W_DN_B), M, D, FF, FFP}; pg8::StaticOrder S; S.init(M, D, F.G, pg8::opaque_bid());
            pg8::EpiGateRes E{xres, xout, mods + 5 * D}; pg8::gemm_phase<pg8::EpiGateRes, pg8::StaticOrder, true, true>(ring, g, S, E); }
        SEAM(pb + 16);
    }
    if (IN(NPHASE - 1)) final_norm_phase(F, xres, xout, argp(args, 23));
#undef IN
#undef xres
#undef xout
#undef Hb
#undef BIG
#undef ring
#undef moda
#undef mods
#undef xa
#undef SEAM
#undef GRID_BAR
}

extern "C" void kernel_launch(void* const* d_in, const int* in_sizes, int n_in, void* d_out, int out_size, void* d_ws, size_t ws_size, hipStream_t stream) {
    static int grid = 0;
    if (grid == 0) {
        if (n_in != 24 || in_sizes[0] != M * D || out_size != M * D || ws_size < WS_END) { fprintf(stderr, "kernel_launch: shape mismatch: n_in %d in0 %d out %d ws %zu (need %zu)\n", n_in, n_in > 0 ? in_sizes[0] : -1, out_size, ws_size, (size_t)WS_END); grid = -1; return; }
        int dev = 0, cus = 0, per_cu = 0;
        if (hipGetDevice(&dev) != hipSuccess || hipDeviceGetAttribute(&cus, hipDeviceAttributeMultiprocessorCount, dev) != hipSuccess) { grid = -1; return; }
        if (hipFuncSetAttribute((const void*)fwd_kernel, hipFuncAttributeMaxDynamicSharedMemorySize, LDS_BYTES) != hipSuccess) { fprintf(stderr, "kernel_launch: hipFuncSetAttribute failed\n"); grid = -1; return; }
        if (hipOccupancyMaxActiveBlocksPerMultiprocessor(&per_cu, (const void*)fwd_kernel, NWAVES * 64, LDS_BYTES) != hipSuccess || per_cu < 1) { fprintf(stderr, "kernel_launch: occupancy query says %d\n", per_cu); }
        (void)hipGetLastError();
        grid = cus;
    }
    if (grid < 0) return;
    if (hipMemsetAsync((char*)d_ws + WS_CTL, 0, CTL_ZERO_BYTES, stream) != hipSuccess) return;
    Args a{};
    for (int i = 0; i < 24; ++i) a.in[i] = (const float*)d_in[i];
    a.out = (float*)d_out; a.ws = (unsigned char*)d_ws;
#if MK_ONE_LAUNCH
    a.ph_lo = 0; a.ph_hi = NPHASE;
    hipLaunchKernelGGL(fwd_kernel, dim3(grid), dim3(NWAVES * 64), LDS_BYTES, stream, a);
#else
    for (int p = 0; p < NPHASE; ++p) { a.ph_lo = p; a.ph_hi = p + 1;
#if MK_DEBUG_CHECKS
        debug_checks(p, true, d_in, (float*)d_out, (unsigned char*)d_ws, stream);
#endif
        { const int kbit = (p == 0) ? 17 : (p == NPHASE - 1 ? 18 : (p - 1) % NPH_PAIR); const int nrep = ((MK_REPEAT_MASK >> kbit) & 1) ? 2 : 1;
          for (int r = 0; r < nrep; ++r) hipLaunchKernelGGL(fwd_kernel, dim3(grid), dim3(NWAVES * 64), LDS_BYTES, stream, a);
          if (((MK_DRY_MASK >> kbit) & 1) && !(kbit == 2 && p > NPH_PAIR)) { a.dry = 1; hipLaunchKernelGGL(fwd_kernel, dim3(grid), dim3(NWAVES * 64), LDS_BYTES, stream, a); a.dry = 0; } }
#if MK_DEBUG_CHECKS
        debug_checks(p, false, d_in, (float*)d_out, (unsigned char*)d_ws, stream);
#endif
    }
#endif
    const hipError_t le = hipPeekAtLastError();
    if (le != hipSuccess) fprintf(stderr, "kernel_launch: launch failed: %s\n", hipGetErrorName(le));
}
```

```cpp
#include <hip/hip_runtime.h>
#include <cstdio>
#include <cstdint>

#ifndef MK_ONE_LAUNCH
#define MK_ONE_LAUNCH 1
#endif
#ifndef MK_DEBUG_CHECKS
#define MK_DEBUG_CHECKS 0
#endif
#ifndef MK_REPEAT_MASK
#define MK_REPEAT_MASK 0
#endif
#ifndef MK_DRY_MASK
#define MK_DRY_MASK 0
#endif
#ifndef MK_ATTN_SAME
#define MK_ATTN_SAME 0
#endif
#ifndef MK_DOUBLE_BAR
#define MK_DOUBLE_BAR 0
#endif
#ifndef MK_DEBUG_NOTAPS
#define MK_DEBUG_NOTAPS 0
#endif

constexpr int BATCH = 16, T = 2048, D = 2048, M = BATCH * T, DEPTH = 4;
constexpr int NH = 16, HD = 128, QK_COLS = 3 * NH * HD, V_COLS = NH * HD, AIN = 2 * QK_COLS + V_COLS;
constexpr int SG = 16, NG = D / SG, SP = 64;
constexpr int FF = 5632, FF2 = 2 * FF;
constexpr int MODW = 6 * D;
constexpr float EPS = 1e-6f;
constexpr int KPAD = 64, DP = D + KPAD, FFP = FF + KPAD;

namespace pg8 {
#define PG8_LAS __attribute__((address_space(3)))
typedef unsigned short bf16_t;
typedef short bf16x8 __attribute__((ext_vector_type(8)));
typedef float f32x4 __attribute__((ext_vector_type(4)));
typedef unsigned u32x4 __attribute__((ext_vector_type(4)));
typedef unsigned u32x2 __attribute__((ext_vector_type(2)));
constexpr int BM = 256, BK = 64, HALF = 128, HTB = HALF * BK * 2  , STAGE_BYTES = 8 * HTB, NXCD = 8, WGM = 4;

__host__ __device__ __forceinline__ int lds_byte(int r, int c) { const int st = (r >> 4) * 2 + (c >> 5), rr = r & 15, cc = c & 31, ob = rr * 64 + cc * 2; return st * 1024 + (ob ^ (((ob >> 9) & 1) << 5)); }
__host__ __device__ __forceinline__ void stage_rc(int b, int& R, int& C) { const int st = b / 1024, sb = b % 1024, swz = sb ^ (((sb >> 9) & 1) << 5); R = (st >> 1) * 16 + swz / 64; C = (st & 1) * 32 + (swz % 64) / 2; }
__host__ __device__ __forceinline__ int perm32(int rho) { const int n = rho >> 4, i = rho & 15; return 8 * (i >> 2) + 4 * n + (i & 3); }

__device__ __forceinline__ int opaque_tid() { int t = (int)threadIdx.x; asm volatile("" : "+v"(t)); return t; }
__device__ __forceinline__ int opaque_bid() { int t = (int)blockIdx.x; asm volatile("" : "+s"(t)); return t; }
struct Unit { int pm, pn; };
struct Gemm { const bf16_t* A; const bf16_t* Bt; int M, N, K, ldk; };

struct StaticOrder {
    int nM, nN, nwg, G, c;
    __host__ __device__ void init(int M_, int N_, int G_, int c_) { nM = M_ / BM; nN = N_ / BM; nwg = nM * nN; G = G_; c = c_; }
    __host__ __device__ bool next(int i, Unit& u) const {
        const long L = (long)i * G + c; if (L >= nwg) return false;
        int wgid = (int)L; { const int q = nwg / NXCD, r = nwg % NXCD, xcd = wgid % NXCD, off = wgid / NXCD; wgid = (xcd < r ? xcd * (q + 1) : r * (q + 1) + (xcd - r) * q) + off; }
        const int nig = WGM * nN, gid = wgid / nig, fm = gid * WGM, gsz = (nM - fm) < WGM ? (nM - fm) : WGM;
        u.pm = fm + ((wgid % nig) % gsz); u.pn = (wgid % nig) / gsz; return true;
    }
    __device__ __forceinline__ void a_ready(const Unit&) const {}
    __device__ __forceinline__ void done(const Unit&) const {}
};
#if MK_DRY_MASK
struct SameTileOrder : StaticOrder {
    __host__ __device__ bool next(int i, Unit& u) const { const bool ok = StaticOrder::next(i, u); u.pm = 0; u.pn = 0; return ok; }
};
#endif

__device__ __forceinline__ unsigned cvt_pk_bf16(float lo, float hi) { unsigned r; asm volatile("v_cvt_pk_bf16_f32 %0, %1, %2" : "=v"(r) : "v"(lo), "v"(hi)); return r; }
__device__ __forceinline__ float bf_lo(unsigned w) { return __uint_as_float(w << 16); }
__device__ __forceinline__ float bf_hi(unsigned w) { return __uint_as_float(w & 0xffff0000u); }
__device__ __forceinline__ float fast_sigmoid(float v) { return __builtin_amdgcn_rcpf(1.0f + __builtin_amdgcn_exp2f(-1.4426950408889634f * v)); }

struct EpiBf16 {
    static constexpr bool PERM = true, AFTER_DRAIN = false;
    bf16_t* O; int ldc;
    __device__ __forceinline__ void operator()(const f32x4 (&acc)[2][2][4][2], const Unit& u, int wr, int wc, int fr, int fq) const {
        const int row0 = u.pm * BM + wr * 64 + fr, col0 = u.pn * BM + wc * 32 + 8 * fq;
#pragma unroll
        for (int ai = 0; ai < 2; ++ai)
#pragma unroll
            for (int m = 0; m < 4; ++m) { bf16_t* rowp = O + (size_t)(row0 + ai * HALF + m * 16) * ldc + col0;
#pragma unroll
                for (int bj = 0; bj < 2; ++bj) { const f32x4 v0 = acc[ai][bj][m][0], v1 = acc[ai][bj][m][1];
                    u32x4 w; w.x = cvt_pk_bf16(v0[0], v0[1]); w.y = cvt_pk_bf16(v0[2], v0[3]); w.z = cvt_pk_bf16(v1[0], v1[1]); w.w = cvt_pk_bf16(v1[2], v1[3]);
                    *(u32x4*)(rowp + bj * HALF) = w; } }
    }
};
#if MK_DRY_MASK
struct EpiNull {
    static constexpr bool PERM = true, AFTER_DRAIN = false;
    __device__ __forceinline__ void operator()(const f32x4 (&acc)[2][2][4][2], const Unit& u, int wr, int wc, int fr, int fq) const {
#pragma unroll
        for (int ai = 0; ai < 2; ++ai)
#pragma unroll
            for (int bj = 0; bj < 2; ++bj)
#pragma unroll
                for (int m = 0; m < 4; ++m)
#pragma unroll
                    for (int n = 0; n < 2; ++n) asm volatile("" :: "v"(acc[ai][bj][m][n]));
    }
};
#endif
constexpr size_t QK_PART = (size_t)BATCH * NH * 3 * T * HD;
struct EpiQKV {
    static constexpr bool PERM = true, AFTER_DRAIN = false;
    bf16_t* O;
    __device__ __forceinline__ void operator()(const f32x4 (&acc)[2][2][4][2], const Unit& u, int wr, int wc, int fr, int fq) const {
        const int part = u.pn >> 3, b = u.pm >> 3, t0 = (u.pm & 7) * BM + wr * 64 + fr, d0 = wc * 32 + 8 * fq;
        const int grp = part < 3 ? part : (part < 6 ? part - 3 : 0), sh = 2 * grp;
#pragma unroll
        for (int bj = 0; bj < 2; ++bj) { const int h = 2 * (u.pn & 7) + bj;
            bf16_t* hb = (part < 6) ? O + (part >= 3 ? QK_PART : 0) + ((size_t)((b * NH + h) * 3 + grp) * T) * HD + d0 : O + 2 * QK_PART + ((size_t)(b * NH + h) * T) * HD + d0;
#pragma unroll
            for (int ai = 0; ai < 2; ++ai)
#pragma unroll
                for (int m = 0; m < 4; ++m) { const int t = t0 + ai * HALF + m * 16;
                    const int pos = (part < 6) ? ((t & ((1 << sh) - 1)) * (T >> sh) + (t >> sh)) : t;
                    const f32x4 v0 = acc[ai][bj][m][0], v1 = acc[ai][bj][m][1];
                    u32x4 w; w.x = cvt_pk_bf16(v0[0], v0[1]); w.y = cvt_pk_bf16(v0[2], v0[3]); w.z = cvt_pk_bf16(v1[0], v1[1]); w.w = cvt_pk_bf16(v1[2], v1[3]);
                    *(u32x4*)(hb + (size_t)pos * HD) = w; } }
    }
};
struct EpiGateRes {
    static constexpr bool PERM = false, AFTER_DRAIN = false;
    const float* base; float* out; const float* gate;
    __device__ __forceinline__ void operator()(const f32x4 (&acc)[2][2][4][2], const Unit& u, int wr, int wc, int fr, int fq) const {
        const int row0 = u.pm * BM + wr * 64 + fr, col0 = u.pn * BM + wc * 32 + 4 * fq;
        const float* gp = gate + (size_t)(u.pm >> 3) * MODW + col0;
        f32x4 gv[2][2];
#pragma unroll
        for (int bj = 0; bj < 2; ++bj)
#pragma unroll
            for (int n = 0; n < 2; ++n) gv[bj][n] = *(const f32x4*)(gp + bj * HALF + n * 16);
        const float* bp = base + (size_t)row0 * D + col0; float* op = out + (size_t)row0 * D + col0;
        f32x4 b0[2][2][2], b1[2][2][2];
#define EGR_LOAD(dst, ai, m0, nm) do { _Pragma("unroll") for (int m = 0; m < (nm); ++m) _Pragma("unroll") for (int bj = 0; bj < 2; ++bj) _Pragma("unroll") for (int n = 0; n < 2; ++n) \
            dst[m][bj][n] = *(const f32x4*)(bp + (size_t)((ai) * HALF + ((m0) + m) * 16) * D + bj * HALF + n * 16); } while (0)
#define EGR_STORE(src, ai, m0, nm) do { _Pragma("unroll") for (int m = 0; m < (nm); ++m) _Pragma("unroll") for (int bj = 0; bj < 2; ++bj) _Pragma("unroll") for (int n = 0; n < 2; ++n) \
            *(f32x4*)(op + (size_t)((ai) * HALF + ((m0) + m) * 16) * D + bj * HALF + n * 16) = src[m][bj][n] + gv[bj][n] * acc[ai][bj][(m0) + m][n]; } while (0)
        EGR_LOAD(b0, 0, 0, 2); asm volatile("" ::: "memory");
        EGR_LOAD(b1, 0, 2, 2); asm volatile("" ::: "memory");
        EGR_STORE(b0, 0, 0, 2); asm volatile("" ::: "memory");
        EGR_LOAD(b0, 1, 0, 2); asm volatile("" ::: "memory");
        EGR_STORE(b1, 0, 2, 2); asm volatile("" ::: "memory");
        EGR_LOAD(b1, 1, 2, 2); asm volatile("" ::: "memory");
        EGR_STORE(b0, 1, 0, 2); asm volatile("" ::: "memory");
        EGR_STORE(b1, 1, 2, 2);
#undef EGR_LOAD
#undef EGR_STORE
    }
};
struct EpiSigGate {
    static constexpr bool PERM = true, AFTER_DRAIN = false;
    const bf16_t* gsrc; bf16_t* O;
    __device__ __forceinline__ void operator()(const f32x4 (&acc)[2][2][4][2], const Unit& u, int wr, int wc, int fr, int fq) const {
        const int row0 = u.pm * BM + wr * 64 + fr, col0 = u.pn * BM + wc * 32 + 8 * fq;
#pragma unroll
        for (int ai = 0; ai < 2; ++ai)
#pragma unroll
            for (int m = 0; m < 4; ++m) { const size_t off = (size_t)(row0 + ai * HALF + m * 16) * DP + col0;
#pragma unroll
                for (int bj = 0; bj < 2; ++bj) { const f32x4 v0 = acc[ai][bj][m][0], v1 = acc[ai][bj][m][1];
                    const u32x4 g = *(const u32x4*)(gsrc + off + bj * HALF);
                    u32x4 w;
                    w.x = cvt_pk_bf16(bf_lo(g.x) * fast_sigmoid(v0[0]), bf_hi(g.x) * fast_sigmoid(v0[1]));
                    w.y = cvt_pk_bf16(bf_lo(g.y) * fast_sigmoid(v0[2]), bf_hi(g.y) * fast_sigmoid(v0[3]));
                    w.z = cvt_pk_bf16(bf_lo(g.z) * fast_sigmoid(v1[0]), bf_hi(g.z) * fast_sigmoid(v1[1]));
                    w.w = cvt_pk_bf16(bf_lo(g.w) * fast_sigmoid(v1[2]), bf_hi(g.w) * fast_sigmoid(v1[3]));
                    *(u32x4*)(O + off + bj * HALF) = w; }
                asm volatile("" ::: "memory"); }
    }
};
template <int CTRL> __device__ __forceinline__ float dpp_ror(float v) { return __int_as_float(__builtin_amdgcn_mov_dpp(__float_as_int(v), CTRL, 0xf, 0xf, true)); }
struct EpiConvGate {
    static constexpr bool PERM = true, AFTER_DRAIN = false;
    bf16_t* O; float* raw; const float* cw; const float* cb; PG8_LAS unsigned char* xlds;
    __device__ __forceinline__ void operator()(const f32x4 (&acc)[2][2][4][2], const Unit& u, int wr, int wc, int fr, int fq) const {
        const int wid = wr * 4 + wc;
        PG8_LAS f32x4* ex = (PG8_LAS f32x4*)xlds;
        if (fr >= 14) {
#pragma unroll
            for (int ai = 0; ai < 2; ++ai)
#pragma unroll
                for (int bj = 0; bj < 2; ++bj)
#pragma unroll
                    for (int n = 0; n < 2; ++n) ex[((((wid * 2 + ai) * 2 + bj) * 2 + n) * 4 + fq) * 2 + (fr - 14)] = acc[ai][bj][3][n];
        }
        asm volatile("s_waitcnt lgkmcnt(0)" ::: "memory"); __builtin_amdgcn_s_barrier(); asm volatile("" ::: "memory");
        const int gcol0 = u.pn * HALF + wc * 32 + 8 * fq;
        const int row0 = u.pm * BM + wr * 64 + fr;
        if (wr == 0 && fr < 2) {
#pragma unroll
            for (int bj = 0; bj < 2; ++bj)
#pragma unroll
                for (int n = 0; n < 2; ++n) *(f32x4*)(raw + ((size_t)u.pm * 4 + fr) * FF2 + bj * FF + gcol0 + 4 * n) = acc[0][bj][0][n];
        }
        if (wr == 1 && fr >= 14) {
#pragma unroll
            for (int bj = 0; bj < 2; ++bj)
#pragma unroll
                for (int n = 0; n < 2; ++n) *(f32x4*)(raw + ((size_t)u.pm * 4 + 2 + (fr - 14)) * FF2 + bj * FF + gcol0 + 4 * n) = acc[1][bj][3][n];
        }
        unsigned outpk[2][4][2];
#pragma unroll
        for (int n = 0; n < 2; ++n) {
            const int gc = gcol0 + 4 * n;
            const f32x4 wg0 = *(const f32x4*)(cw + gc), wg1 = *(const f32x4*)(cw + FF2 + gc), wg2 = *(const f32x4*)(cw + 2 * FF2 + gc), bg = *(const f32x4*)(cb + gc);
            const f32x4 wu0 = *(const f32x4*)(cw + FF + gc), wu1 = *(const f32x4*)(cw + FF2 + FF + gc), wu2 = *(const f32x4*)(cw + 2 * FF2 + FF + gc), bu = *(const f32x4*)(cb + FF + gc);
#pragma unroll
            for (int ai = 0; ai < 2; ++ai) {
                f32x4 pg = (f32x4){0.f, 0.f, 0.f, 0.f}, pu = (f32x4){0.f, 0.f, 0.f, 0.f};
                if (!(ai == 0 && wr == 0) && fr >= 14) {
                    const int sw = (wr == 1) ? wc : 4 + wc, sai = (wr == 1) ? ai : 0;
                    pg = ex[((((sw * 2 + sai) * 2 + 0) * 2 + n) * 4 + fq) * 2 + (fr - 14)];
                    pu = ex[((((sw * 2 + sai) * 2 + 1) * 2 + n) * 4 + fq) * 2 + (fr - 14)];
                }
                f32x4 pg1, pg2, pu1, pu2;
#pragma unroll
                for (int e = 0; e < 4; ++e) { pg1[e] = dpp_ror<0x121>(pg[e]); pg2[e] = dpp_ror<0x122>(pg[e]); pu1[e] = dpp_ror<0x121>(pu[e]); pu2[e] = dpp_ror<0x122>(pu[e]); }
#pragma unroll
                for (int m = 0; m < 4; ++m) {
                    const f32x4 cg = acc[ai][0][m][n], cu = acc[ai][1][m][n];
                    float o[4];
                    f32x4 cg1, cg2, cu1, cu2;
#pragma unroll
                    for (int e = 0; e < 4; ++e) { cg1[e] = dpp_ror<0x121>(cg[e]); cg2[e] = dpp_ror<0x122>(cg[e]); cu1[e] = dpp_ror<0x121>(cu[e]); cu2[e] = dpp_ror<0x122>(cu[e]); }
#pragma unroll
                    for (int e = 0; e < 4; ++e) {
                        const float g1 = (fr == 0) ? pg1[e] : cg1[e], g2 = (fr < 2) ? pg2[e] : cg2[e], u1 = (fr == 0) ? pu1[e] : cu1[e], u2 = (fr < 2) ? pu2[e] : cu2[e];
#if MK_DEBUG_NOTAPS
                        const float gg = bg[e] + wg2[e] * cg[e] + 0.f * (g1 + g2);
                        const float uu = bu[e] + wu2[e] * cu[e] + 0.f * (u1 + u2);
#else
                        const float gg = bg[e] + wg2[e] * cg[e] + wg1[e] * g1 + wg0[e] * g2;
                        const float uu = bu[e] + wu2[e] * cu[e] + wu1[e] * u1 + wu0[e] * u2;
#endif
                        o[e] = gg * fast_sigmoid(gg) * uu;
                    }
                    pg1 = cg1; pg2 = cg2; pu1 = cu1; pu2 = cu2;
                    const unsigned p0 = cvt_pk_bf16(o[0], o[1]), p1 = cvt_pk_bf16(o[2], o[3]);
                    if (n == 0) { outpk[ai][m][0] = p0; outpk[ai][m][1] = p1; }
                    else { u32x4 w; w.x = outpk[ai][m][0]; w.y = outpk[ai][m][1]; w.z = p0; w.w = p1;
                        *(u32x4*)(O + (size_t)(row0 + ai * HALF + m * 16) * FFP + gcol0) = w; }
                }
            }
        }
    }
};

template <class Epi, class Sched, bool ALIGN_EPI = false, bool SP2 = false>
__device__ __forceinline__ void gemm_phase(PG8_LAS unsigned char* lds, const Gemm g, const Sched& S, const Epi& E) {
    const int tid = opaque_tid(), wid = __builtin_amdgcn_readfirstlane(tid >> 6), lane = tid & 63, wr = wid >> 2, wc = wid & 3, fr = lane & 15, fq = lane >> 4;
    const int K = g.K, nt = K / BK, ldk = g.ldk;
    unsigned voffA[2], voffB[2];
#pragma unroll
    for (int i = 0; i < 2; ++i) { int R, C; stage_rc(tid * 16 + i * 8192, R, C); const int Rb = Epi::PERM ? ((R & ~31) + perm32(R & 31)) : R;
        voffA[i] = (unsigned)(R * ldk + C) * 2u; voffB[i] = (unsigned)(Rb * ldk + C) * 2u; }
    const size_t kstep = (size_t)(BK * 2);
    const size_t hstep = (size_t)HALF * ldk * 2;
    const size_t tstep = 2 * hstep;
    const unsigned ldsw = (unsigned)wid * 1024u;
    const int aoff = lds_byte(wr * 64 + fr, fq * 8), boff = lds_byte(wc * 32 + fr, fq * 8);
#define PG8_SA(b, h) (((b) * 2 + (h)) * HTB)
#define PG8_SB(b, h) ((4 + (b) * 2 + (h)) * HTB)
#define PG8_STAGE(bufoff, gbase, voff) do { _Pragma("unroll") for (int _i = 0; _i < 2; ++_i) \
        __builtin_amdgcn_global_load_lds((const unsigned*)((const char*)(gbase) + (voff)[_i]), (PG8_LAS unsigned*)(lds + (bufoff) + ldsw + _i * 8192), 16, 0, 0); } while (0)
#define PG8_LDA(dst, b, h) do { _Pragma("unroll") for (int m = 0; m < 4; ++m) _Pragma("unroll") for (int k = 0; k < 2; ++k) dst[m][k] = *(const PG8_LAS bf16x8*)(lds + PG8_SA(b, h) + aoff + m * 2048 + k * 1024); } while (0)
#define PG8_LDB(dst, b, h) do { _Pragma("unroll") for (int n = 0; n < 2; ++n) _Pragma("unroll") for (int k = 0; k < 2; ++k) dst[n][k] = *(const PG8_LAS bf16x8*)(lds + PG8_SB(b, h) + boff + n * 2048 + k * 1024); } while (0)
#define PG8_MMA(ai, bj, At, Bt) do { __builtin_amdgcn_s_setprio(1); _Pragma("unroll") for (int m = 0; m < 4; ++m) _Pragma("unroll") for (int n = 0; n < 2; ++n) _Pragma("unroll") for (int k = 0; k < 2; ++k) \
        acc[ai][bj][m][n] = __builtin_amdgcn_mfma_f32_16x16x32_bf16(Bt[n][k], At[m][k], acc[ai][bj][m][n], 0, 0, 0); __builtin_amdgcn_s_setprio(0); } while (0)
#define PG8_WAIT_V(n) asm volatile("s_waitcnt vmcnt(" #n ")" ::: "memory")
#define PG8_WAIT_L(n) asm volatile("s_waitcnt lgkmcnt(" #n ")" ::: "memory")
#define PG8_BAR __builtin_amdgcn_s_barrier()
#define PG8_SCHED __builtin_amdgcn_sched_barrier(0)
    Unit cur, nxt; int ui = 0;
    if (!S.next(0, cur)) return;
    f32x4 acc[2][2][4][2];
#pragma unroll
    for (int a = 0; a < 2; ++a)
#pragma unroll
        for (int b = 0; b < 2; ++b)
#pragma unroll
            for (int m = 0; m < 4; ++m)
#pragma unroll
                for (int n = 0; n < 2; ++n) acc[a][b][m][n] = (f32x4){0.f, 0.f, 0.f, 0.f};
    bf16x8 At[4][2], B0[2][2], B1[2][2];
    const char* cA = (const char*)g.A + (size_t)cur.pm * tstep; const char* cB = (const char*)g.Bt + (size_t)cur.pn * tstep;
    S.a_ready(cur);
    if constexpr (SP2) {
        PG8_STAGE(PG8_SB(0, 0), cB, voffB); PG8_STAGE(PG8_SB(0, 1), cB + hstep, voffB); PG8_STAGE(PG8_SA(0, 0), cA, voffA); PG8_STAGE(PG8_SA(0, 1), cA + hstep, voffA);
        if (wr == 1) PG8_BAR;
        PG8_WAIT_V(2); PG8_BAR;
        PG8_STAGE(PG8_SB(1, 0), cB + kstep, voffB); PG8_STAGE(PG8_SA(1, 0), cA + kstep, voffA); PG8_STAGE(PG8_SB(1, 1), cB + hstep + kstep, voffB);
        PG8_WAIT_V(6); PG8_BAR;
    } else {
        PG8_STAGE(PG8_SB(0, 0), cB, voffB); PG8_STAGE(PG8_SA(0, 0), cA, voffA); PG8_STAGE(PG8_SB(0, 1), cB + hstep, voffB); PG8_STAGE(PG8_SA(0, 1), cA + hstep, voffA);
        if (wr == 1) PG8_BAR;
        PG8_WAIT_V(4); PG8_BAR;
        PG8_STAGE(PG8_SB(1, 0), cB + kstep, voffB); PG8_STAGE(PG8_SA(1, 0), cA + kstep, voffA); PG8_STAGE(PG8_SB(1, 1), cB + hstep + kstep, voffB);
        PG8_WAIT_V(6); PG8_BAR;
    }
    for (;;) {
        const bool has_next = S.next(ui + 1, nxt);
        const char* nA = has_next ? (const char*)g.A + (size_t)nxt.pm * tstep : cA; const char* nB = has_next ? (const char*)g.Bt + (size_t)nxt.pn * tstep : cB;
        for (int t = 0; t < nt; t += 2) {
            const bool last = (t == nt - 2);
            const char* a1 = cA + (size_t)(t + 1) * kstep;
            const char* a2 = last ? nA : cA + (size_t)(t + 2) * kstep; const char* b2 = last ? nB : cB + (size_t)(t + 2) * kstep;
            const char* a3 = a2 + kstep; const char* b3 = b2 + kstep;
            if (last && has_next) S.a_ready(nxt);
            if constexpr (SP2) {
            PG8_LDB(B0, 0, 0); PG8_LDB(B1, 0, 1); PG8_SCHED; PG8_LDA(At, 0, 0); PG8_STAGE(PG8_SA(1, 1), a1 + hstep, voffA);
            PG8_WAIT_V(8); PG8_WAIT_L(0); PG8_BAR; PG8_MMA(0, 0, At, B0); PG8_MMA(0, 1, At, B1); PG8_BAR; PG8_SCHED;
            PG8_LDA(At, 0, 1); PG8_STAGE(PG8_SB(0, 0), b2, voffB); PG8_STAGE(PG8_SB(0, 1), b2 + hstep, voffB); PG8_STAGE(PG8_SA(0, 0), a2, voffA);
            PG8_WAIT_V(8); PG8_WAIT_L(0); PG8_BAR; PG8_MMA(1, 0, At, B0); PG8_MMA(1, 1, At, B1); PG8_BAR; PG8_SCHED;
            PG8_LDB(B0, 1, 0); PG8_LDB(B1, 1, 1); PG8_SCHED; PG8_LDA(At, 1, 0); PG8_STAGE(PG8_SA(0, 1), a2 + hstep, voffA);
            PG8_WAIT_V(8); PG8_WAIT_L(0); PG8_BAR; PG8_MMA(0, 0, At, B0); PG8_MMA(0, 1, At, B1); PG8_BAR; PG8_SCHED;
            PG8_LDA(At, 1, 1); PG8_STAGE(PG8_SB(1, 0), b3, voffB); PG8_STAGE(PG8_SB(1, 1), b3 + hstep, voffB); PG8_STAGE(PG8_SA(1, 0), a3, voffA);
            PG8_WAIT_V(8); PG8_WAIT_L(0); PG8_BAR; PG8_MMA(1, 0, At, B0); PG8_MMA(1, 1, At, B1); PG8_BAR; PG8_SCHED;
            } else {
            PG8_LDB(B0, 0, 0); PG8_SCHED; PG8_LDA(At, 0, 0); PG8_STAGE(PG8_SA(1, 1), a1 + hstep, voffA);
            PG8_WAIT_L(8); PG8_BAR; PG8_WAIT_L(0); PG8_MMA(0, 0, At, B0); PG8_BAR; PG8_SCHED;
            PG8_LDB(B1, 0, 1); PG8_STAGE(PG8_SB(0, 0), b2, voffB);
            PG8_BAR; PG8_WAIT_L(0); PG8_MMA(0, 1, At, B1); PG8_BAR;
            PG8_LDA(At, 0, 1); PG8_STAGE(PG8_SA(0, 0), a2, voffA);
            PG8_BAR; PG8_WAIT_L(0); PG8_MMA(1, 0, At, B0); PG8_BAR; PG8_SCHED;
            PG8_STAGE(PG8_SB(0, 1), b2 + hstep, voffB);
            PG8_WAIT_V(6); PG8_BAR; PG8_MMA(1, 1, At, B1); PG8_BAR;
            PG8_LDB(B0, 1, 0); PG8_SCHED; PG8_LDA(At, 1, 0); PG8_STAGE(PG8_SA(0, 1), a2 + hstep, voffA);
            PG8_WAIT_L(8); PG8_BAR; PG8_WAIT_L(0); PG8_MMA(0, 0, At, B0); PG8_BAR; PG8_SCHED;
            PG8_LDB(B1, 1, 1); PG8_STAGE(PG8_SB(1, 0), b3, voffB);
            PG8_BAR; PG8_WAIT_L(0); PG8_MMA(0, 1, At, B1); PG8_BAR;
            PG8_LDA(At, 1, 1); PG8_STAGE(PG8_SA(1, 0), a3, voffA);
            PG8_BAR; PG8_WAIT_L(0); PG8_MMA(1, 0, At, B0); PG8_BAR; PG8_SCHED;
            PG8_STAGE(PG8_SB(1, 1), b3 + hstep, voffB);
            PG8_WAIT_V(6); PG8_BAR; PG8_MMA(1, 1, At, B1); PG8_BAR;
            }
        }
        if constexpr (ALIGN_EPI) { if (wr == 0) PG8_BAR; }
        if constexpr (!Epi::AFTER_DRAIN) { E(acc, cur, wr, wc, fr, fq); S.done(cur); }
        if (!has_next) break;
#pragma unroll
        for (int a = 0; a < 2; ++a)
#pragma unroll
            for (int b = 0; b < 2; ++b)
#pragma unroll
                for (int m = 0; m < 4; ++m)
#pragma unroll
                    for (int n = 0; n < 2; ++n) acc[a][b][m][n] = (f32x4){0.f, 0.f, 0.f, 0.f};
        cur = nxt; cA = nA; cB = nB; ++ui;
        if constexpr (ALIGN_EPI) { if (wr == 1) PG8_BAR; }
    }
    PG8_WAIT_V(0);
    if constexpr (!ALIGN_EPI) { if (wr == 0) PG8_BAR; }
    PG8_BAR;
    if constexpr (Epi::AFTER_DRAIN) { E.fused(acc, cur, wr, wc, fr, fq, lds, wid, lane); S.done(cur); }
#undef PG8_SA
#undef PG8_SB
#undef PG8_STAGE
#undef PG8_LDA
#undef PG8_LDB
#undef PG8_MMA
#undef PG8_WAIT_V
#undef PG8_WAIT_L
#undef PG8_BAR
#undef PG8_SCHED
}
}

constexpr size_t MiB = 1u << 20;
constexpr size_t WS_CTL = 0, CTL_ZERO_BYTES = 1 * MiB;
constexpr size_t WS_MOD = 1 * MiB;
constexpr size_t WS_S5T = 4 * MiB;
constexpr size_t WS_LSE = 8 * MiB;
constexpr size_t WS_RAW = 12 * MiB;
constexpr size_t W_AIN_B = (size_t)AIN * DP * 2, W_DD_B = (size_t)D * DP * 2, W_UP_B = (size_t)FF2 * DP * 2, W_DN_B = (size_t)D * FFP * 2;
constexpr size_t WS_WAIN = 40 * MiB, WS_WAOUT = WS_WAIN + 2 * W_AIN_B, WS_WSIN = WS_WAOUT + 2 * W_DD_B, WS_WSGATE = WS_WSIN + 2 * W_DD_B, WS_WSOUT = WS_WSGATE + 2 * W_DD_B, WS_WUP = WS_WSOUT + 2 * W_DD_B, WS_WDOWN = WS_WUP + 4 * W_UP_B;
constexpr size_t WS_H = 492 * MiB;
constexpr size_t WS_BIG = 624 * MiB;
constexpr size_t WS_END = 1520 * MiB;
static_assert(WS_WDOWN + 4 * W_DN_B <= WS_H && WS_H + (size_t)M * DP * 2 <= WS_BIG && WS_BIG + (size_t)M * AIN * 2 <= WS_END && (size_t)M * FFP * 2 <= 512 * MiB && WS_RAW + (size_t)(M / 256) * 4 * FF2 * 4 <= WS_WAIN, "d_ws map");
constexpr int S5T_WORDS = 2304;
constexpr int CW_BAR = 4096;
constexpr int RING_OFF = 0, RING_BYTES = 131072;
constexpr int LDSCTL_OFF = RING_BYTES, MISC_OFF = LDSCTL_OFF + 320;
constexpr int EXCH_OFF = RING_BYTES + 1024;
constexpr int LDS_BYTES = 147456;
static_assert(EXCH_OFF + 8192 <= LDS_BYTES && MISC_OFF + 128 <= EXCH_OFF, "LDS map");
constexpr int NWAVES = 8;

#define LAS __attribute__((address_space(3)))
typedef unsigned short bf16;
typedef float f32x4 __attribute__((ext_vector_type(4)));
typedef float f32x2 __attribute__((ext_vector_type(2)));
typedef short bf16x8 __attribute__((ext_vector_type(8)));
typedef short s16x4 __attribute__((ext_vector_type(4)));
typedef unsigned u32x4 __attribute__((ext_vector_type(4)));
typedef unsigned u32x2 __attribute__((ext_vector_type(2)));
#define LDS_WAIT() asm volatile("s_waitcnt lgkmcnt(0)" ::: "memory")
#define VM_WAIT() asm volatile("s_waitcnt vmcnt(0)" ::: "memory")
__device__ __forceinline__ unsigned f2bf(float f) { unsigned u = __builtin_bit_cast(unsigned, f); return (u + 0x7fffu + ((u >> 16) & 1u)) >> 16; }
__device__ __forceinline__ unsigned pk2(float lo, float hi) { return f2bf(lo) | (f2bf(hi) << 16); }
using pg8::cvt_pk_bf16; using pg8::bf_lo; using pg8::bf_hi;

#define XB_TMO      128
#define XB_XCNT(j)  (256  + 64 * (j))
#define XB_XSUB(j)  (1280 + 64 * (j))
#define XB_XGEN(j)  (2304 + 64 * (j))
#define XB_TOP      3328
#define XB_TOPGEN   3392
#define XCD_BAR_WORDS 3456
#define XB_SPIN_CAP (1u << 18)

__device__ __forceinline__ unsigned xb_ld(unsigned* p)              { return __hip_atomic_load(p, __ATOMIC_RELAXED, __HIP_MEMORY_SCOPE_AGENT); }
__device__ __forceinline__ unsigned xb_add(unsigned* p, unsigned v) { return __hip_atomic_fetch_add(p, v, __ATOMIC_RELAXED, __HIP_MEMORY_SCOPE_AGENT); }
__device__ __forceinline__ unsigned xb_xcc_id() { return (unsigned)__builtin_amdgcn_s_getreg((3 << 11) | 20) & 0xFu; }
#define XB_SPIN(cond, bar) do { unsigned _sp = 0; while (cond) { __builtin_amdgcn_s_sleep(1); \
    if ((++_sp & 255u) == 0u) { if (xb_ld(&(bar)[XB_TMO])) break; if (_sp > XB_SPIN_CAP) { atomicAdd(&(bar)[XB_TMO], 1u); break; } } } } while (0)

struct XcdBarrier {
    unsigned* bar; unsigned x;
    volatile LAS unsigned* st;
};

__device__ __forceinline__ XcdBarrier xcd_barrier_post(unsigned* bar, volatile LAS unsigned* st) {
    XcdBarrier b; b.bar = bar; b.x = xb_xcc_id(); b.st = st;
    if (threadIdx.x == 0) (void)xb_add(&bar[XB_XCNT(b.x)], 1u);
    return b;
}
__device__ __forceinline__ void xcd_barrier_complete(unsigned* bar, unsigned x, unsigned& nloc, unsigned& nx) {
    const unsigned G = gridDim.x * gridDim.y * gridDim.z;
    unsigned sum, cnt, mine, sp = 0u;
    for (;;) {
        sum = 0u; cnt = 0u; mine = 0u;
#pragma unroll
        for (unsigned j = 0; j < 16; ++j) { const unsigned c = xb_ld(&bar[XB_XCNT(j)]); sum += c; cnt += (c > 0u) ? 1u : 0u; mine = (j == x) ? c : mine; }
        if (sum == G) break;
        __builtin_amdgcn_s_sleep(1);
        if ((++sp & 255u) == 0u) { if (xb_ld(&bar[XB_TMO])) break; if (sp > XB_SPIN_CAP) { atomicAdd(&bar[XB_TMO], 1u); break; } }
    }
    nloc = mine > 0u ? mine : 1u; nx = cnt > 0u ? cnt : 1u;
}

__device__ __forceinline__ void xcd_barrier(const XcdBarrier& b) {
    asm volatile("s_waitcnt vmcnt(0)" ::: "memory");
    __syncthreads();
    if (threadIdx.x == 0) {
        unsigned* bar = b.bar;
        __builtin_amdgcn_s_waitcnt(0);
        unsigned nloc = b.st[0], nx = b.st[1];
        if (nloc == 0u) { xcd_barrier_complete(bar, b.x, nloc, nx); b.st[0] = nloc; b.st[1] = nx; }
        const unsigned old = xb_add(&bar[XB_XSUB(b.x)], 1u);
        const unsigned gen = old / nloc;
        if (old + 1u == (gen + 1u) * nloc) {
            __builtin_amdgcn_fence(__ATOMIC_RELEASE, "agent");
            asm volatile("s_waitcnt vmcnt(0)" ::: "memory");
            const unsigned og = xb_add(&bar[XB_TOP], 1u);
            const unsigned tg = og / nx;
            if (og + 1u == (tg + 1u) * nx) xb_add(&bar[XB_TOPGEN], 1u);
            else XB_SPIN(xb_ld(&bar[XB_TOPGEN]) == tg, bar);
            __builtin_amdgcn_fence(__ATOMIC_ACQUIRE, "agent");
            xb_add(&bar[XB_XGEN(b.x)], 1u);
            asm volatile("s_waitcnt vmcnt(0)" ::: "memory");
        } else {
            XB_SPIN(xb_ld(&bar[XB_XGEN(b.x)]) == gen, bar);
            __builtin_amdgcn_fence(__ATOMIC_ACQUIRE, "agent");
            asm volatile("s_waitcnt vmcnt(0)" ::: "memory");
        }
    }
    __syncthreads();
}

struct Frame {
    LAS unsigned char* lds;
    volatile LAS unsigned* MISC;
    unsigned* ctl;
    int tid, lane, wave;
    int vcu, G;
    unsigned char* ws; float* out;
};
__device__ __forceinline__ void frame_refresh(Frame& F, unsigned char* ws, float* out) {
    size_t z = 0; asm volatile("" : "+s"(z));
    F.ws = ws + z; F.out = out + z; F.ctl = (unsigned*)(F.ws + WS_CTL);
    F.tid = pg8::opaque_tid(); F.lane = F.tid & 63; F.wave = __builtin_amdgcn_readfirstlane(F.tid >> 6);
    const int bx = pg8::opaque_bid(); F.vcu = (F.G % 8 == 0) ? (bx % 8) * (F.G / 8) + bx / 8 : bx;
}
template <int CTRL> __device__ __forceinline__ float dpp_mov(float v) { return __int_as_float(__builtin_amdgcn_mov_dpp(__float_as_int(v), CTRL, 0xf, 0xf, true)); }
__device__ __forceinline__ float wave_sum(float v) {
    v += dpp_mov<0xB1>(v);
    v += dpp_mov<0x4E>(v);
    v += dpp_mov<0x141>(v);
    v += dpp_mov<0x140>(v);
    const float s0 = __int_as_float(__builtin_amdgcn_readlane(__float_as_int(v), 0)), s1 = __int_as_float(__builtin_amdgcn_readlane(__float_as_int(v), 16));
    const float s2 = __int_as_float(__builtin_amdgcn_readlane(__float_as_int(v), 32)), s3 = __int_as_float(__builtin_amdgcn_readlane(__float_as_int(v), 48));
    return (s0 + s1) + (s2 + s3);
}
__device__ __forceinline__ float xrow_max(float v) {
    { const auto r = __builtin_amdgcn_permlane16_swap(__float_as_uint(v), __float_as_uint(v), false, false); v = fmaxf(__uint_as_float(r[0]), __uint_as_float(r[1])); }
    { const auto r = __builtin_amdgcn_permlane32_swap(__float_as_uint(v), __float_as_uint(v), false, false); v = fmaxf(__uint_as_float(r[0]), __uint_as_float(r[1])); }
    return v;
}
__device__ __forceinline__ float xrow_sum(float v) {
    { const auto r = __builtin_amdgcn_permlane16_swap(__float_as_uint(v), __float_as_uint(v), false, false); v = __uint_as_float(r[0]) + __uint_as_float(r[1]); }
    { const auto r = __builtin_amdgcn_permlane32_swap(__float_as_uint(v), __float_as_uint(v), false, false); v = __uint_as_float(r[0]) + __uint_as_float(r[1]); }
    return v;
}

__device__ __forceinline__ void p0_transpose_item(const float* W, int K, int N, bf16* WT, int k0, int n0, int dst_row0, LAS float* scr, int lane) {
#pragma unroll 8
    for (int i = 0; i < 32; ++i) { const int kk = 2 * i + (lane >> 5); scr[kk * 33 + (lane & 31)] = W[(size_t)(k0 + kk) * N + n0 + (lane & 31)]; }
    LDS_WAIT(); asm volatile("" ::: "memory");
    const int c = lane & 7;
#pragma unroll
    for (int j = 0; j < 4; ++j) { const int n = (lane >> 3) + 8 * j; const LAS float* s = scr + (8 * c) * 33 + n;
        u32x4 o; o.x = pk2(s[0 * 33], s[1 * 33]); o.y = pk2(s[2 * 33], s[3 * 33]); o.z = pk2(s[4 * 33], s[5 * 33]); o.w = pk2(s[6 * 33], s[7 * 33]);
        *(u32x4*)(WT + (size_t)(dst_row0 + n) * (K + KPAD) + k0 + 8 * c) = o; }
    LDS_WAIT(); asm volatile("" ::: "memory");
}
struct P0In { const float *c, *ada_w, *ada_b, *attn_w_in, *attn_w_out, *ssm_w_in, *log_step, *a_re, *a_im, *b_re, *b_im, *c_re, *c_im, *ssm_w_gate, *ssm_w_out, *ffn_w_up, *ffn_w_down; };

__device__ __forceinline__ void p0_ada_unit(Frame& F, const P0In& in, int unit) {
    LAS float* csl = (LAS float*)(F.lds + RING_OFF);
    for (int idx = F.tid; idx < BATCH * D; idx += NWAVES * 64) { const int b = idx / D, k = idx % D; const float v = in.c[idx]; csl[k * 16 + b] = v / (1.0f + __expf(-v)); }
    __syncthreads();
    const int li = unit >> 6, c0 = (unit & 63) * 192 + F.lane;
    const float* W = in.ada_w + (size_t)li * D * MODW + c0;
    float acc[3][16];
#pragma unroll
    for (int c = 0; c < 3; ++c)
#pragma unroll
        for (int b = 0; b < 16; ++b) acc[c][b] = 0.f;
    const int kbeg = F.wave * 256;
#pragma unroll 4
    for (int k = kbeg; k < kbeg + 256; ++k) {
        const float w0 = W[(size_t)k * MODW], w1 = W[(size_t)k * MODW + 64], w2 = W[(size_t)k * MODW + 128];
        const LAS f32x4* cp = (const LAS f32x4*)(csl + k * 16);
        const f32x4 s0 = cp[0], s1 = cp[1], s2 = cp[2], s3 = cp[3];
        const float cs[16] = {s0[0], s0[1], s0[2], s0[3], s1[0], s1[1], s1[2], s1[3], s2[0], s2[1], s2[2], s2[3], s3[0], s3[1], s3[2], s3[3]};
#pragma unroll
        for (int b = 0; b < 16; ++b) { acc[0][b] += w0 * cs[b]; acc[1][b] += w1 * cs[b]; acc[2][b] += w2 * cs[b]; }
    }
    __syncthreads();
    LAS float* part = (LAS float*)(F.lds + RING_OFF);
#pragma unroll
    for (int c = 0; c < 3; ++c)
#pragma unroll
        for (int b = 0; b < 16; ++b) part[(F.wave * 16 + b) * 192 + c * 64 + F.lane] = acc[c][b];
    __syncthreads();
    float* mod = (float*)(F.ws + WS_MOD);
    for (int o = F.tid; o < 16 * 192; o += NWAVES * 64) { const int b = o / 192, cc = o % 192; float s = 0.f;
#pragma unroll
        for (int w = 0; w < 8; ++w) s += part[(w * 16 + b) * 192 + cc];
        const int n = (unit & 63) * 192 + cc; mod[((size_t)li * BATCH + b) * MODW + n] = s + in.ada_b[(size_t)li * MODW + n]; }
    __syncthreads();
}
__device__ __forceinline__ void s5_coef(const P0In& in, int jg, int p, float& lbr, float& lbi, float& cfr, float& cfi) {
    const float step = __expf(in.log_step[jg]);
    const float lr = in.a_re[(size_t)jg * SP + p], li = in.a_im[(size_t)jg * SP + p];
    const float mag = expf(lr * step), ang = li * step;
    lbr = mag * cosf(ang); lbi = mag * sinf(ang);
    const float nr = lbr - 1.0f, ni = lbi, den = lr * lr + li * li;
    cfr = (nr * lr + ni * li) / den; cfi = (ni * lr - nr * li) / den;
}
__device__ __forceinline__ void p0_s5_tables(Frame& F, const P0In& in, int jg) {
    unsigned* tab = (unsigned*)(F.ws + WS_S5T) + (size_t)jg * S5T_WORDS;
    const int t = F.tid;
    if (t < 64) {
        float lbr, lbi, cfr, cfi; s5_coef(in, jg, t, lbr, lbi, cfr, cfi);
        float ar = lbr, ai = lbi;
#pragma unroll
        for (int s = 0; s < 7; ++s) { const float nr = ar * ar - ai * ai, ni = 2.0f * ar * ai; ar = nr; ai = ni; }
        tab[t] = __float_as_uint(lbr); tab[64 + t] = __float_as_uint(lbi); tab[128 + t] = __float_as_uint(ar); tab[192 + t] = __float_as_uint(ai);
    }
    {
        const int tau = t >> 6, lane = t & 63, q = tau >> 1, part = tau & 1, p = 16 * q + (lane & 15), c0 = 4 * (lane >> 4);
        float lbr, lbi, cfr, cfi; s5_coef(in, jg, p, lbr, lbi, cfr, cfi);
        const float* br = in.b_re + ((size_t)jg * SP + p) * SG + c0; const float* bi = in.b_im + ((size_t)jg * SP + p) * SG + c0;
        float v[4];
#pragma unroll
        for (int j = 0; j < 4; ++j) v[j] = part ? (cfr * bi[j] + cfi * br[j]) : (cfr * br[j] - cfi * bi[j]);
        tab[256 + (tau * 64 + lane) * 2 + 0] = pk2(v[0], v[1]); tab[256 + (tau * 64 + lane) * 2 + 1] = pk2(v[2], v[3]);
    }
    if (t < 256) {
        const int q = t >> 6, lane = t & 63, c = lane & 15, g4 = lane >> 4;
        const float* cr = in.c_re + ((size_t)jg * SG + c) * SP + 16 * q + 4 * g4; const float* ci = in.c_im + ((size_t)jg * SG + c) * SP + 16 * q + 4 * g4;
        unsigned* o = tab + 1280 + (q * 64 + lane) * 4;
        o[0] = pk2(cr[0], cr[1]); o[1] = pk2(cr[2], cr[3]); o[2] = pk2(-ci[0], -ci[1]); o[3] = pk2(-ci[2], -ci[3]);
    }
}
__device__ __forceinline__ void p0_prologue(Frame& F, const P0In& in) {
    for (int u = F.vcu; u < 256; u += F.G) p0_ada_unit(F, in, u);
    for (int u = F.vcu; u < 2 * NG; u += F.G) p0_s5_tables(F, in, u);
    LAS float* scr = (LAS float*)(F.lds + RING_OFF + F.wave * 16384);
    const int gw = F.vcu * NWAVES + F.wave, NGW = F.G * NWAVES;
    constexpr int I_AIN = (D / 64) * (AIN / 32), I_DD = (D / 64) * (D / 32), I_UP = (D / 64) * (FF2 / 32), I_DN = (FF / 64) * (D / 32);
    constexpr int C0 = 2 * I_AIN, C1 = C0 + 2 * I_DD, C2 = C1 + 2 * I_DD, C3 = C2 + 2 * I_DD, C4 = C3 + 2 * I_DD, C5 = C4 + 4 * I_UP, C6 = C5 + 4 * I_DN;
    for (int it = gw; it < C6; it += NGW) {
        const float* W; bf16* WT; int K, N, r; bool up = false;
        if (it < C0)      { r = it;      const int j = r / I_AIN; r -= j * I_AIN; K = D; N = AIN; W = in.attn_w_in + (size_t)j * D * AIN;  WT = (bf16*)(F.ws + WS_WAIN + j * W_AIN_B); }
        else if (it < C1) { r = it - C0; const int j = r / I_DD;  r -= j * I_DD;  K = D; N = D;   W = in.attn_w_out + (size_t)j * D * D;   WT = (bf16*)(F.ws + WS_WAOUT + j * W_DD_B); }
        else if (it < C2) { r = it - C1; const int j = r / I_DD;  r -= j * I_DD;  K = D; N = D;   W = in.ssm_w_in + (size_t)j * D * D;     WT = (bf16*)(F.ws + WS_WSIN + j * W_DD_B); }
        else if (it < C3) { r = it - C2; const int j = r / I_DD;  r -= j * I_DD;  K = D; N = D;   W = in.ssm_w_gate + (size_t)j * D * D;   WT = (bf16*)(F.ws + WS_WSGATE + j * W_DD_B); }
        else if (it < C4) { r = it - C3; const int j = r / I_DD;  r -= j * I_DD;  K = D; N = D;   W = in.ssm_w_out + (size_t)j * D * D;    WT = (bf16*)(F.ws + WS_WSOUT + j * W_DD_B); }
        else if (it < C5) { r = it - C4; const int j = r / I_UP;  r -= j * I_UP;  K = D; N = FF2; W = in.ffn_w_up + (size_t)j * D * FF2;   WT = (bf16*)(F.ws + WS_WUP + j * W_UP_B); up = true; }
        else              { r = it - C5; const int j = r / I_DN;  r -= j * I_DN;  K = FF; N = D;  W = in.ffn_w_down + (size_t)j * FF * D;  WT = (bf16*)(F.ws + WS_WDOWN + j * W_DN_B); }
        const int nblk = N / 32, kb = r / nblk, nb = r % nblk, n0 = 32 * nb;
        int drow = n0;
        if (up) { const int half = n0 >= FF ? 1 : 0, nn = n0 - half * FF; drow = 256 * (nn >> 7) + 128 * half + (nn & 127); }
        p0_transpose_item(W, K, N, WT, 64 * kb, n0, drow, scr, F.lane);
    }
}

__device__ __forceinline__ void norm_mod_phase(Frame& F, const float* xin, bf16* hout, const float* gain, const float* modl, int sh_off, int sc_off) {
    const int gw = F.vcu * NWAVES + F.wave, NGW = F.G * NWAVES;
    for (int blk = gw; blk < M / 16; blk += NGW) {
        const int row0 = blk * 16, b = row0 / T;
        f32x4 A[8], Bv[8];
#pragma unroll
        for (int j = 0; j < 8; ++j) { const int col = 4 * F.lane + 256 * j;
            const f32x4 g = *(const f32x4*)(gain + col), sc = *(const f32x4*)(modl + (size_t)b * MODW + sc_off + col);
            A[j] = g * (sc + 1.0f); Bv[j] = *(const f32x4*)(modl + (size_t)b * MODW + sh_off + col); }
        f32x4 cur[8], nxt[8];
#pragma unroll
        for (int j = 0; j < 8; ++j) cur[j] = *(const f32x4*)(xin + (size_t)row0 * D + 4 * F.lane + 256 * j);
        for (int r = 0; r < 16; ++r) {
            const int rn = (r + 1 < 16) ? r + 1 : r;
#pragma unroll
            for (int j = 0; j < 8; ++j) nxt[j] = *(const f32x4*)(xin + (size_t)(row0 + rn) * D + 4 * F.lane + 256 * j);
            float ss = 0.f;
#pragma unroll
            for (int j = 0; j < 8; ++j) ss += (cur[j][0] * cur[j][0] + cur[j][1] * cur[j][1]) + (cur[j][2] * cur[j][2] + cur[j][3] * cur[j][3]);
            const float rstd = __builtin_amdgcn_rsqf(wave_sum(ss) * (1.0f / D) + EPS);
            unsigned long long* o8 = (unsigned long long*)(hout + (size_t)(row0 + r) * DP) + F.lane;
#pragma unroll
            for (int j = 0; j < 8; ++j) { const f32x4 v = cur[j] * rstd * A[j] + Bv[j];
                o8[64 * j] = (unsigned long long)cvt_pk_bf16(v[0], v[1]) | ((unsigned long long)cvt_pk_bf16(v[2], v[3]) << 32); }
#pragma unroll
            for (int j = 0; j < 8; ++j) cur[j] = nxt[j];
        }
    }
}
__device__ __forceinline__ void final_norm_phase(Frame& F, const float* xin, float* out, const float* gain) {
    const int gw = F.vcu * NWAVES + F.wave, NGW = F.G * NWAVES;
    f32x4 A[8];
#pragma unroll
    for (int j = 0; j < 8; ++j) A[j] = *(const f32x4*)(gain + 4 * F.lane + 256 * j);
    for (int blk = gw; blk < M / 16; blk += NGW) {
        const int row0 = blk * 16;
        for (int r = 0; r < 16; ++r) {
            f32x4 cur[8];
#pragma unroll
            for (int j = 0; j < 8; ++j) cur[j] = *(const f32x4*)(xin + (size_t)(row0 + r) * D + 4 * F.lane + 256 * j);
            float ss = 0.f;
#pragma unroll
            for (int j = 0; j < 8; ++j) ss += (cur[j][0] * cur[j][0] + cur[j][1] * cur[j][1]) + (cur[j][2] * cur[j][2] + cur[j][3] * cur[j][3]);
            const float rstd = __builtin_amdgcn_rsqf(wave_sum(ss) * (1.0f / D) + EPS);
#pragma unroll
            for (int j = 0; j < 8; ++j) *(f32x4*)(out + (size_t)(row0 + r) * D + 4 * F.lane + 256 * j) = cur[j] * rstd * A[j];
        }
    }
}

__device__ __forceinline__ void conv_fix_phase(Frame& F, const float* raw, bf16* aout, const float* cw, const float* cb) {
    const int gt = (F.vcu * NWAVES + F.wave) * 64 + F.lane, NT = F.G * NWAVES * 64;
    constexpr int C4 = FF / 4, NITEM = 112 * 2 * C4;
    for (int it = gt; it < NITEM; it += NT) {
        const int c4 = it % C4, rr = (it / C4) & 1, bi = it / (2 * C4), pm = (bi / 7) * 8 + 1 + (bi % 7), gc = 4 * c4;
        const float* r_m2 = raw + ((size_t)(pm - 1) * 4 + 2) * FF2; const float* r_m1 = raw + ((size_t)(pm - 1) * 4 + 3) * FF2;
        const float* r_0 = raw + ((size_t)pm * 4 + 0) * FF2;       const float* r_1 = raw + ((size_t)pm * 4 + 1) * FF2;
        const float* pc = rr ? r_1 : r_0; const float* p1 = rr ? r_0 : r_m1; const float* p2 = rr ? r_m1 : r_m2;
        float o[4];
        const f32x4 cg = *(const f32x4*)(pc + gc), g1 = *(const f32x4*)(p1 + gc), g2 = *(const f32x4*)(p2 + gc);
        const f32x4 cu = *(const f32x4*)(pc + FF + gc), u1 = *(const f32x4*)(p1 + FF + gc), u2 = *(const f32x4*)(p2 + FF + gc);
        const f32x4 wg0 = *(const f32x4*)(cw + gc), wg1 = *(const f32x4*)(cw + FF2 + gc), wg2 = *(const f32x4*)(cw + 2 * FF2 + gc), bg = *(const f32x4*)(cb + gc);
        const f32x4 wu0 = *(const f32x4*)(cw + FF + gc), wu1 = *(const f32x4*)(cw + FF2 + FF + gc), wu2 = *(const f32x4*)(cw + 2 * FF2 + FF + gc), bu = *(const f32x4*)(cb + FF + gc);
#pragma unroll
        for (int e = 0; e < 4; ++e) { const float gg = bg[e] + wg2[e] * cg[e] + wg1[e] * g1[e] + wg0[e] * g2[e], uu = bu[e] + wu2[e] * cu[e] + wu1[e] * u1[e] + wu0[e] * u2[e];
            o[e] = gg * pg8::fast_sigmoid(gg) * uu; }
        u32x2 w; w.x = cvt_pk_bf16(o[0], o[1]); w.y = cvt_pk_bf16(o[2], o[3]);
        *(u32x2*)(aout + (size_t)(pm * 256 + rr) * FFP + gc) = w;
    }
}

namespace att {
constexpr int SLOT = 32768, K_OFF = 0, V_OFF = 65536;
__device__ __forceinline__ int kswz(int row, int colB) { return row * 256 + (colB ^ ((row & 15) << 4)); }
__device__ __forceinline__ int vperm(int k) { return (k & ~0xC) | ((k & 4) << 1) | ((k & 8) >> 1); }
__device__ __forceinline__ int voff(int row, int ch) { return 256 * row + 16 * (ch ^ (((row & 3) << 2) | ((row >> 2) & 3))); }
__device__ __forceinline__ s16x4 tr_read(int addr) { s16x4 r; asm volatile("ds_read_b64_tr_b16 %0, %1" : "=&v"(r) : "v"(addr) : "memory"); return r; }
struct Stg { u32x4 k[4], v[4]; };
}
template <bool SAME>
__device__ __forceinline__ void attn_phase(Frame& F, bf16* proj, bf16* obuf, float* lse) {
    using namespace att;
    const int w = F.wave;
    for (int unit = F.vcu; unit < BATCH * NH; unit += F.G) {
        const int b = SAME ? 0 : unit >> 4, h = SAME ? 0 : unit & 15;
        bf16* qbase = proj + (size_t)(SAME ? 0 : unit) * 3 * T * HD; const bf16* kbase = proj + pg8::QK_PART + (size_t)(SAME ? 0 : unit) * 3 * T * HD; const bf16* vbase = proj + 2 * pg8::QK_PART + (size_t)(SAME ? 0 : unit) * T * HD;
        const float c1 = 0.08838834764831845f * 1.4426950408889634f;
        const float slope2 = exp2f(-0.5f * (float)(h + 1)) * 1.4426950408889634f;
        Stg st;
        bf16x8 qn[4];
        int tid = F.tid;
#define ATT_LANE() asm volatile("" : "+v"(tid)); const int lane = tid & 63, q16 = lane & 15, g4 = lane >> 4, skey = tid >> 4, sch = tid & 15
#define ATT_DECODE(bu_, grp, dil, cls, n) const int bux_ = SAME ? 33 : (bu_); const int grp = 2 - ((bux_) >> 4), dil = 1 << (2 * grp), nbk = 16 >> (2 * grp), cls = ((bux_) & 15) / nbk, n = ((bux_) & 15) % nbk
#define ATT_LOAD(bu) do { ATT_DECODE(bu, grp_, dil_, cls_, n_); const bf16* kb_ = kbase + (size_t)grp_ * T * HD + (size_t)(cls_ * (T >> (2 * grp_)) + 128 * n_) * HD + sch * 8; \
            _Pragma("unroll") for (int i = 0; i < 4; ++i) { const int key_ = skey + 32 * i; \
            st.k[i] = *(const u32x4*)(kb_ + (size_t)key_ * HD); st.v[i] = *(const u32x4*)(vbase + (size_t)((128 * n_ + key_) * dil_ + cls_) * HD + sch * 8); } } while (0)
#define ATT_QLOAD(bu) do { ATT_DECODE(bu, grp_, dil_, cls_, n_); (void)dil_; const bf16* qq_ = qbase + ((size_t)grp_ * T + cls_ * (T >> (2 * grp_)) + 128 * n_ + 16 * w + q16) * HD + 8 * g4; \
            _Pragma("unroll") for (int ks = 0; ks < 4; ++ks) qn[ks] = *(const bf16x8*)(qq_ + 32 * ks); } while (0)
#define ATT_WRITE(slot) do { _Pragma("unroll") for (int i = 0; i < 4; ++i) { const int key_ = skey + 32 * i; \
            *(LAS u32x4*)(F.lds + K_OFF + (slot) * SLOT + kswz(key_, sch * 16)) = st.k[i]; *(LAS u32x4*)(F.lds + V_OFF + (slot) * SLOT + voff(vperm(key_), sch)) = st.v[i]; } } while (0)
        { ATT_LANE(); (void)q16; (void)g4; (void)lane;
        ATT_LOAD(0); ATT_QLOAD(0);
        { unsigned z0 = 0u; asm volatile("" : "+v"(z0));
          for (int i = tid; i < SLOT / 16; i += NWAVES * 64) *(LAS u32x4*)(F.lds + V_OFF + SLOT + i * 16) = (u32x4){z0, z0, z0, z0}; }
        ATT_WRITE(0); }
        __syncthreads();
        for (int bu = 0; bu < 48; ++bu) {
            ATT_LANE();
            ATT_DECODE(bu, grp, dil, cls, n);
            const int cur = bu & 1, prev = cur ^ 1;
            const int cpq = 128 * n + 16 * w + q16;
            const size_t rowq = (size_t)b * T + (size_t)cpq * dil + cls;
            bf16* qp = qbase + ((size_t)grp * T + cls * (T >> (2 * grp)) + cpq) * HD;
            bf16x8 qf[4];
#pragma unroll
            for (int ks = 0; ks < 4; ++ks) qf[ks] = qn[ks];
            if (bu + 1 < 48) { ATT_LOAD(bu + 1); ATT_QLOAD(bu + 1); }
            u32x2 a1[8], a2[8]; float l1 = 0.f, l2 = 0.f;
            if (grp == 0) {
                const int tq = cpq;
                const bf16* o1p = qbase + ((size_t)1 * T + (tq & 3) * (T >> 2) + (tq >> 2)) * HD + 4 * g4; const bf16* o2p = qbase + ((size_t)2 * T + (tq & 15) * (T >> 4) + (tq >> 4)) * HD + 4 * g4;
#pragma unroll
                for (int dt = 0; dt < 8; ++dt) { a1[dt] = *(const u32x2*)(o1p + 16 * dt); a2[dt] = *(const u32x2*)(o2p + 16 * dt); }
                l1 = lse[((size_t)0 * M + rowq) * NH + h]; l2 = lse[((size_t)1 * M + rowq) * NH + h];
            }
            f32x4 s[9];
            int kx[4];
#pragma unroll
            for (int ks = 0; ks < 4; ++ks) kx[ks] = q16 * 256 + ((64 * ks + 16 * g4) ^ (q16 << 4));
            const int ring0 = prev * SLOT;
#pragma unroll
            for (int t = 0; t < 9; ++t) { const int base = K_OFF + (((w + t) * 4096 + ring0) & 0xFFFF);
                s[t] = (f32x4){0.f, 0.f, 0.f, 0.f};
#pragma unroll
                for (int ks = 0; ks < 4; ++ks) { const bf16x8 kf = *(const LAS bf16x8*)(F.lds + base + kx[ks]); s[t] = __builtin_amdgcn_mfma_f32_16x16x32_bf16(kf, qf[ks], s[t], 0, 0, 0); }
                if (t & 1) __builtin_amdgcn_sched_barrier(0); }
            const float c2 = slope2 * (float)dil;
            const int basei = q16 - 4 * g4; const float nb = -c2 * (float)basei;
            float mx = -__builtin_inff();
#pragma unroll
            for (int t = 0; t < 9; ++t) {
                if ((n > 0) || (t >= 8 - w)) {
#pragma unroll
                    for (int i = 0; i < 4; ++i) { float z = __builtin_fmaf(-c2, (float)(128 - 16 * t - i), __builtin_fmaf(s[t][i], c1, nb));
                        if (t == 0) z = (basei <= i) ? z : -__builtin_inff();
                        if (t == 8) z = (basei >= i) ? z : -__builtin_inff();
                        s[t][i] = z; mx = fmaxf(mx, z); }
                } else { s[t] = (f32x4){-__builtin_inff(), -__builtin_inff(), -__builtin_inff(), -__builtin_inff()}; }
            }
            mx = xrow_max(mx);
            float l = 0.f;
            u32x2 pp[10];
#pragma unroll
            for (int t = 0; t < 9; ++t) { float p[4];
#pragma unroll
                for (int i = 0; i < 4; ++i) { p[i] = __builtin_amdgcn_exp2f(s[t][i] - mx); l += p[i]; }
                pp[t].x = cvt_pk_bf16(p[0], p[1]); pp[t].y = cvt_pk_bf16(p[2], p[3]); }
            pp[9].x = 0u; pp[9].y = 0u;
            l = xrow_sum(l);
            f32x4 o[8];
#pragma unroll
            for (int dt = 0; dt < 8; ++dt) o[dt] = (f32x4){0.f, 0.f, 0.f, 0.f};
            const int lq = (lane >> 2) & 3, lp = lane & 3;
            const int vmask = (lq << 2) | (2 * (g4 & 1) + (g4 >> 1));
            const int vlane = 256 * (8 * (g4 & 1) + 4 * (g4 >> 1) + lq) + 8 * (lp & 1), vpart = ((lp >> 1) ^ vmask) << 4;
            struct VB { s16x4 va[4], vb[4]; } vb0, vb1;
#define PV_READ(B, g) do { const int pr_ = (g) >> 1, dh_ = (g) & 1, ta_ = 2 * pr_, tb_ = (pr_ < 4) ? 2 * pr_ + 1 : 2 * pr_; \
                const int ba_ = V_OFF + (((w + ta_) * 4096 + ring0) & 0xFFFF) + vlane, bb_ = V_OFF + (((w + tb_) * 4096 + ring0) & 0xFFFF) + vlane; \
                _Pragma("unroll") for (int d = 0; d < 4; ++d) { const int dt_ = 4 * dh_ + d; B.va[d] = tr_read(ba_ + (vpart ^ (dt_ << 5))); B.vb[d] = tr_read(bb_ + (vpart ^ (dt_ << 5))); } } while (0)
#define PV_MMA(B, g) do { const int pr_ = (g) >> 1, dh_ = (g) & 1; u32x4 pw_; pw_.x = pp[2 * pr_].x; pw_.y = pp[2 * pr_].y; pw_.z = pp[2 * pr_ + 1].x; pw_.w = pp[2 * pr_ + 1].y; \
                const bf16x8 pa_ = __builtin_bit_cast(bf16x8, pw_); \
                _Pragma("unroll") for (int d = 0; d < 4; ++d) { const int dt_ = 4 * dh_ + d; const bf16x8 vf_ = (bf16x8){B.va[d][0], B.va[d][1], B.va[d][2], B.va[d][3], B.vb[d][0], B.vb[d][1], B.vb[d][2], B.vb[d][3]}; \
                    o[dt_] = __builtin_amdgcn_mfma_f32_16x16x32_bf16(vf_, pa_, o[dt_], 0, 0, 0); } } while (0)
#define PV_STEP(BC, BN, g) do { PV_READ(BN, (g) + 1); asm volatile("s_waitcnt lgkmcnt(8)" ::: "memory"); __builtin_amdgcn_sched_barrier(0); PV_MMA(BC, g); __builtin_amdgcn_sched_barrier(0); } while (0)
            asm volatile("s_waitcnt lgkmcnt(0)" ::: "memory"); __builtin_amdgcn_sched_barrier(0);
            PV_READ(vb0, 0);
            PV_STEP(vb0, vb1, 0); PV_STEP(vb1, vb0, 1); PV_STEP(vb0, vb1, 2); PV_STEP(vb1, vb0, 3); PV_STEP(vb0, vb1, 4); PV_STEP(vb1, vb0, 5); PV_STEP(vb0, vb1, 6); PV_STEP(vb1, vb0, 7); PV_STEP(vb0, vb1, 8);
            asm volatile("s_waitcnt lgkmcnt(0)" ::: "memory"); __builtin_amdgcn_sched_barrier(0); PV_MMA(vb1, 9); __builtin_amdgcn_sched_barrier(0);
#undef PV_READ
#undef PV_MMA
#undef PV_STEP
            const float inv = 1.0f / l, lse2 = mx + __builtin_amdgcn_logf(l);
            if (grp > 0) {
#pragma unroll
                for (int dt = 0; dt < 8; ++dt) { u32x2 wv; wv.x = cvt_pk_bf16(o[dt][0] * inv, o[dt][1] * inv); wv.y = cvt_pk_bf16(o[dt][2] * inv, o[dt][3] * inv);
                    *(u32x2*)(qp + 16 * dt + 4 * g4) = wv; }
                if (g4 == 0) lse[((size_t)(grp - 1) * M + rowq) * NH + h] = lse2;
            } else {
                const float mm = fmaxf(lse2, fmaxf(l1, l2));
                float w0 = __builtin_amdgcn_exp2f(lse2 - mm), w1 = __builtin_amdgcn_exp2f(l1 - mm), w2 = __builtin_amdgcn_exp2f(l2 - mm);
                const float wi = 1.0f / (w0 + w1 + w2); w0 *= wi * inv; w1 *= wi; w2 *= wi;
                bf16* op = obuf + rowq * DP + h * HD;
#pragma unroll
                for (int dt = 0; dt < 8; ++dt) {
                    const float r0 = w0 * o[dt][0] + w1 * bf_lo(a1[dt].x) + w2 * bf_lo(a2[dt].x), r1 = w0 * o[dt][1] + w1 * bf_hi(a1[dt].x) + w2 * bf_hi(a2[dt].x);
                    const float r2 = w0 * o[dt][2] + w1 * bf_lo(a1[dt].y) + w2 * bf_lo(a2[dt].y), r3 = w0 * o[dt][3] + w1 * bf_hi(a1[dt].y) + w2 * bf_hi(a2[dt].y);
                    u32x2 wv; wv.x = cvt_pk_bf16(r0, r1); wv.y = cvt_pk_bf16(r2, r3); *(u32x2*)(op + 16 * dt + 4 * g4) = wv;
                    if ((dt & 3) == 3) __builtin_amdgcn_sched_barrier(0); }
            }
            if (bu == 31) VM_WAIT();
            __syncthreads();
            if (bu == 31) { __builtin_amdgcn_fence(__ATOMIC_ACQUIRE, "agent"); }
            if (bu + 1 < 48) ATT_WRITE(prev);
            __syncthreads();
        }
#undef ATT_DECODE
#undef ATT_LANE
#undef ATT_LOAD
#undef ATT_QLOAD
#undef ATT_WRITE
    }
}

template <int CTRL> __device__ __forceinline__ float dpp_shr0(float v) { return __int_as_float(__builtin_amdgcn_mov_dpp(__float_as_int(v), CTRL, 0xf, 0xf, true)); }
__device__ __forceinline__ float gelu_tanh(float v) {
    const float inner = 0.7978845608028654f * (v + 0.044715f * v * v * v);
    return v * __builtin_amdgcn_rcpf(1.0f + __builtin_amdgcn_exp2f(-2.8853900817779268f * inner));
}
__device__ __forceinline__ void s5_phase(Frame& F, const bf16* U, bf16* Gout, const unsigned* tabl, const float* dskip) {
    typedef __attribute__((address_space(1))) const bf16 gcbf; typedef __attribute__((address_space(1))) bf16 gbf;
    int tid = F.tid;
#define S5_LANE() asm volatile("" : "+v"(tid)); const int lane = tid & 63, vs = lane & 15, g4 = lane >> 4; (void)vs
    for (int unit = F.vcu; unit < BATCH * (NG / 8); unit += F.G) {
        const int b = unit >> 4, g = (unit & 15) * 8 + F.wave;
        const unsigned* tab = tabl + (size_t)g * S5T_WORDS;
        float lr[4][4], li[4][4], xr[4][4], xi[4][4];
        s16x4 bbf[8];
        { S5_LANE();
#pragma unroll
        for (int q = 0; q < 4; ++q)
#pragma unroll
            for (int i = 0; i < 4; ++i) { const int p = 16 * q + 4 * g4 + i; lr[q][i] = __uint_as_float(tab[p]); li[q][i] = __uint_as_float(tab[64 + p]); xr[q][i] = 0.f; xi[q][i] = 0.f; }
#pragma unroll
        for (int tau = 0; tau < 8; ++tau) bbf[tau] = *(const s16x4*)(tab + 256 + (tau * 64 + lane) * 2); }
        const f32x4 zero4 = (f32x4){0.f, 0.f, 0.f, 0.f};
        { S5_LANE();
        gcbf* upt = (gcbf*)(U + ((size_t)b * T + 128 * vs) * D + g * SG + 4 * g4);
#pragma unroll 2
        for (int tt = 0; tt < 128; ++tt, upt += D) {
            const s16x4 ub = *(const __attribute__((address_space(1))) s16x4*)upt;
#pragma unroll
            for (int q = 0; q < 4; ++q) {
                const f32x4 br = __builtin_amdgcn_mfma_f32_16x16x16bf16_1k(bbf[2 * q], ub, zero4, 0, 0, 0), bi = __builtin_amdgcn_mfma_f32_16x16x16bf16_1k(bbf[2 * q + 1], ub, zero4, 0, 0, 0);
#pragma unroll
                for (int i = 0; i < 4; ++i) { const float nr = lr[q][i] * xr[q][i] - li[q][i] * xi[q][i] + br[i], ni = lr[q][i] * xi[q][i] + li[q][i] * xr[q][i] + bi[i]; xr[q][i] = nr; xi[q][i] = ni; }
            }
        } }
        {
            S5_LANE();
            float ar[4][4], ai[4][4];
#pragma unroll
            for (int q = 0; q < 4; ++q)
#pragma unroll
                for (int i = 0; i < 4; ++i) { const int p = 16 * q + 4 * g4 + i; ar[q][i] = __uint_as_float(tab[128 + p]); ai[q][i] = __uint_as_float(tab[192 + p]); }
#define S5_STEP(CTRL) do { _Pragma("unroll") for (int q = 0; q < 4; ++q) _Pragma("unroll") for (int i = 0; i < 4; ++i) { \
                const float nbr = dpp_shr0<CTRL>(xr[q][i]), nbi = dpp_shr0<CTRL>(xi[q][i]); \
                xr[q][i] += ar[q][i] * nbr - ai[q][i] * nbi; xi[q][i] += ar[q][i] * nbi + ai[q][i] * nbr; \
                const float sr = ar[q][i] * ar[q][i] - ai[q][i] * ai[q][i], si = 2.0f * ar[q][i] * ai[q][i]; ar[q][i] = sr; ai[q][i] = si; } } while (0)
            S5_STEP(0x111); S5_STEP(0x112); S5_STEP(0x114); S5_STEP(0x118);
#undef S5_STEP
#pragma unroll
            for (int q = 0; q < 4; ++q)
#pragma unroll
                for (int i = 0; i < 4; ++i) { xr[q][i] = dpp_shr0<0x111>(xr[q][i]); xi[q][i] = dpp_shr0<0x111>(xi[q][i]); }
        }
        { S5_LANE();
        bf16x8 cmf[4];
#pragma unroll
        for (int q = 0; q < 4; ++q) cmf[q] = *(const bf16x8*)(tab + 1280 + (q * 64 + lane) * 4);
        const f32x4 dsk = *(const f32x4*)(dskip + g * SG + 4 * g4);
        gcbf* upt = (gcbf*)(U + ((size_t)b * T + 128 * vs) * D + g * SG + 4 * g4);
        gbf* gp = (gbf*)(Gout + ((size_t)b * T + 128 * vs) * DP + g * SG + 4 * g4);
#pragma unroll 1
        for (int tt = 0; tt < 128; ++tt, upt += D, gp += DP) {
            const u32x2 uw = *(const __attribute__((address_space(1))) u32x2*)upt;
            const s16x4 ub = __builtin_bit_cast(s16x4, uw);
            f32x4 y = zero4;
#pragma unroll
            for (int q = 0; q < 4; ++q) {
                const f32x4 br = __builtin_amdgcn_mfma_f32_16x16x16bf16_1k(bbf[2 * q], ub, zero4, 0, 0, 0), bi = __builtin_amdgcn_mfma_f32_16x16x16bf16_1k(bbf[2 * q + 1], ub, zero4, 0, 0, 0);
#pragma unroll
                for (int i = 0; i < 4; ++i) { const float nr = lr[q][i] * xr[q][i] - li[q][i] * xi[q][i] + br[i], ni = lr[q][i] * xi[q][i] + li[q][i] * xr[q][i] + bi[i]; xr[q][i] = nr; xi[q][i] = ni; }
                u32x4 xw; xw.x = cvt_pk_bf16(xr[q][0], xr[q][1]); xw.y = cvt_pk_bf16(xr[q][2], xr[q][3]); xw.z = cvt_pk_bf16(xi[q][0], xi[q][1]); xw.w = cvt_pk_bf16(xi[q][2], xi[q][3]);
                y = __builtin_amdgcn_mfma_f32_16x16x32_bf16(cmf[q], __builtin_bit_cast(bf16x8, xw), y, 0, 0, 0);
            }
            const float v0 = y[0] + dsk[0] * bf_lo(uw.x), v1 = y[1] + dsk[1] * bf_hi(uw.x), v2 = y[2] + dsk[2] * bf_lo(uw.y), v3 = y[3] + dsk[3] * bf_hi(uw.y);
            u32x2 ow; ow.x = cvt_pk_bf16(gelu_tanh(v0), gelu_tanh(v1)); ow.y = cvt_pk_bf16(gelu_tanh(v2), gelu_tanh(v3));
            *(__attribute__((address_space(1))) u32x2*)gp = ow;
        } }
    }
#undef S5_LANE
}

constexpr int NPH_PAIR = 17, NPHASE = 2 + 2 * NPH_PAIR;
struct Args { const float* in[24]; float* out; unsigned char* ws; int ph_lo, ph_hi, dry, pad; };
__device__ __forceinline__ const float* argp(const Args& a, int i) { asm volatile("" : "+s"(i)); return a.in[i]; }
__global__ void __launch_bounds__(NWAVES * 64, 2) fwd_kernel(Args args) {
    extern __shared__ __attribute__((aligned(16))) unsigned char lds[];
    Frame F;
    F.lds = (LAS unsigned char*)lds;
    F.MISC = (volatile LAS unsigned*)(F.lds + MISC_OFF);
    F.tid = threadIdx.x; F.lane = F.tid & 63; F.wave = __builtin_amdgcn_readfirstlane(F.tid >> 6);
    F.G = gridDim.x; { const int bx = blockIdx.x; F.vcu = (F.G % 8 == 0) ? (bx % 8) * (F.G / 8) + bx / 8 : bx; }
    F.ws = args.ws; F.ctl = (unsigned*)(F.ws + WS_CTL);
    for (int u = F.tid; u < (EXCH_OFF - LDSCTL_OFF) / 4; u += NWAVES * 64) ((LAS unsigned*)(F.lds + LDSCTL_OFF))[u] = 0u;
    __syncthreads();
#if MK_ONE_LAUNCH
    XcdBarrier bar = xcd_barrier_post(F.ctl + CW_BAR, F.MISC + 8);
#if MK_DOUBLE_BAR
#define GRID_BAR() do { xcd_barrier(bar); xcd_barrier(bar); } while (0)
#else
#define GRID_BAR() xcd_barrier(bar)
#endif
#else
#define GRID_BAR() do { } while (0)
#endif
    const int lo = args.ph_lo, hi = args.ph_hi;
#define IN(k) (lo <= (k) && (k) < hi && (frame_refresh(F, args.ws, args.out), true))
#define SEAM(k) do { if (lo <= (k) && (k) + 1 < hi) GRID_BAR(); } while (0)
#define xres (F.out)
#if MK_DRY_MASK
#define xout (args.dry ? (float*)(F.ws + WS_BIG + 512 * MiB) : F.out)
#else
#define xout (F.out)
#endif
#define Hb ((bf16*)(F.ws + WS_H))
#define BIG ((bf16*)(F.ws + WS_BIG))
#define ring (F.lds + RING_OFF)
#define moda ((const float*)(F.ws + WS_MOD) + (size_t)la * BATCH * MODW)
#define mods ((const float*)(F.ws + WS_MOD) + (size_t)ls * BATCH * MODW)
#define xa ((pr == 0) ? argp(args, 0) : (const float*)F.out)

    if (IN(0)) {
        P0In pin{argp(args, 1), argp(args, 2), argp(args, 3), argp(args, 6), argp(args, 7), argp(args, 8), argp(args, 9), argp(args, 10), argp(args, 11), argp(args, 12), argp(args, 13), argp(args, 14), argp(args, 15),
                 argp(args, 17), argp(args, 18), argp(args, 19), argp(args, 22)};
        p0_prologue(F, pin);
    }
    SEAM(0);
    for (int pr = 0; pr < 2; ++pr) {
        const int pb = 1 + NPH_PAIR * pr, la = 2 * pr, ls = 2 * pr + 1;
        if (IN(pb + 0)) norm_mod_phase(F, xa, Hb, argp(args, 4) + (size_t)la * D, moda, 0, D);
        SEAM(pb + 0);
        if (IN(pb + 1)) { pg8::Gemm g{Hb, (const bf16*)(F.ws + WS_WAIN + pr * W_AIN_B), M, AIN, D, DP}; pg8::StaticOrder S; S.init(M, AIN, F.G, pg8::opaque_bid());
#if MK_DRY_MASK
            if (args.dry) { pg8::EpiNull E0; pg8::SameTileOrder S1; S1.init(M, AIN, F.G, pg8::opaque_bid()); pg8::gemm_phase<pg8::EpiNull, pg8::SameTileOrder, true, true>(ring, g, S1, E0); } else
#endif
            { pg8::EpiQKV E{BIG}; pg8::gemm_phase<pg8::EpiQKV, pg8::StaticOrder, true, true>(ring, g, S, E); } }
        SEAM(pb + 1);
#if MK_DRY_MASK
        if (IN(pb + 2)) { if (args.dry) attn_phase<MK_ATTN_SAME != 0>(F, BIG, (bf16*)F.out, (float*)(F.ws + WS_RAW)); else attn_phase<false>(F, BIG, Hb, (float*)(F.ws + WS_LSE)); }
#else
        if (IN(pb + 2)) attn_phase<false>(F, BIG, Hb, (float*)(F.ws + WS_LSE));
#endif
        SEAM(pb + 2);
        if (IN(pb + 3)) { pg8::Gemm g{Hb, (const bf16*)(F.ws + WS_WAOUT + pr * W_DD_B), M, D, D, DP}; pg8::StaticOrder S; S.init(M, D, F.G, pg8::opaque_bid());
            pg8::EpiGateRes E{xa, xout, moda + 2 * D}; pg8::gemm_phase<pg8::EpiGateRes, pg8::StaticOrder, true, true>(ring, g, S, E); }
        SEAM(pb + 3);
        if (IN(pb + 4)) norm_mod_phase(F, xres, Hb, argp(args, 5) + (size_t)la * D, moda, 3 * D, 4 * D);
        SEAM(pb + 4);
        if (IN(pb + 5)) { pg8::Gemm g{Hb, (const bf16*)(F.ws + WS_WUP + la * W_UP_B), M, FF2, D, DP}; pg8::StaticOrder S; S.init(M, FF2, F.G, pg8::opaque_bid());
            pg8::EpiConvGate E{BIG, (float*)(F.ws + WS_RAW), argp(args, 20) + (size_t)la * 3 * FF2, argp(args, 21) + (size_t)la * FF2, F.lds + EXCH_OFF};
            pg8::gemm_phase<pg8::EpiConvGate, pg8::StaticOrder, true, true>(ring, g, S, E); }
        SEAM(pb + 5);
        if (IN(pb + 6)) conv_fix_phase(F, (const float*)(F.ws + WS_RAW), BIG, argp(args, 20) + (size_t)la * 3 * FF2, argp(args, 21) + (size_t)la * FF2);
        SEAM(pb + 6);
        if (IN(pb + 7)) { pg8::Gemm g{BIG, (const bf16*)(F.ws + WS_WDOWN + la * W_DN_B), M, D, FF, FFP}; pg8::StaticOrder S; S.init(M, D, F.G, pg8::opaque_bid());
            pg8::EpiGateRes E{xres, xout, moda + 5 * D}; pg8::gemm_phase<pg8::EpiGateRes, pg8::StaticOrder, true, true>(ring, g, S, E); }
        SEAM(pb + 7);
        if (IN(pb + 8)) norm_mod_phase(F, xres, Hb, argp(args, 4) + (size_t)ls * D, mods, 0, D);
        SEAM(pb + 8);
        if (IN(pb + 9)) { pg8::Gemm g{Hb, (const bf16*)(F.ws + WS_WSIN + pr * W_DD_B), M, D, D, DP}; pg8::StaticOrder S; S.init(M, D, F.G, pg8::opaque_bid());
            pg8::EpiBf16 E{BIG, D}; pg8::gemm_phase<pg8::EpiBf16, pg8::StaticOrder, true, true>(ring, g, S, E); }
        SEAM(pb + 9);
        if (IN(pb + 10)) s5_phase(F, BIG, Hb, (const unsigned*)(F.ws + WS_S5T) + (size_t)pr * NG * S5T_WORDS, argp(args, 16) + (size_t)pr * D);
        SEAM(pb + 10);
        if (IN(pb + 11)) { pg8::Gemm g{Hb, (const bf16*)(F.ws + WS_WSGATE + pr * W_DD_B), M, D, D, DP}; pg8::StaticOrder S; S.init(M, D, F.G, pg8::opaque_bid());
            pg8::EpiSigGate E{Hb, (bf16*)(F.ws + WS_BIG + 128 * MiB)}; pg8::gemm_phase<pg8::EpiSigGate, pg8::StaticOrder, true, true>(ring, g, S, E); }
        SEAM(pb + 11);
        if (IN(pb + 12)) { pg8::Gemm g{(const bf16*)(F.ws + WS_BIG + 128 * MiB), (const bf16*)(F.ws + WS_WSOUT + pr * W_DD_B), M, D, D, DP}; pg8::StaticOrder S; S.init(M, D, F.G, pg8::opaque_bid());
            pg8::EpiGateRes E{xres, xout, mods + 2 * D}; pg8::gemm_phase<pg8::EpiGateRes, pg8::StaticOrder, true, true>(ring, g, S, E); }
        SEAM(pb + 12);
        if (IN(pb + 13)) norm_mod_phase(F, xres, Hb, argp(args, 5) + (size_t)ls * D, mods, 3 * D, 4 * D);
        SEAM(pb + 13);
        if (IN(pb + 14)) { pg8::Gemm g{Hb, (const bf16*)(F.ws + WS_WUP + ls * W_UP_B), M, FF2, D, DP}; pg8::StaticOrder S; S.init(M, FF2, F.G, pg8::opaque_bid());
            pg8::EpiConvGate E{BIG, (float*)(F.ws + WS_RAW), argp(args, 20) + (size_t)ls * 3 * FF2, argp(args, 21) + (size_t)ls * FF2, F.lds + EXCH_OFF};
            pg8::gemm_phase<pg8::EpiConvGate, pg8::StaticOrder, true, true>(ring, g, S, E); }
        SEAM(pb + 14);
        if (IN(pb + 15)) conv_fix_phase(F, (const float*)(F.ws + WS_RAW), BIG, argp(args, 20) + (size_t)ls * 3 * FF2, argp(args, 21) + (size_t)ls * FF2);
        SEAM(pb + 15);
        if (IN(pb + 16)) { pg8::Gemm g{BIG, (const bf16*)(F.ws + WS_WDOWN + ls * W_DN_B), M, D, FF, FFP}; pg8::StaticOrder S; S.init(M, D, F.G, pg8::opaque_bid());
            pg8::EpiGateRes E{xres, xout, mods + 5 * D}; pg8::gemm_phase<pg8::EpiGateRes, pg8::StaticOrder, true, true>(ring, g, S, E); }
        SEAM(pb + 16);
    }
    if (IN(NPHASE - 1)) final_norm_phase(F, xres, xout, argp(args, 23));
#undef IN
#undef xres
#undef xout
#undef Hb
#undef BIG
#undef ring
#undef moda
#undef mods
#undef xa
#undef SEAM
#undef GRID_BAR
}

extern "C" void kernel_launch(void* const* d_in, const int* in_sizes, int n_in, void* d_out, int out_size, void* d_ws, size_t ws_size, hipStream_t stream) {
    static int grid = 0;
    if (grid == 0) {
        if (n_in != 24 || in_sizes[0] != M * D || out_size != M * D || ws_size < WS_END) { fprintf(stderr, "kernel_launch: shape mismatch: n_in %d in0 %d out %d ws %zu (need %zu)\n", n_in, n_in > 0 ? in_sizes[0] : -1, out_size, ws_size, (size_t)WS_END); grid = -1; return; }
        int dev = 0, cus = 0, per_cu = 0;
        if (hipGetDevice(&dev) != hipSuccess || hipDeviceGetAttribute(&cus, hipDeviceAttributeMultiprocessorCount, dev) != hipSuccess) { grid = -1; return; }
        if (hipFuncSetAttribute((const void*)fwd_kernel, hipFuncAttributeMaxDynamicSharedMemorySize, LDS_BYTES) != hipSuccess) { fprintf(stderr, "kernel_launch: hipFuncSetAttribute failed\n"); grid = -1; return; }
        if (hipOccupancyMaxActiveBlocksPerMultiprocessor(&per_cu, (const void*)fwd_kernel, NWAVES * 64, LDS_BYTES) != hipSuccess || per_cu < 1) { fprintf(stderr, "kernel_launch: occupancy query says %d\n", per_cu); }
        (void)hipGetLastError();
        grid = cus;
    }
    if (grid < 0) return;
    if (hipMemsetAsync((char*)d_ws + WS_CTL, 0, CTL_ZERO_BYTES, stream) != hipSuccess) return;
    Args a{};
    for (int i = 0; i < 24; ++i) a.in[i] = (const float*)d_in[i];
    a.out = (float*)d_out; a.ws = (unsigned char*)d_ws;
#if MK_ONE_LAUNCH
    a.ph_lo = 0; a.ph_hi = NPHASE;
    hipLaunchKernelGGL(fwd_kernel, dim3(grid), dim3(NWAVES * 64), LDS_BYTES, stream, a);
#else
    for (int p = 0; p < NPHASE; ++p) { a.ph_lo = p; a.ph_hi = p + 1;
#if MK_DEBUG_CHECKS
        debug_checks(p, true, d_in, (float*)d_out, (unsigned char*)d_ws, stream);
#endif
        { const int kbit = (p == 0) ? 17 : (p == NPHASE - 1 ? 18 : (p - 1) % NPH_PAIR); const int nrep = ((MK_REPEAT_MASK >> kbit) & 1) ? 2 : 1;
          for (int r = 0; r < nrep; ++r) hipLaunchKernelGGL(fwd_kernel, dim3(grid), dim3(NWAVES * 64), LDS_BYTES, stream, a);
          if (((MK_DRY_MASK >> kbit) & 1) && !(kbit == 2 && p > NPH_PAIR)) { a.dry = 1; hipLaunchKernelGGL(fwd_kernel, dim3(grid), dim3(NWAVES * 64), LDS_BYTES, stream, a); a.dry = 0; } }
#if MK_DEBUG_CHECKS
        debug_checks(p, false, d_in, (float*)d_out, (unsigned char*)d_ws, stream);
#endif
    }
#endif
    const hipError_t le = hipPeekAtLastError();
    if (le != hipSuccess) fprintf(stderr, "kernel_launch: launch failed: %s\n", hipGetErrorName(le));
}
```
